# Optimizing an MI355X kernel written in HIP

```python
import jax, jax.numpy as jnp
from jax import lax
import numpy as np

D_MODEL = 1024
BATCH = 32
SEQ = 2048
DEPTH = 2

HEAD_DIM = 64
A_Q_HEADS = 8
A_KV_HEADS = 2
A_WINDOW = 128
B_HEADS = 8
B_PATTERNS = ((128, 1), (512, 4), (2048, 16))
ROPE_THETA = 10000.0
BLOCK = 128
C_HEADS = 16
C_Q_RANK = 384
C_KV_RANK = 256
C_NOPE_DIM = 64
C_ROPE_DIM = 32
C_V_DIM = 64
C_QK_DIM = C_NOPE_DIM + C_ROPE_DIM
D_FF = 2816
N_EXPERTS = 8
TOP_K = 2
D_FF_EXPERT = 3584
MOE_BLOCK = 256
EPS = 1e-6

A_Q_W = A_Q_HEADS * HEAD_DIM
A_KV_W = A_KV_HEADS * HEAD_DIM
B_W = B_HEADS * HEAD_DIM
L0_IN = A_Q_W + 2 * A_KV_W + 3 * B_W
L0_MIX = A_Q_W + B_W
L0_SPLITS = (A_Q_W, A_Q_W + A_KV_W, A_Q_W + 2 * A_KV_W, A_Q_W + 2 * A_KV_W + B_W, A_Q_W + 2 * A_KV_W + 2 * B_W)
L1_IN = C_Q_RANK + C_KV_RANK + C_ROPE_DIM

kernel_name = "hybrid_swa_dilated_mla_moe"


def rms_norm(x, g):
    xf = x.astype(jnp.float32)
    y = xf * lax.rsqrt(jnp.mean(xf * xf, axis=-1, keepdims=True) + EPS)
    return (y * g.astype(jnp.float32)).astype(x.dtype)


def rope_tables(positions, dim):
    inv = ROPE_THETA ** (-jnp.arange(0, dim, 2, dtype=jnp.float32) / dim)
    ang = positions.astype(jnp.float32)[..., None] * inv
    return jnp.cos(ang)[:, :, None, :], jnp.sin(ang)[:, :, None, :]


def apply_rope(t, cos, sin):
    half = t.shape[-1] // 2
    tf = t.astype(jnp.float32)
    t1, t2 = tf[..., :half], tf[..., half:]
    return jnp.concatenate([t1 * cos - t2 * sin, t2 * cos + t1 * sin], axis=-1).astype(t.dtype)


def swiglu(h, w_gate, w_up, w_down):
    return (jax.nn.silu(h @ w_gate) * (h @ w_up)) @ w_down


def banded_attention(q, k, v, max_dist, sinks):
    nb_, L, hq, dh = q.shape
    hkv = k.shape[2]
    g = hq // hkv
    nblk = -(-L // BLOCK)
    lp = nblk * BLOCK
    pad = ((0, 0), (0, lp - L), (0, 0), (0, 0))
    q, k, v = jnp.pad(q, pad), jnp.pad(k, pad), jnp.pad(v, pad)

    def two_blocks(t):
        prev = jnp.pad(t, ((0, 0), (BLOCK, 0), (0, 0), (0, 0)))[:, :lp]
        return jnp.concatenate([prev.reshape(nb_, nblk, BLOCK, hkv, dh),
                                t.reshape(nb_, nblk, BLOCK, hkv, dh)], axis=2)

    kb, vb = two_blocks(k), two_blocks(v)
    qb = q.reshape(nb_, nblk, BLOCK, hkv, g, dh)
    s = jnp.einsum('bnqhgd,bnkhd->bnhgqk', qb, kb, preferred_element_type=jnp.float32) * (dh ** -0.5)
    qi = jnp.arange(BLOCK)[:, None]
    kj = jnp.arange(2 * BLOCK)[None, :]
    dist = BLOCK + qi - kj
    kpos = jnp.arange(nblk)[:, None, None] * BLOCK - BLOCK + kj
    valid = (dist >= 0) & (dist <= max_dist) & (kpos >= 0)
    s = jnp.where(valid[None, :, None, None], s, -jnp.inf)
    m = jnp.max(s, axis=-1)
    if sinks is not None:
        sink = sinks.astype(jnp.float32).reshape(1, 1, hkv, g, 1)
        m = jnp.maximum(m, sink)
    p = jnp.exp(s - m[..., None])
    denom = jnp.sum(p, axis=-1)
    if sinks is not None:
        denom = denom + jnp.exp(sink - m)
    o = jnp.einsum('bnhgqk,bnkhd->bnhgqd', p.astype(v.dtype), vb,
                   preferred_element_type=jnp.float32) / denom[..., None]
    o = o.transpose(0, 1, 4, 2, 3, 5).reshape(nb_, lp, hq, dh)[:, :L]
    lse = (m + jnp.log(denom)).transpose(0, 1, 4, 2, 3).reshape(nb_, lp, hq)[:, :L]
    return o, lse


def dilated_mixture(q, k, v):
    bn, s, h, dh = q.shape
    outs, lses = [], []
    for window, dil in B_PATTERNS:
        def fold(t):
            rest = t.shape[2:]
            return t.reshape(bn, s // dil, dil, *rest).swapaxes(1, 2).reshape(bn * dil, s // dil, *rest)

        def unfold(t):
            rest = t.shape[2:]
            return t.reshape(bn, dil, s // dil, *rest).swapaxes(1, 2).reshape(bn, s, *rest)

        o, lse = banded_attention(fold(q), fold(k), fold(v), window // dil, None)
        outs.append(unfold(o))
        lses.append(unfold(lse))
    w = jax.nn.softmax(jnp.stack(lses), axis=0)
    return jnp.sum(w[..., None] * jnp.stack(outs), axis=0)


def causal_block_attention(q, k, v):
    bn, s, h, dqk = q.shape
    dv = v.shape[-1]
    nq = s // BLOCK
    qb = q.reshape(bn, nq, BLOCK, h, dqk).swapaxes(0, 1)
    key_pos = jnp.arange(s)
    scale = dqk ** -0.5

    def one(args):
        qi, n = args
        sc = jnp.einsum('bqhd,bkhd->bhqk', qi, k, preferred_element_type=jnp.float32) * scale
        qpos = n * BLOCK + jnp.arange(BLOCK)
        sc = jnp.where(qpos[:, None] >= key_pos[None, :], sc, -jnp.inf)
        p = jax.nn.softmax(sc, axis=-1)
        return jnp.einsum('bhqk,bkhd->bqhd', p.astype(v.dtype), v,
                          preferred_element_type=jnp.float32).astype(v.dtype)

    o = lax.map(one, (qb, jnp.arange(nq)))
    return o.swapaxes(0, 1).reshape(bn, s, h * dv)


def moe_swiglu(h, router, we_gate, we_up, we_down):
    bn, s, d = h.shape
    n = bn * s
    xt = h.reshape(n, d)
    logits = jnp.einsum('nd,de->ne', xt, router, preferred_element_type=jnp.float32)
    top_vals, top_idx = lax.top_k(logits, TOP_K)
    gates = jax.nn.softmax(top_vals, axis=-1)
    e_flat = top_idx.reshape(-1).astype(jnp.int32)
    tok_flat = jnp.repeat(jnp.arange(n, dtype=jnp.int32), TOP_K)
    g_flat = gates.reshape(-1)
    order = jnp.argsort(e_flat)
    e_sorted = e_flat[order]
    counts = jnp.zeros((N_EXPERTS,), jnp.int32).at[e_flat].add(1)
    starts = jnp.cumsum(counts) - counts
    padded = (counts + MOE_BLOCK - 1) // MOE_BLOCK * MOE_BLOCK
    pend = jnp.cumsum(padded)
    pstarts = pend - padded
    rank = jnp.arange(n * TOP_K, dtype=jnp.int32) - starts[e_sorted]
    dest = pstarts[e_sorted] + rank
    nb = -(-(n * TOP_K) // MOE_BLOCK) + N_EXPERTS
    p_rows = nb * MOE_BLOCK
    row_tok = jnp.full((p_rows,), n, jnp.int32).at[dest].set(tok_flat[order])
    row_gate = jnp.zeros((p_rows,), jnp.float32).at[dest].set(g_flat[order])
    block_e = jnp.minimum(jnp.searchsorted(pend, jnp.arange(nb, dtype=jnp.int32) * MOE_BLOCK, side='right'),
                          N_EXPERTS - 1)
    x_pad = jnp.concatenate([xt, jnp.zeros((1, d), xt.dtype)], axis=0)
    xs = x_pad[row_tok].reshape(nb, MOE_BLOCK, d)

    def expert_block(args):
        xb, e = args
        return swiglu(xb, we_gate[e], we_up[e], we_down[e])

    ys = lax.map(expert_block, (xs, block_e)).reshape(p_rows, d)
    ys = ys * row_gate[:, None].astype(ys.dtype)
    out = jnp.zeros((n + 1, d), ys.dtype).at[row_tok].add(ys)[:n]
    return out.reshape(bn, s, d)


def ab_layer(x, cos, sin, attn_norm, w_in, a_qn, a_kn, a_sinks, b_qn, b_kn, w_out,
             ffn_norm, w_gate, w_up, w_down):
    bn, s, _ = x.shape
    h = rms_norm(x, attn_norm)
    proj = h @ w_in
    aq, ak, av, bq, bk, bv = jnp.split(proj, L0_SPLITS, axis=-1)

    def heads(t, nh):
        return t.reshape(bn, s, nh, HEAD_DIM)

    aq = apply_rope(rms_norm(heads(aq, A_Q_HEADS), a_qn), cos, sin)
    ak = apply_rope(rms_norm(heads(ak, A_KV_HEADS), a_kn), cos, sin)
    a_out, _ = banded_attention(aq, ak, heads(av, A_KV_HEADS), A_WINDOW - 1, a_sinks)
    bq = apply_rope(rms_norm(heads(bq, B_HEADS), b_qn), cos, sin)
    bk = apply_rope(rms_norm(heads(bk, B_HEADS), b_kn), cos, sin)
    b_out = dilated_mixture(bq, bk, heads(bv, B_HEADS))
    mix = jnp.concatenate([a_out.reshape(bn, s, A_Q_W), b_out.reshape(bn, s, B_W)], axis=-1).astype(x.dtype)
    x = x + mix @ w_out
    return x + swiglu(rms_norm(x, ffn_norm), w_gate, w_up, w_down)


def mla_moe_layer(x, cos, sin, attn_norm, w_in, q_a_norm, w_uq, kv_a_norm, w_ukv, c_qn, c_kn, w_out,
                  ffn_norm, router, we_gate, we_up, we_down):
    bn, s, _ = x.shape
    h = rms_norm(x, attn_norm)
    proj = h @ w_in
    cq, ckv, kpe = jnp.split(proj, (C_Q_RANK, C_Q_RANK + C_KV_RANK), axis=-1)
    q = (rms_norm(cq, q_a_norm) @ w_uq).reshape(bn, s, C_HEADS, C_QK_DIM)
    kv = (rms_norm(ckv, kv_a_norm) @ w_ukv).reshape(bn, s, C_HEADS, C_NOPE_DIM + C_V_DIM)
    k_nope, v = kv[..., :C_NOPE_DIM], kv[..., C_NOPE_DIM:]
    k = jnp.concatenate([k_nope, jnp.broadcast_to(kpe[:, :, None, :], (bn, s, C_HEADS, C_ROPE_DIM))], axis=-1)
    q = rms_norm(q, c_qn)
    k = rms_norm(k, c_kn)
    q = jnp.concatenate([q[..., :C_NOPE_DIM], apply_rope(q[..., C_NOPE_DIM:], cos, sin)], axis=-1)
    k = jnp.concatenate([k[..., :C_NOPE_DIM], apply_rope(k[..., C_NOPE_DIM:], cos, sin)], axis=-1)
    attn = causal_block_attention(q, k, v)
    x = x + attn @ w_out
    return x + moe_swiglu(rms_norm(x, ffn_norm), router, we_gate, we_up, we_down)


def setup_inputs(seed: int = 0) -> dict:
    key = jax.random.key(seed)
    ks = iter(jax.random.split(key, 40))

    def w(shape, fan_in):
        return jax.random.normal(next(ks), shape, jnp.float32) * (fan_in ** -0.5)

    def gain(nd):
        return 1.0 + 0.05 * jax.random.normal(next(ks), (nd,), jnp.float32)

    x = jax.random.normal(next(ks), (BATCH, SEQ, D_MODEL), jnp.float32)
    offsets = jax.random.randint(next(ks), (BATCH, 1), 0, 4096, dtype=jnp.int32)
    positions = (offsets + jnp.arange(SEQ, dtype=jnp.int32)[None, :]).astype(jnp.int32)
    return {
        'x': x,
        'positions': positions,
        'l0_attn_norm': gain(D_MODEL),
        'l0_w_in': w((D_MODEL, L0_IN), D_MODEL),
        'l0_a_q_norm': gain(HEAD_DIM),
        'l0_a_k_norm': gain(HEAD_DIM),
        'l0_a_sinks': 0.5 * jax.random.normal(next(ks), (A_Q_HEADS,), jnp.float32),
        'l0_b_q_norm': gain(HEAD_DIM),
        'l0_b_k_norm': gain(HEAD_DIM),
        'l0_w_out': w((L0_MIX, D_MODEL), L0_MIX),
        'l0_ffn_norm': gain(D_MODEL),
        'l0_w_gate': w((D_MODEL, D_FF), D_MODEL),
        'l0_w_up': w((D_MODEL, D_FF), D_MODEL),
        'l0_w_down': w((D_FF, D_MODEL), D_FF),
        'l1_attn_norm': gain(D_MODEL),
        'l1_w_in': w((D_MODEL, L1_IN), D_MODEL),
        'l1_q_a_norm': gain(C_Q_RANK),
        'l1_w_uq': w((C_Q_RANK, C_HEADS * C_QK_DIM), C_Q_RANK),
        'l1_kv_a_norm': gain(C_KV_RANK),
        'l1_w_ukv': w((C_KV_RANK, C_HEADS * (C_NOPE_DIM + C_V_DIM)), C_KV_RANK),
        'l1_c_q_norm': gain(C_QK_DIM),
        'l1_c_k_norm': gain(C_QK_DIM),
        'l1_w_out': w((C_HEADS * C_V_DIM, D_MODEL), C_HEADS * C_V_DIM),
        'l1_ffn_norm': gain(D_MODEL),
        'l1_router': w((D_MODEL, N_EXPERTS), D_MODEL),
        'l1_we_gate': w((N_EXPERTS, D_MODEL, D_FF_EXPERT), D_MODEL),
        'l1_we_up': w((N_EXPERTS, D_MODEL, D_FF_EXPERT), D_MODEL),
        'l1_we_down': w((N_EXPERTS, D_FF_EXPERT, D_MODEL), D_FF_EXPERT),
    }


def reference(x, positions, l0_attn_norm, l0_w_in, l0_a_q_norm, l0_a_k_norm, l0_a_sinks, l0_b_q_norm,
              l0_b_k_norm, l0_w_out, l0_ffn_norm, l0_w_gate, l0_w_up, l0_w_down, l1_attn_norm, l1_w_in,
              l1_q_a_norm, l1_w_uq, l1_kv_a_norm, l1_w_ukv, l1_c_q_norm, l1_c_k_norm, l1_w_out, l1_ffn_norm,
              l1_router, l1_we_gate, l1_we_up, l1_we_down):
    cos_h, sin_h = rope_tables(positions, HEAD_DIM)
    cos_c, sin_c = rope_tables(positions, C_ROPE_DIM)
    layer_params = (
        (l0_attn_norm, l0_w_in, l0_a_q_norm, l0_a_k_norm, l0_a_sinks, l0_b_q_norm, l0_b_k_norm, l0_w_out,
         l0_ffn_norm, l0_w_gate, l0_w_up, l0_w_down),
        (l1_attn_norm, l1_w_in, l1_q_a_norm, l1_w_uq, l1_kv_a_norm, l1_w_ukv, l1_c_q_norm, l1_c_k_norm,
         l1_w_out, l1_ffn_norm, l1_router, l1_we_gate, l1_we_up, l1_we_down),
    )
    for layer in range(DEPTH):
        if layer % 2 == 0:
            x = ab_layer(x, cos_h, sin_h, *layer_params[layer])
        else:
            x = mla_moe_layer(x, cos_c, sin_c, *layer_params[layer])
    return x
```

```cpp
#include <hip/hip_runtime.h>
#include <cstdio>
#include <cstdint>

#ifndef PROBE_MASK
#define PROBE_MASK 0u
#endif
#ifndef MK_PER_PHASE
#define MK_PER_PHASE 0
#endif

#define LAS __attribute__((address_space(3)))
#define GAS __attribute__((address_space(1)))
typedef unsigned short bf16_t;
typedef short bf16x8 __attribute__((ext_vector_type(8)));
typedef short s16x4 __attribute__((ext_vector_type(4)));
typedef float f32x2 __attribute__((ext_vector_type(2)));
typedef float f32x4 __attribute__((ext_vector_type(4)));
typedef float f32x16 __attribute__((ext_vector_type(16)));
typedef unsigned u32x2 __attribute__((ext_vector_type(2)));
typedef unsigned u32x4 __attribute__((ext_vector_type(4)));
typedef int v8i_t __attribute__((ext_vector_type(8)));
typedef int v4i_t __attribute__((ext_vector_type(4)));
typedef short bf16x16_t __attribute__((ext_vector_type(16)));

constexpr int NTOK = 65536, DM = 1024, SEQ = 2048, NBATCH = 32;
constexpr int L0_IN = 2304, DFF = 2816, L1_INP = 768  , CQ = 384, CKV = 256, NUQ = 1536, NUKV = 2048;
constexpr int NEXP = 8, DFE = 3584, MOE_ROWS_MAX = 133120  , MOE_TILES_MAX = 520, MOE_CHUNK_TILES = 130;
constexpr float EPS = 1e-6f;
constexpr float LOG2E = 1.4426950408889634f;
constexpr float WGU_SCALE = 32.0f, WDN_SCALE = 64.0f;

constexpr size_t MiB = 1u << 20;
constexpr size_t WS_CTL = 0, CTL_ZERO_BYTES = 64 * 1024;
constexpr size_t WS_ROUTE = 1 * MiB;
constexpr size_t RT_TOKE = WS_ROUTE;
constexpr size_t RT_TOKG = RT_TOKE + (size_t)NTOK * 8;
constexpr size_t RT_TOKS = RT_TOKG + (size_t)NTOK * 8;
constexpr size_t RT_ROWTOK = RT_TOKS + (size_t)NTOK * 8;
constexpr size_t RT_WGCNT = RT_ROWTOK + (size_t)MOE_ROWS_MAX * 4;
constexpr size_t RT_TILEE = RT_WGCNT + 1024 * 8 * 4;
constexpr size_t RT_ROWST = RT_TILEE + 4096;
constexpr size_t RT_END = RT_ROWST + (size_t)NTOK * 8;
static_assert(RT_END <= 4 * MiB, "route tables");
constexpr size_t WS_W = 4 * MiB;
constexpr size_t W0_IN = WS_W;
constexpr size_t W0_OUT = W0_IN + (size_t)L0_IN * DM * 2;
constexpr size_t W0_GU = W0_OUT + (size_t)DM * DM * 2;
constexpr size_t W0_DN = W0_GU + (size_t)2 * DFF * DM * 2;
constexpr size_t W1_IN = W0_DN + (size_t)DM * DFF * 2;
constexpr size_t W1_UQ = W1_IN + (size_t)L1_INP * DM * 2;
constexpr size_t W1_UKV = W1_UQ + (size_t)NUQ * CQ * 2;
constexpr size_t W1_OUT = W1_UKV + (size_t)NUKV * CKV * 2;
constexpr size_t WE_GU = W1_OUT + (size_t)DM * DM * 2;
constexpr size_t WE_DN = WE_GU + (size_t)NEXP * 2 * DFE * DM;
constexpr size_t WS_W_END = WE_DN + (size_t)NEXP * DM * DFE;
static_assert(WS_W_END <= 202 * MiB, "weights");
constexpr size_t WS_H = 202 * MiB;
constexpr size_t WS_PROJ0 = 330 * MiB;
constexpr size_t WS_MIX = 618 * MiB;
constexpr size_t WS_PART = 746 * MiB;
constexpr size_t WS_LSE = 874 * MiB;
constexpr size_t WS_X12 = 746 * MiB;
constexpr size_t WS_SSX = 1004 * MiB;
constexpr size_t WS_ROPEH = 1000 * MiB;
constexpr size_t WS_ROPEC = 1016 * MiB;
constexpr size_t WS_HID0 = 330 * MiB;
constexpr size_t WS_PROJ1 = 878 * MiB;
constexpr size_t WS_Q = 426 * MiB;
constexpr size_t WS_KV = 618 * MiB;
constexpr size_t WS_K = 202 * MiB;
constexpr size_t WS_ATT = 874 * MiB;
constexpr size_t WS_X3 = 117 * MiB;
constexpr size_t WS_H3F8 = 245 * MiB;
constexpr size_t WS_HIDE = 309 * MiB;
constexpr size_t WS_Y = 764 * MiB;
static_assert(WE_DN + (size_t)NEXP * DM * DFE <= WS_X3 && WS_X3 + (size_t)NTOK * DM * 2 <= WS_H3F8, "x3 map");
constexpr size_t WS_END = 1024 * MiB;
static_assert(WS_H3F8 + (size_t)NTOK * DM <= WS_HIDE && WS_HIDE + (size_t)MOE_ROWS_MAX * DFE <= WS_Y && WS_Y + (size_t)MOE_ROWS_MAX * DM * 2 <= WS_END, "moe map");
static_assert(WS_ATT + (size_t)NTOK * DM * 2 <= WS_ROPEC, "att map");

constexpr int CW_BAR = 1024;

constexpr int RING_BYTES = 131072;
constexpr int LDS_ROWTAB = RING_BYTES;
constexpr int LDS_BYTES = 147456;
constexpr int LDS_MISC = LDS_BYTES - 256;

#define RLX_AGENT __ATOMIC_RELAXED, __HIP_MEMORY_SCOPE_AGENT
#define LDS_WAIT() asm volatile("s_waitcnt lgkmcnt(0)" ::: "memory")
#define VM_WAIT() asm volatile("s_waitcnt vmcnt(0)" ::: "memory")
__device__ __forceinline__ unsigned cvt_pk_bf16(float lo, float hi) { unsigned r; asm volatile("v_cvt_pk_bf16_f32 %0, %1, %2" : "=v"(r) : "v"(lo), "v"(hi)); return r; }
__device__ __forceinline__ unsigned pk4_fp8(float a, float b, float c, float d) { int w = 0; w = __builtin_amdgcn_cvt_pk_fp8_f32(a, b, w, false); w = __builtin_amdgcn_cvt_pk_fp8_f32(c, d, w, true); return (unsigned)w; }
__device__ __forceinline__ float bf_lo(unsigned u) { return __uint_as_float(u << 16); }
__device__ __forceinline__ float bf_hi(unsigned u) { return __uint_as_float(u & 0xffff0000u); }
__device__ __forceinline__ int lane_id() { return (int)__builtin_amdgcn_mbcnt_hi(~0u, __builtin_amdgcn_mbcnt_lo(~0u, 0u)); }
__device__ __forceinline__ int lane_id_v() { int l; asm volatile("v_mbcnt_lo_u32_b32 %0, -1, 0\n\tv_mbcnt_hi_u32_b32 %0, -1, %0" : "=v"(l)); return l; }
__device__ __forceinline__ float wave_sum(float v) {
#pragma unroll
    for (int o = 1; o < 64; o <<= 1) v += __shfl_xor(v, o);
    return v;
}
__device__ __forceinline__ float fq_sum(float v) {
    auto a = __builtin_amdgcn_permlane16_swap(__float_as_uint(v), __float_as_uint(v), false, false); v = __uint_as_float(a[0]) + __uint_as_float(a[1]);
    auto b = __builtin_amdgcn_permlane32_swap(__float_as_uint(v), __float_as_uint(v), false, false); return __uint_as_float(b[0]) + __uint_as_float(b[1]); }
__device__ __forceinline__ float swap32_max(float v) { auto rr = __builtin_amdgcn_permlane32_swap(__float_as_uint(v), __float_as_uint(v), false, false); return fmaxf(__uint_as_float(rr[0]), __uint_as_float(rr[1])); }
__device__ __forceinline__ float swap32_sum(float v) { auto rr = __builtin_amdgcn_permlane32_swap(__float_as_uint(v), __float_as_uint(v), false, false); return __uint_as_float(rr[0]) + __uint_as_float(rr[1]); }

#define XB_TMO      128
#define XB_XCNT(j)  (256  + 64 * (j))
#define XB_XSUB(j)  (1280 + 64 * (j))
#define XB_XGEN(j)  (2304 + 64 * (j))
#define XB_TOP      3328
#define XB_TOPGEN   3392
#define XCD_BAR_WORDS 3456
#define XB_SPIN_CAP (1u << 18)
__device__ __forceinline__ unsigned xb_ld(unsigned* p)              { return __hip_atomic_load(p, __ATOMIC_RELAXED, __HIP_MEMORY_SCOPE_AGENT); }
__device__ __forceinline__ unsigned xb_add(unsigned* p, unsigned v) { return __hip_atomic_fetch_add(p, v, __ATOMIC_RELAXED, __HIP_MEMORY_SCOPE_AGENT); }
__device__ __forceinline__ unsigned xb_xcc_id() { return (unsigned)__builtin_amdgcn_s_getreg((3 << 11) | 20) & 0xFu; }
#define XB_SPIN(cond, bar) do { unsigned _sp = 0; while (cond) { __builtin_amdgcn_s_sleep(1); \
    if ((++_sp & 255u) == 0u) { if (xb_ld(&(bar)[XB_TMO])) break; if (_sp > XB_SPIN_CAP) { atomicAdd(&(bar)[XB_TMO], 1u); break; } } } } while (0)
struct XcdBarrier { unsigned* bar; unsigned x; volatile LAS unsigned* st; int wave; };
__device__ __forceinline__ XcdBarrier xcd_barrier_post(unsigned* bar, volatile LAS unsigned* st, int wave) {
    XcdBarrier b; b.bar = bar; b.x = xb_xcc_id(); b.st = st; b.wave = wave;
    if (wave == 0 && lane_id() == 0) (void)xb_add(&bar[XB_XCNT(b.x)], 1u);
    return b;
}
__device__ __forceinline__ void xcd_barrier_complete(unsigned* bar, unsigned x, unsigned& nloc, unsigned& nx) {
    const unsigned G = gridDim.x * gridDim.y * gridDim.z;
    unsigned sum, cnt, mine, sp = 0u;
    for (;;) {
        sum = 0u; cnt = 0u; mine = 0u;
#pragma unroll
        for (unsigned j = 0; j < 16; ++j) { const unsigned c = xb_ld(&bar[XB_XCNT(j)]); sum += c; cnt += (c > 0u) ? 1u : 0u; mine = (j == x) ? c : mine; }
        if (sum == G) break;
        __builtin_amdgcn_s_sleep(1);
        if ((++sp & 255u) == 0u) { if (xb_ld(&bar[XB_TMO])) break; if (sp > XB_SPIN_CAP) { atomicAdd(&bar[XB_TMO], 1u); break; } }
    }
    nloc = mine > 0u ? mine : 1u; nx = cnt > 0u ? cnt : 1u;
}
__device__ __forceinline__ void xcd_barrier(const XcdBarrier& b) {
    asm volatile("s_waitcnt vmcnt(0)" ::: "memory");
    __syncthreads();
    if (b.wave == 0 && lane_id() == 0) {
        unsigned* bar = b.bar;
        __builtin_amdgcn_s_waitcnt(0);
        unsigned nloc = b.st[0], nx = b.st[1];
        if (nloc == 0u) { xcd_barrier_complete(bar, b.x, nloc, nx); b.st[0] = nloc; b.st[1] = nx; }
        const unsigned old = xb_add(&bar[XB_XSUB(b.x)], 1u);
        const unsigned gen = old / nloc;
        if (old + 1u == (gen + 1u) * nloc) {
            __builtin_amdgcn_fence(__ATOMIC_RELEASE, "agent");
            asm volatile("s_waitcnt vmcnt(0)" ::: "memory");
            const unsigned og = xb_add(&bar[XB_TOP], 1u);
            const unsigned tg = og / nx;
            if (og + 1u == (tg + 1u) * nx) xb_add(&bar[XB_TOPGEN], 1u);
            else XB_SPIN(xb_ld(&bar[XB_TOPGEN]) == tg, bar);
            __builtin_amdgcn_fence(__ATOMIC_ACQUIRE, "agent");
            xb_add(&bar[XB_XGEN(b.x)], 1u);
            asm volatile("s_waitcnt vmcnt(0)" ::: "memory");
        } else {
            XB_SPIN(xb_ld(&bar[XB_XGEN(b.x)]) == gen, bar);
            __builtin_amdgcn_fence(__ATOMIC_ACQUIRE, "agent");
            asm volatile("s_waitcnt vmcnt(0)" ::: "memory");
        }
    }
    __syncthreads();
}

namespace pg8 {
constexpr int BM = 256, BK = 64, HALF = 128, HTB = HALF * BK * 2, STAGE_BYTES = 8 * HTB, NXCD = 8, WGM = 8;
__host__ __device__ __forceinline__ int lds_byte(int r, int c) { const int st = (r >> 4) * 2 + (c >> 5), rr = r & 15, cc = c & 31, ob = rr * 64 + cc * 2; return st * 1024 + (ob ^ (((ob >> 9) & 1) << 5)); }
__host__ __device__ __forceinline__ void stage_rc(int b, int& R, int& C) { const int st = b / 1024, sb = b % 1024, swz = sb ^ (((sb >> 9) & 1) << 5); R = (st >> 1) * 16 + swz / 64; C = (st & 1) * 32 + (swz % 64) / 2; }
__host__ __device__ __forceinline__ int perm32(int rho) { const int n = rho >> 4, i = rho & 15; return 8 * (i >> 2) + 4 * n + (i & 3); }

struct Unit { int pm, pn, e; };
struct Gemm { const bf16_t* A; const bf16_t* Bt; int lda, K; size_t bstride; const int* rowtab; };

struct StaticOrder {
    int nM, nN, nwg, G, c, pm0; const int* tile_e;
    __device__ void init(int nM_, int nN_, int G_, int c_, int pm0_ = 0, const int* te = nullptr) { nM = nM_; nN = nN_; nwg = nM * nN; G = G_; c = c_; pm0 = pm0_; tile_e = te; }
    template <int NN> __device__ bool next_dense(int i, Unit& u) const {
        const int L = i * G + c; if (L >= nwg) return false;
        const int wgid = (L % NXCD) * ((NTOK / 256) * NN / NXCD) + L / NXCD;
        const int gid = wgid / (WGM * NN), w = wgid % (WGM * NN);
        u.pm = gid * WGM + (w % WGM); u.pn = w / WGM; u.e = 0; return true;
    }
    __device__ bool next(int i, Unit& u) const {
        const int L = i * G + c; if (L >= nwg) return false;
        int wgid = L; { const int q = nwg / NXCD, r = nwg % NXCD, xcd = wgid % NXCD, off = wgid / NXCD; wgid = (xcd < r ? xcd * (q + 1) : r * (q + 1) + (xcd - r) * q) + off; }
        const int nig = WGM * nN, gid = wgid / nig, fm = gid * WGM, gsz = (nM - fm) < WGM ? (nM - fm) : WGM;
        u.pm = pm0 + fm + ((wgid % nig) % gsz); u.pn = (wgid % nig) / gsz;
        u.e = tile_e ? __builtin_amdgcn_readfirstlane(tile_e[u.pm]) : 0;
        return true;
    }
};

template <class Epi, bool GATHER, int ESZ = 2, int NNC = 0, int WSC = 0x7f7f7f7f  >
__device__ __forceinline__ void gemm_phase(LAS unsigned char* lds, const Gemm g, const StaticOrder& S, const Epi& E, int a_row0  , int wave_id) {
    const int wid = wave_id, wr = wid >> 2, wc = wid & 3;
    const int K = g.K, nt = K * ESZ / 128, lda = g.lda;
    const unsigned hstepA = (unsigned)(HALF * lda * ESZ), hstepB = (unsigned)(HALF * K * ESZ);
    const unsigned ldsw0 = (unsigned)wid * 1024u;
    const __amdgpu_buffer_rsrc_t rsA = __builtin_amdgcn_make_buffer_rsrc((void*)g.A, (short)0, 0x7ffffff0, 0x00020000);
    const __amdgpu_buffer_rsrc_t rsB = __builtin_amdgcn_make_buffer_rsrc((void*)g.Bt, (short)0, 0x7ffffff0, 0x00020000);
#define PG8_SA(b, h) (((b) * 2 + (h)) * HTB)
#define PG8_SB(b, h) ((4 + (b) * 2 + (h)) * HTB)
#define PG8_STAGE_B(bufoff, soff) do { _Pragma("unroll") for (int _i = 0; _i < 2; ++_i) \
        __builtin_amdgcn_raw_ptr_buffer_load_lds(rsB, (LAS unsigned*)(lds + (bufoff) + ldsw + _i * 8192), 16, voffB[_i], (soff), 0, 0); } while (0)
#define PG8_STAGE_A(bufoff, abase, h, kofs, VO) do { _Pragma("unroll") for (int _i = 0; _i < 2; ++_i) { if constexpr (GATHER) \
        __builtin_amdgcn_raw_ptr_buffer_load_lds(rsA, (LAS unsigned*)(lds + (bufoff) + ldsw + _i * 8192), 16, VO[h][_i], (kofs), 0, 0); else \
        __builtin_amdgcn_raw_ptr_buffer_load_lds(rsA, (LAS unsigned*)(lds + (bufoff) + ldsw + _i * 8192), 16, voffA[_i], (abase) + (h) * hstepA + (kofs), 0, 0); } } while (0)
#define PG8_LD1(base, i) __builtin_shufflevector(*(const LAS v4i_t*)(lds + (base) + (i) * 2048), *(const LAS v4i_t*)(lds + (base) + (i) * 2048 + 1024), 0, 1, 2, 3, 4, 5, 6, 7)
#define PG8_LD1H(off, i) __builtin_shufflevector(*(const LAS v4i_t*)(ldsB + (off) + (i) * 2048), *(const LAS v4i_t*)(ldsB + (off) + (i) * 2048 + 1024), 0, 1, 2, 3, 4, 5, 6, 7)
#define PG8_LDA(dst, b, h) do { _Pragma("unroll") for (int m = 0; m < 4; ++m) dst[m] = PG8_LD1(PG8_SA(b, h) + aoff, m); } while (0)
#define PG8_LDB(dst, b, h) do { _Pragma("unroll") for (int n = 0; n < 2; ++n) dst[n] = PG8_LD1H(PG8_SB(b, h) - 65536, n); } while (0)
#define PG8_LO(x) __builtin_bit_cast(bf16x8, __builtin_shufflevector(x, x, 0, 1, 2, 3))
#define PG8_HI(x) __builtin_bit_cast(bf16x8, __builtin_shufflevector(x, x, 4, 5, 6, 7))
#define PG8_MMA(ai, bj, At, Bt) do { __builtin_amdgcn_s_setprio(1); if constexpr (ESZ == 2) { _Pragma("unroll") for (int m = 0; m < 4; ++m) _Pragma("unroll") for (int n = 0; n < 2; ++n) { \
        acc[ai][bj][m][n] = __builtin_amdgcn_mfma_f32_16x16x32_bf16(PG8_LO(Bt[n]), PG8_LO(At[m]), acc[ai][bj][m][n], 0, 0, 0); \
        acc[ai][bj][m][n] = __builtin_amdgcn_mfma_f32_16x16x32_bf16(PG8_HI(Bt[n]), PG8_HI(At[m]), acc[ai][bj][m][n], 0, 0, 0); } } \
        else { _Pragma("unroll") for (int m = 0; m < 4; ++m) _Pragma("unroll") for (int n = 0; n < 2; ++n) \
        acc[ai][bj][m][n] = __builtin_amdgcn_mfma_scale_f32_16x16x128_f8f6f4(Bt[n], At[m], acc[ai][bj][m][n], 0, 0, 0, WSC, 0, 0x7f7f7f7f); } \
        __builtin_amdgcn_s_setprio(0); } while (0)
#define PG8_WAIT_V(n) asm volatile("s_waitcnt vmcnt(" #n ")" ::: "memory")
#define PG8_WAIT_L(n) asm volatile("s_waitcnt lgkmcnt(" #n ")" ::: "memory")
#define PG8_BAR __builtin_amdgcn_s_barrier()
#define PG8_SCHED __builtin_amdgcn_sched_barrier(0)
    Unit cur, nxt; int ui = 0;
    if (!(NNC > 0 ? S.template next_dense<NNC ? NNC : 1>(0, cur) : S.next(0, cur))) return;
    f32x4 acc[2][2][4][2];
    v8i_t At[4], B0[2], B1[2];
    unsigned voC[2][2];
    LAS int* rtab = (LAS int*)(lds + RING_BYTES);
#pragma unroll
    for (int h = 0; h < 2; ++h)
#pragma unroll
        for (int i = 0; i < 2; ++i) voC[h][i] = 0;
    unsigned cA = (unsigned)((cur.pm * BM - a_row0) * lda * ESZ), cB = (unsigned)((cur.e * (int)g.bstride + cur.pn * BM * K) * ESZ);
    for (;;) {
        float zr; asm volatile("v_mov_b32 %0, 0" : "=v"(zr));
#pragma unroll
        for (int a = 0; a < 2; ++a)
#pragma unroll
            for (int b = 0; b < 2; ++b)
#pragma unroll
                for (int m = 0; m < 4; ++m)
#pragma unroll
                    for (int n = 0; n < 2; ++n) { acc[a][b][m][n] = (f32x4){zr, zr, zr, zr}; }
        const int lane = lane_id_v(), tid = wid * 64 + lane, fr = lane & 15, fq = lane >> 4;
        unsigned voffA[2], voffB[2];
#pragma unroll
        for (int i = 0; i < 2; ++i) { int R_, C_; stage_rc(tid * 16 + i * 8192, R_, C_); voffA[i] = (unsigned)(R_ * lda * ESZ + C_ * 2); voffB[i] = (unsigned)(R_ * K * ESZ + C_ * 2); }
        const int aoff = lds_byte(wr * 64 + fr, fq * 8), boff = lds_byte(wc * 32 + fr, fq * 8);
        LAS unsigned char* ldsB = lds + 65536 + boff;
        if (ui == 0) {
            const unsigned ldsw = ldsw0;
            if constexpr (GATHER) {
#pragma unroll
                for (int h = 0; h < 2; ++h)
#pragma unroll
                    for (int i = 0; i < 2; ++i) { int R_, C_; stage_rc(tid * 16 + i * 8192, R_, C_); int t = g.rowtab[cur.pm * BM + h * HALF + R_]; t = t < 0 ? 0 : t; voC[h][i] = (unsigned)t * (unsigned)(lda * ESZ) + (unsigned)C_ * 2u; }
                VM_WAIT();
            }
            PG8_STAGE_B(PG8_SB(0, 0), cB); PG8_STAGE_B(PG8_SB(0, 1), cB + hstepB); PG8_STAGE_A(PG8_SA(0, 0), cA, 0, 0u, voC); PG8_STAGE_A(PG8_SA(0, 1), cA, 1, 0u, voC);
            if (wr == 1) PG8_BAR;
            PG8_WAIT_V(2); PG8_BAR;
            PG8_STAGE_B(PG8_SB(1, 0), cB + 128u); PG8_STAGE_A(PG8_SA(1, 0), cA, 0, 128u, voC); PG8_STAGE_B(PG8_SB(1, 1), cB + hstepB + 128u);
            PG8_WAIT_V(6); PG8_BAR;
        }
        const bool has_next = NNC > 0 ? S.template next_dense<NNC ? NNC : 1>(ui + 1, nxt) : S.next(ui + 1, nxt);
        const unsigned nA = has_next ? (unsigned)((nxt.pm * BM - a_row0) * lda * ESZ) : cA, nB = has_next ? (unsigned)((nxt.e * (int)g.bstride + nxt.pn * BM * K) * ESZ) : cB;
        if constexpr (GATHER) {
            if (has_next && wid == 0) __builtin_amdgcn_global_load_lds((const unsigned*)(g.rowtab + nxt.pm * BM + lane * 4), (LAS unsigned*)(lds + RING_BYTES + ((ui + 1) & 1) * 1024), 16, 0, 0);
        }
#pragma unroll 1
        for (int t = 0; t < nt; t += 2) {
            unsigned ldsw = ldsw0; asm volatile("" : "+s"(ldsw));
            int last_i = __builtin_amdgcn_readfirstlane((t == nt - 2) ? 1 : 0); asm volatile("" : "+s"(last_i));
            const bool last = last_i != 0;
            const unsigned k1 = (unsigned)(t + 1) * 128u;
            const unsigned a2 = last ? nA : cA, k2 = last ? 0u : (unsigned)(t + 2) * 128u;
            const unsigned b2 = last ? nB : cB + (unsigned)(t + 2) * 128u;
            const unsigned b3 = b2 + 128u, k3 = k2 + 128u;
            PG8_LDB(B0, 0, 0); PG8_LDB(B1, 0, 1); PG8_SCHED; PG8_LDA(At, 0, 0); PG8_STAGE_A(PG8_SA(1, 1), cA, 1, k1, voC);
            PG8_WAIT_V(8); PG8_WAIT_L(0); PG8_BAR; PG8_MMA(0, 0, At, B0); PG8_MMA(0, 1, At, B1); PG8_BAR; PG8_SCHED;
            if constexpr (GATHER) {
                if (last && has_next) {
#pragma unroll
                    for (int h = 0; h < 2; ++h)
#pragma unroll
                        for (int i = 0; i < 2; ++i) { int R_, C_; stage_rc(tid * 16 + i * 8192, R_, C_); int tk = rtab[((ui + 1) & 1) * 256 + h * HALF + R_]; tk = tk < 0 ? 0 : tk; voC[h][i] = (unsigned)tk * (unsigned)(lda * ESZ) + (unsigned)C_ * 2u; }
                }
            }
            PG8_LDA(At, 0, 1); PG8_STAGE_B(PG8_SB(0, 0), b2); PG8_STAGE_B(PG8_SB(0, 1), b2 + hstepB);
            PG8_STAGE_A(PG8_SA(0, 0), a2, 0, k2, voC);
            PG8_WAIT_V(8); PG8_WAIT_L(0); PG8_BAR; PG8_MMA(1, 0, At, B0); PG8_MMA(1, 1, At, B1); PG8_BAR; PG8_SCHED;
            PG8_LDB(B0, 1, 0); PG8_LDB(B1, 1, 1); PG8_SCHED; PG8_LDA(At, 1, 0);
            PG8_STAGE_A(PG8_SA(0, 1), a2, 1, k2, voC);
            PG8_WAIT_V(8); PG8_WAIT_L(0); PG8_BAR; PG8_MMA(0, 0, At, B0); PG8_MMA(0, 1, At, B1); PG8_BAR; PG8_SCHED;
            PG8_LDA(At, 1, 1); PG8_STAGE_B(PG8_SB(1, 0), b3); PG8_STAGE_B(PG8_SB(1, 1), b3 + hstepB);
            PG8_STAGE_A(PG8_SA(1, 0), a2, 0, k3, voC);
            PG8_WAIT_V(8); PG8_WAIT_L(0); PG8_BAR; PG8_MMA(1, 0, At, B0); PG8_MMA(1, 1, At, B1); PG8_BAR; PG8_SCHED;
        }
        if (wr == 0) PG8_BAR;
        { const int l2 = lane_id_v(); E(acc, cur, wr, wc, l2 & 15, l2 >> 4); }
        if (!has_next) break;
        cur = nxt; cA = nA; cB = nB; ++ui;
        if (wr == 1) PG8_BAR;
    }
    PG8_WAIT_V(0);
    PG8_BAR;
#undef PG8_SA
#undef PG8_SB
#undef PG8_STAGE_A
#undef PG8_STAGE_B
#undef PG8_LD1
#undef PG8_LD1H
#undef PG8_LDA
#undef PG8_LDB
#undef PG8_LO
#undef PG8_HI
#undef PG8_MMA
#undef PG8_WAIT_V
#undef PG8_WAIT_L
#undef PG8_BAR
#undef PG8_SCHED
}


struct EpiBf16 {
    bf16_t* O; int ldc; float sc;
    __device__ __forceinline__ void operator()(const f32x4 (&acc)[2][2][4][2], const Unit& u, int wr, int wc, int fr, int fq) const {
        const int row0 = u.pm * BM + wr * 64 + fr, col0 = u.pn * BM + wc * 32 + 8 * fq;
#pragma unroll
        for (int ai = 0; ai < 2; ++ai)
#pragma unroll
            for (int m = 0; m < 4; ++m) { bf16_t* rowp = O + (size_t)(row0 + ai * HALF + m * 16) * ldc + col0;
#pragma unroll
                for (int bj = 0; bj < 2; ++bj) { const f32x4 v0 = acc[ai][bj][m][0] * sc, v1 = acc[ai][bj][m][1] * sc;
                    u32x4 w; w.x = cvt_pk_bf16(v0[0], v0[1]); w.y = cvt_pk_bf16(v0[2], v0[3]); w.z = cvt_pk_bf16(v1[0], v1[1]); w.w = cvt_pk_bf16(v1[2], v1[3]);
                    *(u32x4*)(rowp + bj * HALF) = w; } }
    }
};
struct EpiProj1 {
    bf16_t* O; float* SS; LAS float* part; const float* ssx;
    __device__ __forceinline__ void operator()(const f32x4 (&acc)[2][2][4][2], const Unit& u, int wr, int wc, int fr, int fq) const {
        const int row0 = u.pm * BM + wr * 64 + fr, col0 = u.pn * BM + wc * 32 + 8 * fq, wid = wr * 4 + wc;
        float rsv[8];
#pragma unroll
        for (int i = 0; i < 8; ++i) { const f32x4 x4 = *(const f32x4*)(ssx + (size_t)(row0 + (i >> 2) * HALF + (i & 3) * 16) * 4); rsv[i] = __builtin_amdgcn_rsqf(((x4[0] + x4[1]) + (x4[2] + x4[3])) * (1.f / DM) + EPS); }
#pragma unroll
        for (int ai = 0; ai < 2; ++ai)
#pragma unroll
            for (int m = 0; m < 4; ++m) { bf16_t* rowp = O + (size_t)(row0 + ai * HALF + m * 16) * L1_INP + col0;
                const float rstd = rsv[ai * 4 + m];
#pragma unroll
                for (int bj = 0; bj < 2; ++bj) { const f32x4 v0 = acc[ai][bj][m][0] * rstd, v1 = acc[ai][bj][m][1] * rstd;
                    u32x4 w; w.x = cvt_pk_bf16(v0[0], v0[1]); w.y = cvt_pk_bf16(v0[2], v0[3]); w.z = cvt_pk_bf16(v1[0], v1[1]); w.w = cvt_pk_bf16(v1[2], v1[3]);
                    *(u32x4*)(rowp + bj * HALF) = w;
                    float ss = (bf_lo(w.x) * bf_lo(w.x) + bf_hi(w.x) * bf_hi(w.x)) + (bf_lo(w.y) * bf_lo(w.y) + bf_hi(w.y) * bf_hi(w.y)) + (bf_lo(w.z) * bf_lo(w.z) + bf_hi(w.z) * bf_hi(w.z)) + (bf_lo(w.w) * bf_lo(w.w) + bf_hi(w.w) * bf_hi(w.w));
                    ss = fq_sum(ss);
                    if (fq == 0) part[((wid * 2 + bj) * 8 + ai * 4 + m) * 16 + fr] = ss; } }
        asm volatile("s_waitcnt lgkmcnt(0)\n\ts_barrier" ::: "memory");
        { const int t = wid * 64 + fq * 16 + fr, bj = t >> 8, wr2 = (t >> 7) & 1, am = (t >> 4) & 7, fr2 = t & 15;
          const LAS float* pp = part + ((wr2 * 4 * 2 + bj) * 8 + am) * 16 + fr2;
          const float ssum = (pp[0] + pp[2 * 8 * 16]) + (pp[2 * 2 * 8 * 16] + pp[3 * 2 * 8 * 16]);
          const int row = u.pm * BM + (am >> 2) * HALF + wr2 * 64 + (am & 3) * 16 + fr2, sl = u.pn * 2 + bj;
          SS[(size_t)row * 8 + sl + (sl >= 3 ? 1 : 0)] = ssum; }
    }
};
struct EpiBf16Row {
    bf16_t* O; int ldc; const float* rs; int which;
    __device__ __forceinline__ void operator()(const f32x4 (&acc)[2][2][4][2], const Unit& u, int wr, int wc, int fr, int fq) const {
        const int row0 = u.pm * BM + wr * 64 + fr;
        float scv[8];
#pragma unroll
        for (int i = 0; i < 8; ++i) { const f32x4 s4 = *(const f32x4*)(rs + (size_t)(row0 + (i >> 2) * HALF + (i & 3) * 16) * 8); scv[i] = __builtin_amdgcn_rsqf(((s4[0] + s4[1]) + s4[2]) * (1.f / CQ) + EPS); }
#pragma unroll
        for (int ai = 0; ai < 2; ++ai)
#pragma unroll
            for (int m = 0; m < 4; ++m) { const int row = row0 + ai * HALF + m * 16; const float sc = scv[ai * 4 + m]; const int b = row >> 11, t = row & (SEQ - 1);
#pragma unroll
                for (int bj = 0; bj < 2; ++bj) { const f32x4 v0 = acc[ai][bj][m][0] * sc, v1 = acc[ai][bj][m][1] * sc;
                    u32x4 w; w.x = cvt_pk_bf16(v0[0], v0[1]); w.y = cvt_pk_bf16(v0[2], v0[3]); w.z = cvt_pk_bf16(v1[0], v1[1]); w.w = cvt_pk_bf16(v1[2], v1[3]);
                    const int col = u.pn * BM + bj * HALF + wc * 32 + 8 * fq;
                    bf16_t* dst;
                    if (which == 0) { const int hd = col / 96, d = col - hd * 96; dst = O + (((size_t)b * 16 + hd) * SEQ + t) * 96 + d; }
                    else { const int hd = col >> 7, d = col & 127;
                        dst = d < 64 ? O + (size_t)row * 1024 + hd * 64 + d : O + (size_t)NTOK * 1024 + (((size_t)b * 16 + hd) * SEQ + t) * 64 + (d - 64); }
                    *(u32x4*)dst = w; } }
    }
};
template <bool RB, bool OB, bool ST = false>
struct EpiRes {
    const void* res; void* out; bool dry; float* SS; LAS float* part;
    __device__ __forceinline__ void operator()(const f32x4 (&acc)[2][2][4][2], const Unit& u, int wr, int wc, int fr, int fq) const {
        const int row0 = u.pm * BM + wr * 64 + fr, col0 = u.pn * BM + wc * 32 + 8 * fq;
#pragma unroll
        for (int ai = 0; ai < 2; ++ai) {
            u32x4 xb_[4][2]; f32x4 xf_[4][2][2];
#pragma unroll
            for (int m = 0; m < 4; ++m)
#pragma unroll
                for (int bj = 0; bj < 2; ++bj) { const size_t o = (size_t)(row0 + ai * HALF + m * 16) * DM + col0 + bj * HALF;
                    if constexpr (RB) xb_[m][bj] = *(const u32x4*)((const bf16_t*)res + o); else { xf_[m][bj][0] = *(const f32x4*)((const float*)res + o); xf_[m][bj][1] = *(const f32x4*)((const float*)res + o + 4); } }
            __builtin_amdgcn_sched_barrier(0);
#pragma unroll
            for (int m = 0; m < 4; ++m) { const size_t off = (size_t)(row0 + ai * HALF + m * 16) * DM + col0; float ssr = 0.f;
#pragma unroll
                for (int bj = 0; bj < 2; ++bj) { const size_t o = off + bj * HALF;
                    f32x4 r0, r1;
                    if constexpr (RB) { const u32x4 x = xb_[m][bj]; r0 = (f32x4){bf_lo(x.x), bf_hi(x.x), bf_lo(x.y), bf_hi(x.y)}; r1 = (f32x4){bf_lo(x.z), bf_hi(x.z), bf_lo(x.w), bf_hi(x.w)}; }
                    else { r0 = xf_[m][bj][0]; r1 = xf_[m][bj][1]; }
                    r0 += acc[ai][bj][m][0]; r1 += acc[ai][bj][m][1];
                    if (!dry) {
                        if constexpr (OB) { u32x4 w; w.x = cvt_pk_bf16(r0[0], r0[1]); w.y = cvt_pk_bf16(r0[2], r0[3]); w.z = cvt_pk_bf16(r1[0], r1[1]); w.w = cvt_pk_bf16(r1[2], r1[3]); *(u32x4*)((bf16_t*)out + o) = w;
                            if constexpr (ST) ssr += (bf_lo(w.x) * bf_lo(w.x) + bf_hi(w.x) * bf_hi(w.x)) + (bf_lo(w.y) * bf_lo(w.y) + bf_hi(w.y) * bf_hi(w.y)) + (bf_lo(w.z) * bf_lo(w.z) + bf_hi(w.z) * bf_hi(w.z)) + (bf_lo(w.w) * bf_lo(w.w) + bf_hi(w.w) * bf_hi(w.w)); }
                        else { *(f32x4*)((float*)out + o) = r0; *(f32x4*)((float*)out + o + 4) = r1; } } }
                if constexpr (ST) { ssr = fq_sum(ssr); if (fq == 0) part[((wr * 4 + wc) * 8 + ai * 4 + m) * 16 + fr] = ssr; } }
        }
        if constexpr (ST) {
            asm volatile("s_waitcnt lgkmcnt(0)\n\ts_barrier" ::: "memory");
            const int t = (wr * 4 + wc) * 64 + fq * 16 + fr;
            if (t < 256) { const int wr2 = t >> 7, am = (t >> 4) & 7, fr2 = t & 15; const LAS float* pp = part + (wr2 * 4 * 8 + am) * 16 + fr2;
                const float ssum = (pp[0] + pp[8 * 16]) + (pp[2 * 8 * 16] + pp[3 * 8 * 16]);
                SS[(size_t)(u.pm * BM + (am >> 2) * HALF + wr2 * 64 + (am & 3) * 16 + fr2) * 4 + u.pn] = ssum; }
        }
    }
};
struct EpiSwiGLU {
    bf16_t* H; int ldc; int row_sub; const float* ss;
    __device__ __forceinline__ void operator()(const f32x4 (&acc)[2][2][4][2], const Unit& u, int wr, int wc, int fr, int fq) const {
        const int row0 = u.pm * BM - row_sub + wr * 64 + fr, col0 = u.pn * HALF + wc * 32 + 8 * fq;
        float rsv[8];
#pragma unroll
        for (int i = 0; i < 8; ++i) { const f32x4 s4 = *(const f32x4*)(ss + (size_t)(row0 + (i >> 2) * HALF + (i & 3) * 16) * 4); rsv[i] = __builtin_amdgcn_rsqf(((s4[0] + s4[1]) + (s4[2] + s4[3])) * (1.f / DM) + EPS); }
#pragma unroll
        for (int ai = 0; ai < 2; ++ai)
#pragma unroll
            for (int m = 0; m < 4; ++m) { bf16_t* rowp = H + (size_t)(row0 + ai * HALF + m * 16) * ldc + col0;
                const float rstd = rsv[ai * 4 + m];
                float r[8];
#pragma unroll
                for (int n = 0; n < 2; ++n)
#pragma unroll
                    for (int j = 0; j < 4; ++j) { const float gt = acc[ai][0][m][n][j] * rstd, up = acc[ai][1][m][n][j] * rstd;
                        r[n * 4 + j] = gt * __builtin_amdgcn_rcpf(1.0f + __builtin_amdgcn_exp2f(-gt * LOG2E)) * up; }
                u32x4 w; w.x = cvt_pk_bf16(r[0], r[1]); w.y = cvt_pk_bf16(r[2], r[3]); w.z = cvt_pk_bf16(r[4], r[5]); w.w = cvt_pk_bf16(r[6], r[7]);
                *(u32x4*)rowp = w; }
    }
};
struct EpiSwiGLU8 {
    unsigned char* H; int ldc; bool dry;
    __device__ __forceinline__ void operator()(const f32x4 (&acc)[2][2][4][2], const Unit& u, int wr, int wc, int fr, int fq) const {
        const int row0 = u.pm * BM + wr * 64 + fr, col0 = u.pn * HALF + wc * 32 + 8 * fq;
#pragma unroll
        for (int ai = 0; ai < 2; ++ai)
#pragma unroll
            for (int m = 0; m < 4; ++m) { unsigned char* rowp = H + (size_t)(row0 + ai * HALF + m * 16) * ldc + col0;
                float r[8];
#pragma unroll
                for (int n = 0; n < 2; ++n)
#pragma unroll
                    for (int j = 0; j < 4; ++j) { const float ga = acc[ai][0][m][n][j], ua = acc[ai][1][m][n][j];
                        const float e = __builtin_amdgcn_exp2f(-ga); const float q = __builtin_amdgcn_rcpf(__builtin_fmaf(e, LOG2E, LOG2E));
                        r[n * 4 + j] = __builtin_amdgcn_fmed3f((ga * ua) * q, -448.f, 448.f); }
                u32x2 w; w.x = pk4_fp8(r[0], r[1], r[2], r[3]); w.y = pk4_fp8(r[4], r[5], r[6], r[7]);
                if (!dry) *(u32x2*)rowp = w; }
    }
};
struct EpiQKV0 {
    bf16_t* O; const float* cosT; const float* sinT;
    const float* rs0;
    const float* g_aq; const float* g_ak; const float* g_bq; const float* g_bk;
    __device__ __forceinline__ void operator()(const f32x4 (&acc)[2][2][4][2], const Unit& u, int wr, int wc, int fr, int fq) const {
        const int hd = u.pn * 4 + wc;
        const float* g = hd < 8 ? g_aq : hd < 10 ? g_ak : hd < 12 ? nullptr : hd < 20 ? g_bq : hd < 28 ? g_bk : nullptr;
        const float qs = (hd < 8 || (hd >= 12 && hd < 20)) ? 0.125f * LOG2E : 1.0f;
        const int row0 = u.pm * BM + wr * 64 + fr;
        float r0v[8];
#pragma unroll
        for (int i = 0; i < 8; ++i) r0v[i] = rs0[row0 + (i >> 2) * HALF + (i & 3) * 16];
        if (g == nullptr) {
#pragma unroll
            for (int ai = 0; ai < 2; ++ai)
#pragma unroll
                for (int m = 0; m < 4; ++m) { const int row_ = row0 + ai * HALF + m * 16; bf16_t* rowp = O + (((size_t)(row_ >> 11) * 36 + hd) * SEQ + (row_ & (SEQ - 1))) * 64 + 8 * fq; const float r0 = r0v[ai * 4 + m];
#pragma unroll
                    for (int bj = 0; bj < 2; ++bj) { const f32x4 v0 = acc[ai][bj][m][0] * r0, v1 = acc[ai][bj][m][1] * r0;
                        u32x4 w; w.x = cvt_pk_bf16(v0[0], v0[1]); w.y = cvt_pk_bf16(v0[2], v0[3]); w.z = cvt_pk_bf16(v1[0], v1[1]); w.w = cvt_pk_bf16(v1[2], v1[3]);
                        *(u32x4*)(rowp + bj * 32) = w; } }
            return;
        }
        f32x4 gl[2], gh[2];
#pragma unroll
        for (int n = 0; n < 2; ++n) { gl[n] = *(const f32x4*)(g + 8 * fq + 4 * n); gh[n] = *(const f32x4*)(g + 32 + 8 * fq + 4 * n); }
        f32x4 ctb[2][2], stb[2][2];
#pragma unroll
        for (int n = 0; n < 2; ++n) { ctb[0][n] = *(const f32x4*)(cosT + (size_t)row0 * 32 + 8 * fq + 4 * n); stb[0][n] = *(const f32x4*)(sinT + (size_t)row0 * 32 + 8 * fq + 4 * n); }
#pragma unroll
        for (int ai = 0; ai < 2; ++ai)
#pragma unroll
            for (int m = 0; m < 4; ++m) {
                const int row = row0 + ai * HALF + m * 16, cb_ = (ai * 4 + m) & 1;
                if (ai * 4 + m < 7) { const int nr = row0 + ((ai * 4 + m + 1) >> 2) * HALF + ((ai * 4 + m + 1) & 3) * 16;
#pragma unroll
                    for (int n = 0; n < 2; ++n) { ctb[cb_ ^ 1][n] = *(const f32x4*)(cosT + (size_t)nr * 32 + 8 * fq + 4 * n); stb[cb_ ^ 1][n] = *(const f32x4*)(sinT + (size_t)nr * 32 + 8 * fq + 4 * n); } }
                __builtin_amdgcn_sched_barrier(0);
                float ss = 0.f;
#pragma unroll
                for (int bj = 0; bj < 2; ++bj)
#pragma unroll
                    for (int n = 0; n < 2; ++n) { const f32x4 x = acc[ai][bj][m][n]; ss += (x[0] * x[0] + x[1] * x[1]) + (x[2] * x[2] + x[3] * x[3]); }
                ss = fq_sum(ss);
                const float r0 = r0v[ai * 4 + m]; const float rstd = r0 * __builtin_amdgcn_rsqf(ss * (r0 * r0) * (1.0f / 64.0f) + EPS);
                float lo[8], hi[8];
#pragma unroll
                for (int n = 0; n < 2; ++n) { const f32x4 c = ctb[cb_][n], s = stb[cb_][n];
#pragma unroll
                    for (int j = 0; j < 4; ++j) { const float a = acc[ai][0][m][n][j] * rstd * gl[n][j], b = acc[ai][1][m][n][j] * rstd * gh[n][j];
                        lo[n * 4 + j] = (a * c[j] - b * s[j]) * qs; hi[n * 4 + j] = (b * c[j] + a * s[j]) * qs; } }
                bf16_t* rowp = O + (((size_t)(row >> 11) * 36 + hd) * SEQ + (row & (SEQ - 1))) * 64 + 8 * fq;
                u32x4 w; w.x = cvt_pk_bf16(lo[0], lo[1]); w.y = cvt_pk_bf16(lo[2], lo[3]); w.z = cvt_pk_bf16(lo[4], lo[5]); w.w = cvt_pk_bf16(lo[6], lo[7]);
                *(u32x4*)rowp = w;
                w.x = cvt_pk_bf16(hi[0], hi[1]); w.y = cvt_pk_bf16(hi[2], hi[3]); w.z = cvt_pk_bf16(hi[4], hi[5]); w.w = cvt_pk_bf16(hi[6], hi[7]);
                *(u32x4*)(rowp + 32) = w;
            }
    }
};
struct EpiKV1 {
    bf16_t* Ko; bf16_t* Vo; const float* rs; const bf16_t* P1; const float* cc; const float* sc; const float* gk;
    __device__ __forceinline__ void operator()(const f32x4 (&acc)[2][2][4][2], const Unit& u, int wr, int wc, int fr, int fq) const {
        const int hd = 2 * u.pn + (wc & 1);
        const int row0 = u.pm * BM + wr * 64 + fr;
        float sv[8];
#pragma unroll
        for (int i = 0; i < 8; ++i) { const f32x2 s2 = *(const f32x2*)(rs + (size_t)(row0 + (i >> 2) * HALF + (i & 3) * 16) * 8 + 4); sv[i] = __builtin_amdgcn_rsqf((s2[0] + s2[1]) * (1.f / CKV) + EPS); }
        if (wc >= 2) {
#pragma unroll
            for (int ai = 0; ai < 2; ++ai)
#pragma unroll
                for (int m = 0; m < 4; ++m) { const int row = row0 + ai * HALF + m * 16; const float s = sv[ai * 4 + m];
                    bf16_t* dst = Vo + (((size_t)(row >> 11) * 16 + hd) * SEQ + (row & (SEQ - 1))) * 64 + 8 * fq;
#pragma unroll
                    for (int bj = 0; bj < 2; ++bj) { const f32x4 v0 = acc[ai][bj][m][0] * s, v1 = acc[ai][bj][m][1] * s;
                        u32x4 w; w.x = cvt_pk_bf16(v0[0], v0[1]); w.y = cvt_pk_bf16(v0[2], v0[3]); w.z = cvt_pk_bf16(v1[0], v1[1]); w.w = cvt_pk_bf16(v1[2], v1[3]);
                        *(u32x4*)(dst + bj * 32) = w; } }
            return;
        }
        f32x4 gl[2], gh[2];
#pragma unroll
        for (int n = 0; n < 2; ++n) { gl[n] = *(const f32x4*)(gk + 8 * fq + 4 * n); gh[n] = *(const f32x4*)(gk + 32 + 8 * fq + 4 * n); }
        const f32x4 gr0 = *(const f32x4*)(gk + 64 + 4 * fq), gr1 = *(const f32x4*)(gk + 80 + 4 * fq);
#pragma unroll
        for (int ai2 = 0; ai2 < 4; ++ai2) { const int ai = ai2 >> 1, mh = ai2 & 1;
            u32x2 kr0v[2], kr1v[2]; f32x4 csv[2], snv[2];
#pragma unroll
            for (int m2 = 0; m2 < 2; ++m2) { const int row = row0 + ai * HALF + (2 * mh + m2) * 16; const bf16_t* kp = P1 + (size_t)row * L1_INP + CQ + CKV + 4 * fq;
                kr0v[m2] = *(const u32x2*)kp; kr1v[m2] = *(const u32x2*)(kp + 16); csv[m2] = *(const f32x4*)(cc + (size_t)row * 16 + 4 * fq); snv[m2] = *(const f32x4*)(sc + (size_t)row * 16 + 4 * fq); }
            __builtin_amdgcn_sched_barrier(0);
#pragma unroll
            for (int m2 = 0; m2 < 2; ++m2) { const int m = 2 * mh + m2;
                const int row = row0 + ai * HALF + m * 16; const float s = sv[ai * 4 + m];
                const u32x2 kr0 = kr0v[m2], kr1 = kr1v[m2];
                const f32x4 cs = csv[m2], sn = snv[m2];
                const f32x4 ra = (f32x4){bf_lo(kr0.x), bf_hi(kr0.x), bf_lo(kr0.y), bf_hi(kr0.y)}, rb = (f32x4){bf_lo(kr1.x), bf_hi(kr1.x), bf_lo(kr1.y), bf_hi(kr1.y)};
                float ss = (ra[0] * ra[0] + ra[1] * ra[1]) + (ra[2] * ra[2] + ra[3] * ra[3]) + (rb[0] * rb[0] + rb[1] * rb[1]) + (rb[2] * rb[2] + rb[3] * rb[3]);
#pragma unroll
                for (int bj = 0; bj < 2; ++bj)
#pragma unroll
                    for (int n = 0; n < 2; ++n) { const f32x4 x = acc[ai][bj][m][n] * s; ss += (x[0] * x[0] + x[1] * x[1]) + (x[2] * x[2] + x[3] * x[3]); }
                ss = fq_sum(ss);
                const float rstd = __builtin_amdgcn_rsqf(ss * (1.0f / 96.0f) + EPS), rl = rstd * s;
                bf16_t* dst = Ko + (((size_t)(row >> 11) * 16 + hd) * SEQ + (row & (SEQ - 1))) * 96;
                { const f32x4 a0 = acc[ai][0][m][0] * rl * gl[0], a1 = acc[ai][0][m][1] * rl * gl[1], b0 = acc[ai][1][m][0] * rl * gh[0], b1 = acc[ai][1][m][1] * rl * gh[1];
                  u32x4 w; w.x = cvt_pk_bf16(a0[0], a0[1]); w.y = cvt_pk_bf16(a0[2], a0[3]); w.z = cvt_pk_bf16(a1[0], a1[1]); w.w = cvt_pk_bf16(a1[2], a1[3]);
                  *(u32x4*)(dst + 8 * fq) = w;
                  w.x = cvt_pk_bf16(b0[0], b0[1]); w.y = cvt_pk_bf16(b0[2], b0[3]); w.z = cvt_pk_bf16(b1[0], b1[1]); w.w = cvt_pk_bf16(b1[2], b1[3]);
                  *(u32x4*)(dst + 32 + 8 * fq) = w; }
                { const f32x4 a = ra * rstd * gr0, b = rb * rstd * gr1; const f32x4 oa = a * cs - b * sn, ob = b * cs + a * sn;
                  u32x2 p; p.x = cvt_pk_bf16(oa[0], oa[1]); p.y = cvt_pk_bf16(oa[2], oa[3]); *(u32x2*)(dst + 64 + 4 * fq) = p;
                  p.x = cvt_pk_bf16(ob[0], ob[1]); p.y = cvt_pk_bf16(ob[2], ob[3]); *(u32x2*)(dst + 80 + 4 * fq) = p; }
            }
        }
    }
};
}

__device__ __forceinline__ void dma_piece(__amdgpu_buffer_rsrc_t rs, unsigned lds_dst, unsigned voff, unsigned soff) {
    asm volatile("s_mov_b32 m0, %0\n\ts_nop 0\n\tbuffer_load_dwordx4 %1, %2, %3 offen lds" :: "s"(lds_dst), "v"(voff), "s"(rs), "s"(soff) : "m0", "memory");
}
__device__ __forceinline__ int crow(int r, int hi) { return (r & 3) + 8 * (r >> 2) + 4 * hi; }
typedef short v4i16_t __attribute__((ext_vector_type(4)));
__device__ __forceinline__ s16x4 vtr(LAS unsigned char* p) { return __builtin_bit_cast(s16x4, __builtin_amdgcn_ds_read_tr16_b64_v4i16((LAS v4i16_t*)p)); }
constexpr float ATT_THR = 8.0f, ATT_FIX_BOUND = 60.0f;
template <int DQK, bool TWO, bool FIXREF>
__device__ __forceinline__ void attn_step(LAS unsigned char* kp0, LAS unsigned char* kp1, int ke0, int ke1, LAS unsigned char* vp0, LAS unsigned char* vp1, int vd0,
                                          const bf16x8 (&qf)[DQK / 16], f32x16& negm, float& mref, float& l, f32x16& o0, f32x16& o1,
                                          bool mask0, bool mask1, int qidx, int kidx0, int maxd, int hi) {
    f32x16 s0, s1;
    const f32x16 zf = (f32x16){0.f, 0.f, 0.f, 0.f, 0.f, 0.f, 0.f, 0.f, 0.f, 0.f, 0.f, 0.f, 0.f, 0.f, 0.f, 0.f};
    if constexpr (FIXREF) { s1 = zf; } else { s0 = negm; s1 = negm; }
    bf16x8 kfa[DQK / 16];
#pragma unroll
    for (int kk = 0; kk < DQK / 16; ++kk) kfa[kk] = *(const LAS bf16x8*)(kp0 + (kk >> 1) * 1024 + ((kk & 1) ? ke1 : ke0));
#pragma unroll
    for (int kk = 0; kk < DQK / 16; ++kk) s0 = __builtin_amdgcn_mfma_f32_32x32x16_bf16(kfa[kk], qf[kk], (FIXREF && kk == 0) ? zf : s0, 0, 0, 0);
    if constexpr (TWO) {
#pragma unroll
        for (int kk = 0; kk < DQK / 16; ++kk) kfa[kk] = *(const LAS bf16x8*)(kp1 + (kk >> 1) * 1024 + ((kk & 1) ? ke1 : ke0));
#pragma unroll
        for (int kk = 0; kk < DQK / 16; ++kk) s1 = __builtin_amdgcn_mfma_f32_32x32x16_bf16(kfa[kk], qf[kk], (FIXREF && kk == 0) ? zf : s1, 0, 0, 0);
    }
    if (mask0) {
#pragma unroll
        for (int r = 0; r < 16; ++r) { const int d = qidx - (kidx0 + crow(r, hi)); if (d < 0 || d > maxd) s0[r] = -INFINITY; }
    }
    if constexpr (TWO) { if (mask1) {
#pragma unroll
        for (int r = 0; r < 16; ++r) { const int d = qidx - (kidx0 + 32 + crow(r, hi)); if (d < 0 || d > maxd) s1[r] = -INFINITY; }
    } }
    if constexpr (!FIXREF) {
    float rm = fmaxf(fmaxf(s0[0], s0[1]), fmaxf(s0[2], s0[3]));
#pragma unroll
    for (int r = 4; r < 16; r += 4) rm = fmaxf(rm, fmaxf(fmaxf(s0[r], s0[r + 1]), fmaxf(s0[r + 2], s0[r + 3])));
    if constexpr (TWO) {
#pragma unroll
        for (int r = 0; r < 16; r += 4) rm = fmaxf(rm, fmaxf(fmaxf(s1[r], s1[r + 1]), fmaxf(s1[r + 2], s1[r + 3])));
    }
    rm = swap32_max(rm);
    if (__builtin_expect(__any(rm > ATT_THR), 0)) {
        const float dl = fmaxf(rm, 0.f); mref += dl;
#pragma unroll
        for (int r = 0; r < 16; ++r) { s0[r] -= dl; negm[r] -= dl; if constexpr (TWO) s1[r] -= dl; }
        const float f = __builtin_amdgcn_exp2f(-dl); l *= f;
#pragma unroll
        for (int r = 0; r < 16; ++r) { o0[r] *= f; o1[r] *= f; }
    }
    }
    float ps = 0.f;
#pragma unroll
    for (int r = 0; r < 16; ++r) { s0[r] = __builtin_amdgcn_exp2f(s0[r]); ps += s0[r]; }
    if constexpr (TWO) {
#pragma unroll
        for (int r = 0; r < 16; ++r) { s1[r] = __builtin_amdgcn_exp2f(s1[r]); ps += s1[r]; }
    }
    l += ps;
    {
        u32x4 pw0, pw1;
        pw0.x = cvt_pk_bf16(s0[0], s0[1]); pw0.y = cvt_pk_bf16(s0[2], s0[3]); pw0.z = cvt_pk_bf16(s0[4], s0[5]); pw0.w = cvt_pk_bf16(s0[6], s0[7]);
        pw1.x = cvt_pk_bf16(s0[8], s0[9]); pw1.y = cvt_pk_bf16(s0[10], s0[11]); pw1.z = cvt_pk_bf16(s0[12], s0[13]); pw1.w = cvt_pk_bf16(s0[14], s0[15]);
        const bf16x8 pf0 = __builtin_bit_cast(bf16x8, pw0), pf1 = __builtin_bit_cast(bf16x8, pw1);
#pragma unroll
        for (int ks = 0; ks < 2; ++ks) {
            const s16x4 a0 = vtr(vp0 + ks * 1024), a1 = vtr(vp0 + ks * 1024 + 512);
            const s16x4 b0 = vtr(vp0 + vd0 + ks * 1024), b1 = vtr(vp0 + vd0 + ks * 1024 + 512);
            const bf16x8 va = (bf16x8){a0[0], a0[1], a0[2], a0[3], a1[0], a1[1], a1[2], a1[3]};
            const bf16x8 vb = (bf16x8){b0[0], b0[1], b0[2], b0[3], b1[0], b1[1], b1[2], b1[3]};
            o0 = __builtin_amdgcn_mfma_f32_32x32x16_bf16(va, ks ? pf1 : pf0, o0, 0, 0, 0);
            o1 = __builtin_amdgcn_mfma_f32_32x32x16_bf16(vb, ks ? pf1 : pf0, o1, 0, 0, 0);
        }
    }
    if constexpr (TWO) {
        u32x4 pw0, pw1;
        pw0.x = cvt_pk_bf16(s1[0], s1[1]); pw0.y = cvt_pk_bf16(s1[2], s1[3]); pw0.z = cvt_pk_bf16(s1[4], s1[5]); pw0.w = cvt_pk_bf16(s1[6], s1[7]);
        pw1.x = cvt_pk_bf16(s1[8], s1[9]); pw1.y = cvt_pk_bf16(s1[10], s1[11]); pw1.z = cvt_pk_bf16(s1[12], s1[13]); pw1.w = cvt_pk_bf16(s1[14], s1[15]);
        const bf16x8 pf0 = __builtin_bit_cast(bf16x8, pw0), pf1 = __builtin_bit_cast(bf16x8, pw1);
#pragma unroll
        for (int ks = 0; ks < 2; ++ks) {
            const s16x4 a0 = vtr(vp1 + ks * 1024), a1 = vtr(vp1 + ks * 1024 + 512);
            const s16x4 b0 = vtr(vp1 + vd0 + ks * 1024), b1 = vtr(vp1 + vd0 + ks * 1024 + 512);
            const bf16x8 va = (bf16x8){a0[0], a0[1], a0[2], a0[3], a1[0], a1[1], a1[2], a1[3]};
            const bf16x8 vb = (bf16x8){b0[0], b0[1], b0[2], b0[3], b1[0], b1[1], b1[2], b1[3]};
            o0 = __builtin_amdgcn_mfma_f32_32x32x16_bf16(va, ks ? pf1 : pf0, o0, 0, 0, 0);
            o1 = __builtin_amdgcn_mfma_f32_32x32x16_bf16(vb, ks ? pf1 : pf0, o1, 0, 0, 0);
        }
    }
}

template <int DQK, bool ONLYB>
__device__ __forceinline__ void attn_step2(LAS unsigned char* kp, int ke0, int ke1, LAS unsigned char* vp, int vd0, const bf16x8 (&qa)[DQK / 16], const bf16x8 (&qb)[DQK / 16],
                                           float& la, float& lb, f32x16& oa0, f32x16& oa1, f32x16& ob0, f32x16& ob1, bool maska, bool maskb, int qidxa, int qidxb, int kidx0, int hi) {
    f32x16 sa, sb;
    const f32x16 zf = (f32x16){0.f, 0.f, 0.f, 0.f, 0.f, 0.f, 0.f, 0.f, 0.f, 0.f, 0.f, 0.f, 0.f, 0.f, 0.f, 0.f};
    bf16x8 kf[DQK / 16];
#pragma unroll
    for (int kk = 0; kk < DQK / 16; ++kk) kf[kk] = *(const LAS bf16x8*)(kp + (kk >> 1) * 1024 + ((kk & 1) ? ke1 : ke0));
    if constexpr (!ONLYB) sa = __builtin_amdgcn_mfma_f32_32x32x16_bf16(kf[0], qa[0], zf, 0, 0, 0);
    sb = __builtin_amdgcn_mfma_f32_32x32x16_bf16(kf[0], qb[0], zf, 0, 0, 0);
#pragma unroll
    for (int kk = 1; kk < DQK / 16; ++kk) { if constexpr (!ONLYB) sa = __builtin_amdgcn_mfma_f32_32x32x16_bf16(kf[kk], qa[kk], sa, 0, 0, 0); sb = __builtin_amdgcn_mfma_f32_32x32x16_bf16(kf[kk], qb[kk], sb, 0, 0, 0); }
    if constexpr (!ONLYB) { if (maska) {
#pragma unroll
        for (int r = 0; r < 16; ++r) { if (qidxa - (kidx0 + crow(r, hi)) < 0) sa[r] = -INFINITY; }
    } }
    if (maskb) {
#pragma unroll
        for (int r = 0; r < 16; ++r) { if (qidxb - (kidx0 + crow(r, hi)) < 0) sb[r] = -INFINITY; }
    }
    s16x4 vfr[2][4];
#pragma unroll
    for (int ks = 0; ks < 2; ++ks) { vfr[ks][0] = vtr(vp + ks * 1024); vfr[ks][1] = vtr(vp + ks * 1024 + 512); vfr[ks][2] = vtr(vp + vd0 + ks * 1024); vfr[ks][3] = vtr(vp + vd0 + ks * 1024 + 512); }
    __builtin_amdgcn_sched_barrier(0);
    float pa = 0.f, pb = 0.f;
#pragma unroll
    for (int r = 0; r < 16; ++r) { if constexpr (!ONLYB) { sa[r] = __builtin_amdgcn_exp2f(sa[r]); pa += sa[r]; } sb[r] = __builtin_amdgcn_exp2f(sb[r]); pb += sb[r]; }
    la += pa; lb += pb;
    u32x4 wa0 = (u32x4){0u, 0u, 0u, 0u}, wa1 = wa0, wb0, wb1;
    if constexpr (!ONLYB) {
        wa0.x = cvt_pk_bf16(sa[0], sa[1]); wa0.y = cvt_pk_bf16(sa[2], sa[3]); wa0.z = cvt_pk_bf16(sa[4], sa[5]); wa0.w = cvt_pk_bf16(sa[6], sa[7]);
        wa1.x = cvt_pk_bf16(sa[8], sa[9]); wa1.y = cvt_pk_bf16(sa[10], sa[11]); wa1.z = cvt_pk_bf16(sa[12], sa[13]); wa1.w = cvt_pk_bf16(sa[14], sa[15]); }
    wb0.x = cvt_pk_bf16(sb[0], sb[1]); wb0.y = cvt_pk_bf16(sb[2], sb[3]); wb0.z = cvt_pk_bf16(sb[4], sb[5]); wb0.w = cvt_pk_bf16(sb[6], sb[7]);
    wb1.x = cvt_pk_bf16(sb[8], sb[9]); wb1.y = cvt_pk_bf16(sb[10], sb[11]); wb1.z = cvt_pk_bf16(sb[12], sb[13]); wb1.w = cvt_pk_bf16(sb[14], sb[15]);
#pragma unroll
    for (int ks = 0; ks < 2; ++ks) {
        const s16x4 a0 = vfr[ks][0], a1 = vfr[ks][1], b0 = vfr[ks][2], b1 = vfr[ks][3];
        const bf16x8 va = (bf16x8){a0[0], a0[1], a0[2], a0[3], a1[0], a1[1], a1[2], a1[3]};
        const bf16x8 vb = (bf16x8){b0[0], b0[1], b0[2], b0[3], b1[0], b1[1], b1[2], b1[3]};
        const bf16x8 pfa = __builtin_bit_cast(bf16x8, ks ? wa1 : wa0), pfb = __builtin_bit_cast(bf16x8, ks ? wb1 : wb0);
        if constexpr (!ONLYB) oa0 = __builtin_amdgcn_mfma_f32_32x32x16_bf16(va, pfa, oa0, 0, 0, 0);
        ob0 = __builtin_amdgcn_mfma_f32_32x32x16_bf16(va, pfb, ob0, 0, 0, 0);
        if constexpr (!ONLYB) oa1 = __builtin_amdgcn_mfma_f32_32x32x16_bf16(vb, pfa, oa1, 0, 0, 0);
        ob1 = __builtin_amdgcn_mfma_f32_32x32x16_bf16(vb, pfb, ob1, 0, 0, 0);
    }
}

constexpr int OST_ROW = 144, OST_WAVE = 32 * OST_ROW;
__device__ __forceinline__ void ostage_write(LAS unsigned char* st, const f32x16& o0, const f32x16& o1, float sc, int r32, int hi) {
#pragma unroll
    for (int g4 = 0; g4 < 4; ++g4) { u32x2 a, b2; a.x = cvt_pk_bf16(o0[4 * g4] * sc, o0[4 * g4 + 1] * sc); a.y = cvt_pk_bf16(o0[4 * g4 + 2] * sc, o0[4 * g4 + 3] * sc);
        b2.x = cvt_pk_bf16(o1[4 * g4] * sc, o1[4 * g4 + 1] * sc); b2.y = cvt_pk_bf16(o1[4 * g4 + 2] * sc, o1[4 * g4 + 3] * sc);
        *(LAS u32x2*)(st + r32 * OST_ROW + (8 * g4 + 4 * hi) * 2) = a; *(LAS u32x2*)(st + r32 * OST_ROW + (32 + 8 * g4 + 4 * hi) * 2) = b2; }
}
struct Args {
    const float* in[28]; float* out; unsigned char* ws; int ph_lo, ph_hi; unsigned probe; int pad;
};
struct Frame {
    LAS unsigned char* lds; int wave, G, bid;
    unsigned char* ws; float* out; const float* const* in;
};
enum { I_X = 0, I_POS, I_L0_ATTN_NORM, I_L0_W_IN, I_L0_A_QN, I_L0_A_KN, I_L0_A_SINKS, I_L0_B_QN, I_L0_B_KN, I_L0_W_OUT, I_L0_FFN_NORM, I_L0_W_GATE, I_L0_W_UP, I_L0_W_DOWN,
       I_L1_ATTN_NORM, I_L1_W_IN, I_L1_QA_NORM, I_L1_W_UQ, I_L1_KVA_NORM, I_L1_W_UKV, I_L1_C_QN, I_L1_C_KN, I_L1_W_OUT, I_L1_FFN_NORM, I_L1_ROUTER, I_L1_WE_GATE, I_L1_WE_UP, I_L1_WE_DOWN };

__device__ __forceinline__ void cvt_item(const float* W, int ldw, int srccol0  , const float* kgain, bf16_t* Bt, int K, int dstrow0, bool perm, int k0, LAS float* scr, int lane) {
#pragma unroll
    for (int i = 0; i < 8; ++i) { const int kk = 8 * i + (lane >> 3), c4 = (lane & 7) * 4; f32x4 v = (f32x4){0.f, 0.f, 0.f, 0.f};
        if (srccol0 >= 0) { v = *(const f32x4*)(W + (size_t)(k0 + kk) * ldw + srccol0 + c4); if (kgain) v = v * kgain[k0 + kk]; }
        scr[kk * 33 + c4] = v[0]; scr[kk * 33 + c4 + 1] = v[1]; scr[kk * 33 + c4 + 2] = v[2]; scr[kk * 33 + c4 + 3] = v[3]; }
    LDS_WAIT(); asm volatile("" ::: "memory");
    const int c = lane & 7;
#pragma unroll
    for (int j = 0; j < 4; ++j) { const int rho = (lane >> 3) + 8 * j; const int sc = perm ? pg8::perm32(rho) : rho; const LAS float* s = scr + (8 * c) * 33 + sc;
        u32x4 o; o.x = cvt_pk_bf16(s[0 * 33], s[1 * 33]); o.y = cvt_pk_bf16(s[2 * 33], s[3 * 33]); o.z = cvt_pk_bf16(s[4 * 33], s[5 * 33]); o.w = cvt_pk_bf16(s[6 * 33], s[7 * 33]);
        *(u32x4*)(Bt + (size_t)(dstrow0 + rho) * K + k0 + 8 * c) = o; }
    LDS_WAIT(); asm volatile("" ::: "memory");
}
__device__ __forceinline__ void cvt_item8(const float* W, int ldw, int srccol0, unsigned char* Bt, int K, int dstrow0, bool perm, int k0, float scale, LAS float* scr, int lane) {
#pragma unroll
    for (int i = 0; i < 8; ++i) { const int kk = 8 * i + (lane >> 3), c4 = (lane & 7) * 4; const f32x4 v = *(const f32x4*)(W + (size_t)(k0 + kk) * ldw + srccol0 + c4) * scale;
        scr[kk * 33 + c4] = v[0]; scr[kk * 33 + c4 + 1] = v[1]; scr[kk * 33 + c4 + 2] = v[2]; scr[kk * 33 + c4 + 3] = v[3]; }
    LDS_WAIT(); asm volatile("" ::: "memory");
    const int rho = lane >> 1, kh = (lane & 1) * 32; const int sc = perm ? pg8::perm32(rho) : rho; const LAS float* s = scr + kh * 33 + sc;
    u32x4 o0, o1;
    o0.x = pk4_fp8(s[0 * 33], s[1 * 33], s[2 * 33], s[3 * 33]); o0.y = pk4_fp8(s[4 * 33], s[5 * 33], s[6 * 33], s[7 * 33]); o0.z = pk4_fp8(s[8 * 33], s[9 * 33], s[10 * 33], s[11 * 33]); o0.w = pk4_fp8(s[12 * 33], s[13 * 33], s[14 * 33], s[15 * 33]);
    o1.x = pk4_fp8(s[16 * 33], s[17 * 33], s[18 * 33], s[19 * 33]); o1.y = pk4_fp8(s[20 * 33], s[21 * 33], s[22 * 33], s[23 * 33]); o1.z = pk4_fp8(s[24 * 33], s[25 * 33], s[26 * 33], s[27 * 33]); o1.w = pk4_fp8(s[28 * 33], s[29 * 33], s[30 * 33], s[31 * 33]);
    unsigned char* dp = Bt + (size_t)(dstrow0 + rho) * K + k0 + kh;
    *(u32x4*)dp = o0; *(u32x4*)(dp + 16) = o1;
    LDS_WAIT(); asm volatile("" ::: "memory");
}
__device__ __forceinline__ void p0_weights(const Frame& F) {
    const int lane_ = lane_id_v(), tid_ = F.wave * 64 + lane_; (void)tid_;
    LAS float* scr = (LAS float*)(F.lds + F.wave * 16384);
    const int gw = F.bid * 8 + F.wave, NGW = F.G * 8;
    constexpr int N0 = (L0_IN / 32) * (DM / 64);
    constexpr int N1 = (DM / 32) * (DM / 64);
    constexpr int N2 = (2 * DFF / 32) * (DM / 64);
    constexpr int N3 = (DM / 32) * (DFF / 64);
    constexpr int N4 = (L1_INP / 32) * (DM / 64);
    constexpr int N5 = (NUQ / 32) * (CQ / 64);
    constexpr int N6 = (NUKV / 32) * (CKV / 64);
    constexpr int N7 = N1;
    constexpr int N8 = NEXP * (2 * DFE / 32) * (DM / 64);
    constexpr int N9 = NEXP * (DM / 32) * (DFE / 64);
    constexpr int NT = N0 + N1 + N2 + N3 + N4 + N5 + N6 + N7 + N8 + N9;
    unsigned char* ws = F.ws;
    for (int it = gw; it < NT; it += NGW) {
        int r = it;
        if (r < N0) { const int g = r % (L0_IN / 32), kb = r / (L0_IN / 32); const int pn = g >> 3, bj = (g >> 2) & 1, wc = g & 3;
            cvt_item(F.in[I_L0_W_IN], L0_IN, pn * 256 + wc * 64 + bj * 32, F.in[I_L0_ATTN_NORM], (bf16_t*)(ws + W0_IN), DM, g * 32, true, kb * 64, scr, lane_); continue; } r -= N0;
        if (r < N1) { const int g = r % (DM / 32), kb = r / (DM / 32);
            cvt_item(F.in[I_L0_W_OUT], DM, g * 32, nullptr, (bf16_t*)(ws + W0_OUT), DM, g * 32, true, kb * 64, scr, lane_); continue; } r -= N1;
        if (r < N2) { const int g = r % (2 * DFF / 32), kb = r / (2 * DFF / 32); const int pn = g >> 3, bj = (g >> 2) & 1, wc = g & 3;
            cvt_item(bj ? F.in[I_L0_W_UP] : F.in[I_L0_W_GATE], DFF, pn * 128 + wc * 32, F.in[I_L0_FFN_NORM], (bf16_t*)(ws + W0_GU), DM, g * 32, true, kb * 64, scr, lane_); continue; } r -= N2;
        if (r < N3) { const int g = r % (DM / 32), kb = r / (DM / 32);
            cvt_item(F.in[I_L0_W_DOWN], DM, g * 32, nullptr, (bf16_t*)(ws + W0_DN), DFF, g * 32, true, kb * 64, scr, lane_); continue; } r -= N3;
        if (r < N4) { const int g = r % (L1_INP / 32), kb = r / (L1_INP / 32);
            cvt_item(F.in[I_L1_W_IN], 672, g < 21 ? g * 32 : -1, F.in[I_L1_ATTN_NORM], (bf16_t*)(ws + W1_IN), DM, g * 32, true, kb * 64, scr, lane_); continue; } r -= N4;
        if (r < N5) { const int g = r % (NUQ / 32), kb = r / (NUQ / 32);
            cvt_item(F.in[I_L1_W_UQ], NUQ, g * 32, F.in[I_L1_QA_NORM], (bf16_t*)(ws + W1_UQ), CQ, g * 32, true, kb * 64, scr, lane_); continue; } r -= N5;
        if (r < N6) { const int g = r % (NUKV / 32), kb = r / (NUKV / 32); const int pn = g >> 3, bj = (g >> 2) & 1, wc = g & 3;
            cvt_item(F.in[I_L1_W_UKV], NUKV, (2 * pn + (wc & 1)) * 128 + (wc >> 1) * 64 + bj * 32, F.in[I_L1_KVA_NORM], (bf16_t*)(ws + W1_UKV), CKV, g * 32, true, kb * 64, scr, lane_); continue; } r -= N6;
        if (r < N7) { const int g = r % (DM / 32), kb = r / (DM / 32);
            cvt_item(F.in[I_L1_W_OUT], DM, g * 32, nullptr, (bf16_t*)(ws + W1_OUT), DM, g * 32, true, kb * 64, scr, lane_); continue; } r -= N7;
        if (r < N8) { constexpr int PE = (2 * DFE / 32) * (DM / 64); const int e = r / PE, q = r % PE; const int g = q % (2 * DFE / 32), kb = q / (2 * DFE / 32); const int pn = g >> 3, bj = (g >> 2) & 1, wc = g & 3;
            cvt_item8((bj ? F.in[I_L1_WE_UP] : F.in[I_L1_WE_GATE]) + (size_t)e * DM * DFE, DFE, pn * 128 + wc * 32, (unsigned char*)(ws + WE_GU) + (size_t)e * 2 * DFE * DM, DM, g * 32, true, kb * 64, bj ? WGU_SCALE : WGU_SCALE * LOG2E, scr, lane_); continue; } r -= N8;
        { constexpr int PE = (DM / 32) * (DFE / 64); const int e = r / PE, q = r % PE; const int g = q % (DM / 32), kb = q / (DM / 32);
            cvt_item8(F.in[I_L1_WE_DOWN] + (size_t)e * DFE * DM, DM, g * 32, (unsigned char*)(ws + WE_DN) + (size_t)e * DM * DFE, DFE, g * 32, true, kb * 64, WDN_SCALE, scr, lane_); }
    }
}
__device__ __forceinline__ void p0_rope(const Frame& F) {
    const int lane_ = lane_id_v(), tid_ = F.wave * 64 + lane_; (void)tid_;
    const int* pos = (const int*)F.in[I_POS];
    float* ch = (float*)(F.ws + WS_ROPEH); float* sh = ch + (size_t)NTOK * 32;
    float* cc = (float*)(F.ws + WS_ROPEC); float* sc = cc + (size_t)NTOK * 16;
    const size_t stride = (size_t)F.G * 512;
    const int f = tid_ & 31;
    const float inv = powf(10000.0f, -(float)(2 * f) / 64.0f), inv2 = powf(10000.0f, -(float)(2 * (f & 15)) / 32.0f);
    for (size_t i = (size_t)F.bid * 512 + tid_; i < (size_t)NTOK * 32; i += stride) {
        const int t = (int)(i >> 5); const float p = (float)pos[t];
        float s, c; sincosf(p * inv, &s, &c); ch[i] = c; sh[i] = s;
        if (f < 16) { sincosf(p * inv2, &s, &c); cc[(size_t)t * 16 + f] = c; sc[(size_t)t * 16 + f] = s; }
    }
}
__device__ __forceinline__ void x_rows(const Frame& F, const float* src, bf16_t* dst, float* rs0) {
    const int lane_ = lane_id_v();
    const int gw = F.bid * 8 + F.wave, NGW = F.G * 8;
    for (int m = gw * 4; m < NTOK; m += NGW * 4) {
        f32x4 v[4][4]; float s[4];
#pragma unroll
        for (int r = 0; r < 4; ++r) { const f32x4* xr = (const f32x4*)(src + (size_t)(m + r) * DM) + lane_;
#pragma unroll
            for (int j = 0; j < 4; ++j) v[r][j] = xr[64 * j]; }
#pragma unroll
        for (int r = 0; r < 4; ++r) { s[r] = 0.f;
#pragma unroll
            for (int j = 0; j < 4; ++j) s[r] += (v[r][j].x * v[r][j].x + v[r][j].y * v[r][j].y) + (v[r][j].z * v[r][j].z + v[r][j].w * v[r][j].w); }
#pragma unroll
        for (int r = 0; r < 4; ++r) {
            const float rstd = __builtin_amdgcn_rsqf(wave_sum(s[r]) * (1.f / DM) + EPS);
            if (lane_ == 0) rs0[m + r] = rstd;
            u32x2* o8 = (u32x2*)(dst + (size_t)(m + r) * DM) + lane_;
#pragma unroll
            for (int j = 0; j < 4; ++j) { u32x2 w; w.x = cvt_pk_bf16(v[r][j].x, v[r][j].y); w.y = cvt_pk_bf16(v[r][j].z, v[r][j].w); o8[64 * j] = w; }
        }
    }
}

constexpr int BK_ROWS = 384, BK_VOFF = BK_ROWS * 128, BK_VD0 = BK_ROWS * 64;
struct BandItem { int b, qcol, kcol, vcol, dil, cls0, cls1, tq0, tq1, maxd, mode  , outcol, pidx, head; float sink; bool has_sink, split_rows; };
template <bool FIXREF>
__device__ __forceinline__ void band_item(const Frame& F, const BandItem it) {
    const int lane_ = lane_id_v();
    const bf16_t* P = (const bf16_t*)(F.ws + WS_PROJ0);
    LAS unsigned char* lds = F.lds;
    const int lane = lane_, w = F.wave, hq = w >> 2, wq = w & 3, hi = lane >> 5, r32 = lane & 31;
    const size_t tokbase = (size_t)it.b * SEQ;
    {
        const __amdgpu_buffer_rsrc_t rsP = __builtin_amdgcn_make_buffer_rsrc((void*)(P + tokbase * L0_IN), (short)0, SEQ * L0_IN * 2, 0x00020000);
        const int k16 = lane >> 2, pc = lane & 3;
        const unsigned vok = (unsigned)(k16 * it.dil * 128 + (pc ^ ((k16 >> 2) & 3)) * 16), vov = (unsigned)(k16 * it.dil * 128 + pc * 16);
#pragma unroll 1
        for (int i = 0; i < 12; ++i) {
            const int p = w + 8 * i; const bool isv = p >= 48; const int j = isv ? p - 48 : p;
            const int kg = isv ? j % 24 : j >> 1, sub = isv ? j / 24 : j & 1;
            const int R0 = kg * 16; const bool second = it.split_rows && R0 >= 256;
            const int kidx = second ? R0 - 256 : it.tq0 - 128 + R0; const int cls = second ? it.cls1 : it.cls0;
            if (kidx >= 0 && kidx < SEQ / it.dil) {
                const unsigned so = (unsigned)((((isv ? it.vcol : it.kcol) >> 6) * SEQ + cls + it.dil * kidx) * 128 + sub * 64);
                dma_piece(rsP, (unsigned)(uintptr_t)lds + (unsigned)(isv ? BK_VOFF + j * 1024 : p * 1024), isv ? vov : vok, so);
            }
        }
    }
    const int tq = hq ? it.tq1 : it.tq0, cls = hq ? it.cls1 : it.cls0;
    const int qidx0 = tq + 32 * wq, qidx = qidx0 + r32;
    const size_t qtok = tokbase + cls + (size_t)it.dil * qidx;
    bf16x8 qf[4];
#pragma unroll
    for (int kk = 0; kk < 4; ++kk) qf[kk] = *(const bf16x8*)(P + (((size_t)it.b * 36 + (it.qcol >> 6)) * SEQ + cls + (size_t)it.dil * qidx) * 64 + 16 * kk + 8 * hi);
    float m = it.has_sink ? it.sink : 0.f, l = (it.has_sink && hi == 0) ? 1.f : 0.f;
    f32x16 o0, o1, negm;
#pragma unroll
    for (int r = 0; r < 16; ++r) { o0[r] = 0.f; o1[r] = 0.f; negm[r] = -m; }
    asm volatile("s_waitcnt vmcnt(0) lgkmcnt(0)\n\ts_barrier" ::: "memory");
    {
        const int vlane = (4 * hi + ((lane & 15) >> 2)) * 64 + ((lane >> 4) & 1) * 32 + (lane & 3) * 8;
        const int ksw = (r32 >> 2) & 3, ke0 = ((hi) ^ ksw) * 16, ke1 = ((2 + hi) ^ ksw) * 16;
#define BK_KP(kb) (lds + (8 * hq + 2 * (kb) + (r32 >> 4)) * 2048 + (r32 & 15) * 64)
#define BK_VP(kb) (lds + BK_VOFF + (128 * hq + 32 * (kb)) * 64 + vlane)
        const int kx0 = tq - 128 + 32 * wq;
        if (kx0 >= 0) {
            attn_step<64, true, FIXREF>(BK_KP(wq), BK_KP(wq + 1), ke0, ke1, BK_VP(wq), BK_VP(wq + 1), BK_VD0, qf, negm, m, l, o0, o1, true, false, qidx, kx0, it.maxd, hi);
            attn_step<64, true, FIXREF>(BK_KP(wq + 2), BK_KP(wq + 3), ke0, ke1, BK_VP(wq + 2), BK_VP(wq + 3), BK_VD0, qf, negm, m, l, o0, o1, false, false, qidx, kx0 + 64, it.maxd, hi);
            attn_step<64, false, FIXREF>(BK_KP(wq + 4), BK_KP(wq + 4), ke0, ke1, BK_VP(wq + 4), BK_VP(wq + 4), BK_VD0, qf, negm, m, l, o0, o1, true, false, qidx, kx0 + 128, it.maxd, hi);
        } else {
#pragma unroll 1
            for (int kb = 4; kb < wq + 4; ++kb) attn_step<64, false, FIXREF>(BK_KP(kb), BK_KP(kb), ke0, ke1, BK_VP(kb), BK_VP(kb), BK_VD0, qf, negm, m, l, o0, o1, false, false, qidx, tq - 128 + 32 * kb, it.maxd, hi);
            attn_step<64, false, FIXREF>(BK_KP(wq + 4), BK_KP(wq + 4), ke0, ke1, BK_VP(wq + 4), BK_VP(wq + 4), BK_VD0, qf, negm, m, l, o0, o1, true, false, qidx, kx0 + 128, it.maxd, hi);
        }
#undef BK_KP
#undef BK_VP
    }
    l = swap32_sum(l);
    const float inv = 1.0f / l;
    const float lse = m + __builtin_amdgcn_logf(l);
    LAS unsigned char* st = lds + 98304 + w * OST_WAVE;
    LAS float* wst = (LAS float*)(lds + 98304 + 8 * OST_WAVE) + w * 128;
    const int srow = lane >> 3, sch = lane & 7;
    if (it.mode != 2) {
        ostage_write(st, o0, o1, inv, r32, hi);
        asm volatile("s_waitcnt lgkmcnt(0)" ::: "memory");
        bf16_t* obase = it.mode == 0 ? (bf16_t*)(F.ws + WS_MIX) + it.outcol : (bf16_t*)(F.ws + WS_PART) + (size_t)it.pidx * NTOK * 512 + it.head * 64;
        const int opitch = it.mode == 0 ? DM : 512;
#pragma unroll
        for (int i = 0; i < 4; ++i) { const int row = 8 * i + srow; const u32x4 v = *(const LAS u32x4*)(st + row * OST_ROW + sch * 16);
            *(u32x4*)(obase + (tokbase + cls + (size_t)it.dil * (qidx0 + row)) * opitch + sch * 8) = v; }
        if (it.mode == 1 && hi == 0) ((float*)(F.ws + WS_LSE))[(size_t)it.pidx * NTOK * 8 + qtok * 8 + it.head] = lse;
    } else {
        const float* lsep = (const float*)(F.ws + WS_LSE);
        const float l1 = lsep[qtok * 8 + it.head], l2 = lsep[(size_t)NTOK * 8 + qtok * 8 + it.head];
        const float M = fmaxf(fmaxf(l1, l2), lse);
        float w0 = __builtin_amdgcn_exp2f(lse - M), w1 = __builtin_amdgcn_exp2f(l1 - M), w2 = __builtin_amdgcn_exp2f(l2 - M);
        const float wn = 1.0f / (w0 + w1 + w2); w0 *= wn; w1 *= wn; w2 *= wn;
        ostage_write(st, o0, o1, inv * w0, r32, hi);
        if (hi == 0) { wst[r32 * 4 + 1] = w1; wst[r32 * 4 + 2] = w2; }
        asm volatile("s_waitcnt lgkmcnt(0)" ::: "memory");
        const bf16_t* p1b = (const bf16_t*)(F.ws + WS_PART) + it.head * 64; const bf16_t* p2b = p1b + (size_t)NTOK * 512;
        bf16_t* obase = (bf16_t*)(F.ws + WS_MIX) + it.outcol;
#pragma unroll
        for (int i = 0; i < 4; ++i) { const int row = 8 * i + srow; const size_t tk = tokbase + cls + (size_t)it.dil * (qidx0 + row);
            const u32x4 a = *(const LAS u32x4*)(st + row * OST_ROW + sch * 16); const u32x4 x1 = *(const u32x4*)(p1b + tk * 512 + sch * 8), x2 = *(const u32x4*)(p2b + tk * 512 + sch * 8);
            const float q1 = wst[row * 4 + 1], q2 = wst[row * 4 + 2];
            u32x4 o;
            o.x = cvt_pk_bf16(bf_lo(a.x) + bf_lo(x1.x) * q1 + bf_lo(x2.x) * q2, bf_hi(a.x) + bf_hi(x1.x) * q1 + bf_hi(x2.x) * q2);
            o.y = cvt_pk_bf16(bf_lo(a.y) + bf_lo(x1.y) * q1 + bf_lo(x2.y) * q2, bf_hi(a.y) + bf_hi(x1.y) * q1 + bf_hi(x2.y) * q2);
            o.z = cvt_pk_bf16(bf_lo(a.z) + bf_lo(x1.z) * q1 + bf_lo(x2.z) * q2, bf_hi(a.z) + bf_hi(x1.z) * q1 + bf_hi(x2.z) * q2);
            o.w = cvt_pk_bf16(bf_lo(a.w) + bf_lo(x1.w) * q1 + bf_lo(x2.w) * q2, bf_hi(a.w) + bf_hi(x1.w) * q1 + bf_hi(x2.w) * q2);
            *(u32x4*)(obase + tk * DM + sch * 8) = o; }
    }
    __syncthreads();
}
__device__ __forceinline__ void band_phase(const Frame& F, int which  ) {
    const float* sinks = F.in[I_L0_A_SINKS];
    float gm[4] = {0.f, 0.f, 0.f, 0.f}, smax = 0.f;
    for (int i = 0; i < 64; ++i) { gm[0] = fmaxf(gm[0], fabsf(F.in[I_L0_A_QN][i])); gm[1] = fmaxf(gm[1], fabsf(F.in[I_L0_A_KN][i])); gm[2] = fmaxf(gm[2], fabsf(F.in[I_L0_B_QN][i])); gm[3] = fmaxf(gm[3], fabsf(F.in[I_L0_B_KN][i])); }
    for (int i = 0; i < 8; ++i) smax = fmaxf(smax, fabsf(sinks[i]));
    const bool fix = fmaxf(fmaxf(gm[0] * gm[1], gm[2] * gm[3]) * 8.0f, smax) * LOG2E < ATT_FIX_BOUND;
    const int nitems = which == 0 ? 6144 : 2048;
    for (int idx = F.bid; idx < nitems; idx += F.G) {
        BandItem it;
        const int ty = which == 0 ? idx / 2048 : 3, r = idx % 2048;
        it.b = r >> 6; const int h = (r >> 3) & 7, jp = r & 7;
        it.head = h; it.split_rows = false; it.has_sink = false; it.sink = 0.f; it.pidx = 0;
        if (ty == 0) { it.qcol = 64 * h; it.kcol = 512 + 64 * (h >> 2); it.vcol = 640 + 64 * (h >> 2); it.dil = 1; it.cls0 = it.cls1 = 0; it.tq0 = 256 * jp; it.tq1 = it.tq0 + 128; it.maxd = 127; it.mode = 0; it.outcol = 64 * h;
            it.has_sink = true; it.sink = sinks[h] * LOG2E; }
        else { it.qcol = 768 + 64 * h; it.kcol = 1280 + 64 * h; it.vcol = 1792 + 64 * h; it.maxd = 128; it.outcol = 512 + 64 * h;
            if (ty == 1) { it.dil = 1; it.cls0 = it.cls1 = 0; it.tq0 = 256 * jp; it.tq1 = it.tq0 + 128; it.mode = 1; it.pidx = 0; }
            else if (ty == 2) { it.dil = 4; it.cls0 = it.cls1 = jp >> 1; it.tq0 = 256 * (jp & 1); it.tq1 = it.tq0 + 128; it.mode = 1; it.pidx = 1; }
            else { it.dil = 16; it.cls0 = 2 * jp; it.cls1 = 2 * jp + 1; it.tq0 = 0; it.tq1 = 0; it.mode = 2; it.split_rows = true; } }
        if (fix) band_item<true>(F, it); else band_item<false>(F, it);
    }
}

constexpr int ML_KB = 12288, ML_VB = 8192, ML_STAGE = ML_KB + ML_VB;
__device__ __forceinline__ void mla_q_prep(bf16x8 (&q)[6], const float* gq, const float* cc, const float* sc, size_t t, int hi) {
    float ss = 0.f;
#pragma unroll
    for (int kk = 0; kk < 6; ++kk) { const u32x4 x = __builtin_bit_cast(u32x4, q[kk]);
        ss += bf_lo(x.x) * bf_lo(x.x) + bf_hi(x.x) * bf_hi(x.x) + bf_lo(x.y) * bf_lo(x.y) + bf_hi(x.y) * bf_hi(x.y) + bf_lo(x.z) * bf_lo(x.z) + bf_hi(x.z) * bf_hi(x.z) + bf_lo(x.w) * bf_lo(x.w) + bf_hi(x.w) * bf_hi(x.w); }
    const float rsd = __builtin_amdgcn_rsqf(swap32_sum(ss) * (1.f / 96.f) + EPS) * (0.10206207261596577f * LOG2E);
    float va[8], vb[8];
#pragma unroll
    for (int kk = 0; kk < 6; ++kk) { const u32x4 x = __builtin_bit_cast(u32x4, q[kk]);
        const f32x4 g0 = *(const f32x4*)(gq + 16 * kk + 8 * hi) * rsd, g1 = *(const f32x4*)(gq + 16 * kk + 8 * hi + 4) * rsd;
        float v[8] = {bf_lo(x.x) * g0[0], bf_hi(x.x) * g0[1], bf_lo(x.y) * g0[2], bf_hi(x.y) * g0[3], bf_lo(x.z) * g1[0], bf_hi(x.z) * g1[1], bf_lo(x.w) * g1[2], bf_hi(x.w) * g1[3]};
        if (kk < 4) { u32x4 o; o.x = cvt_pk_bf16(v[0], v[1]); o.y = cvt_pk_bf16(v[2], v[3]); o.z = cvt_pk_bf16(v[4], v[5]); o.w = cvt_pk_bf16(v[6], v[7]); q[kk] = __builtin_bit_cast(bf16x8, o); }
        else {
#pragma unroll
            for (int j = 0; j < 8; ++j) { if (kk == 4) va[j] = v[j]; else vb[j] = v[j]; } } }
    const f32x4 c0 = *(const f32x4*)(cc + t * 16 + 8 * hi), c1 = *(const f32x4*)(cc + t * 16 + 8 * hi + 4), s0 = *(const f32x4*)(sc + t * 16 + 8 * hi), s1 = *(const f32x4*)(sc + t * 16 + 8 * hi + 4);
    float ra[8], rb[8];
#pragma unroll
    for (int j = 0; j < 8; ++j) { const float c = j < 4 ? c0[j & 3] : c1[j & 3], s = j < 4 ? s0[j & 3] : s1[j & 3]; ra[j] = va[j] * c - vb[j] * s; rb[j] = vb[j] * c + va[j] * s; }
    { u32x4 o; o.x = cvt_pk_bf16(ra[0], ra[1]); o.y = cvt_pk_bf16(ra[2], ra[3]); o.z = cvt_pk_bf16(ra[4], ra[5]); o.w = cvt_pk_bf16(ra[6], ra[7]); q[4] = __builtin_bit_cast(bf16x8, o);
      o.x = cvt_pk_bf16(rb[0], rb[1]); o.y = cvt_pk_bf16(rb[2], rb[3]); o.z = cvt_pk_bf16(rb[4], rb[5]); o.w = cvt_pk_bf16(rb[6], rb[7]); q[5] = __builtin_bit_cast(bf16x8, o); }
}
template <bool FIXREF>
__device__ __forceinline__ void mla_unit(const Frame& F, int b, int h, int qb) {
    const int lane_ = lane_id_v();
    const bf16_t* Q = (const bf16_t*)(F.ws + WS_Q); const bf16_t* Kt = (const bf16_t*)(F.ws + WS_K); const bf16_t* V = (const bf16_t*)(F.ws + WS_KV);
    LAS unsigned char* lds = F.lds;
    const int lane = lane_, w = F.wave, hi = lane >> 5, r32 = lane & 31;
    const size_t tokbase = (size_t)b * SEQ;
    const int q0 = qb * 256, qidx0 = q0 + 32 * w, qidx = qidx0 + r32;
    const int NT = 4 * (qb + 1);
    const size_t hbase = ((size_t)b * 16 + h) * SEQ;
    const __amdgpu_buffer_rsrc_t rsK = __builtin_amdgcn_make_buffer_rsrc((void*)(Kt + hbase * 96), (short)0, SEQ * 96 * 2, 0x00020000);
    const __amdgpu_buffer_rsrc_t rsV = __builtin_amdgcn_make_buffer_rsrc((void*)(V + hbase * 64), (short)0, SEQ * 64 * 2, 0x00020000);
    const int k16 = lane >> 2, pc = lane & 3, swz = pc ^ ((k16 >> 2) & 3);
    unsigned vo0, vo1, vo2;
    { const int kg = w / 3, cg = w % 3; vo0 = (unsigned)((kg * 16 + k16) * 192 + (cg * 4 + swz) * 16); }
    if (w < 4) { const int id = w + 8, kg = id / 3, cg = id % 3; vo1 = (unsigned)((kg * 16 + k16) * 192 + (cg * 4 + swz) * 16);
                 const int j = w + 4, d0 = j >> 2, kgv = j & 3; vo2 = (unsigned)((kgv * 16 + k16) * 128 + (d0 * 4 + pc) * 16); }
    else { const int j = w - 4, d0 = j >> 2, kgv = j & 3; vo1 = (unsigned)((kgv * 16 + k16) * 128 + (d0 * 4 + pc) * 16); vo2 = 0; }
    const unsigned lds0 = (unsigned)(uintptr_t)lds;
#define ML_DMA(t, st) do { const unsigned so_k = (unsigned)((t) * 64 * 192), so_v = (unsigned)((t) * 64 * 128); \
        dma_piece(rsK, lds0 + (st) + w * 1024, vo0, so_k); \
        if (w < 4) { dma_piece(rsK, lds0 + (st) + (w + 8) * 1024, vo1, so_k); dma_piece(rsV, lds0 + (st) + ML_KB + (w + 4) * 1024, vo2, so_v); } \
        else { dma_piece(rsV, lds0 + (st) + ML_KB + (w - 4) * 1024, vo1, so_v); } } while (0)
    ML_DMA(0, 0);
    bf16x8 qf[6];
#pragma unroll
    for (int kk = 0; kk < 6; ++kk) qf[kk] = *(const bf16x8*)(Q + (hbase + qidx) * 96 + 16 * kk + 8 * hi);
    mla_q_prep(qf, F.in[I_L1_C_QN], (const float*)(F.ws + WS_ROPEC), (const float*)(F.ws + WS_ROPEC) + (size_t)NTOK * 16, tokbase + qidx, hi);
    float m = 0.f, l = 0.f; f32x16 o0, o1, negm;
#pragma unroll
    for (int r = 0; r < 16; ++r) { o0[r] = 0.f; o1[r] = 0.f; negm[r] = 0.f; }
    const int vlane = (4 * hi + ((lane & 15) >> 2)) * 64 + ((lane >> 4) & 1) * 32 + (lane & 3) * 8;
    const int klane = (r32 >> 4) * 3072 + (r32 & 15) * 64, ksw = (r32 >> 2) & 3, ke0 = ((hi) ^ ksw) * 16, ke1 = ((2 + hi) ^ ksw) * 16;
    asm volatile("s_waitcnt vmcnt(0) lgkmcnt(0)\n\ts_barrier" ::: "memory");
#define ML_TILE(t, CUR, NXT) do { \
        if ((t) + 1 < NT) ML_DMA((t) + 1, NXT); \
        const int kidx0 = 64 * (t); \
        LAS unsigned char* kp0 = lds + (CUR) + klane; LAS unsigned char* kp1 = kp0 + 6144; \
        LAS unsigned char* vp0 = lds + (CUR) + ML_KB + vlane; LAS unsigned char* vp1 = vp0 + 32 * 64; \
        if (kidx0 <= qidx0 + 31) \
            attn_step<96, true, FIXREF>(kp0, kp1, ke0, ke1, vp0, vp1, 4096, qf, negm, m, l, o0, o1, kidx0 + 31 > qidx0, kidx0 + 63 > qidx0, qidx, kidx0, 1 << 30, hi); \
        asm volatile("s_waitcnt vmcnt(0) lgkmcnt(0)\n\ts_barrier" ::: "memory"); } while (0)
#pragma unroll 1
    for (int t = 0; t < NT; t += 2) {
        ML_TILE(t, 0, ML_STAGE);
        ML_TILE(t + 1, ML_STAGE, 0);
    }
#undef ML_TILE
#undef ML_DMA
    l = swap32_sum(l);
    const float inv = 1.0f / l;
    { LAS unsigned char* st = lds + 2 * ML_STAGE + w * OST_WAVE;
      ostage_write(st, o0, o1, inv, r32, hi);
      asm volatile("s_waitcnt lgkmcnt(0)" ::: "memory");
      bf16_t* obase = (bf16_t*)(F.ws + WS_ATT) + (tokbase + qidx0) * DM + h * 64;
#pragma unroll
      for (int i = 0; i < 4; ++i) { const int row = 8 * i + (lane >> 3); *(u32x4*)(obase + (size_t)row * DM + (lane & 7) * 8) = *(const LAS u32x4*)(st + row * OST_ROW + (lane & 7) * 16); } }
}
__device__ __forceinline__ void mla_unit2(const Frame& F, int b, int h, int qb  ) {
    const int lane_ = lane_id_v();
    const bf16_t* Q = (const bf16_t*)(F.ws + WS_Q); const bf16_t* Kt = (const bf16_t*)(F.ws + WS_K); const bf16_t* V = (const bf16_t*)(F.ws + WS_KV);
    LAS unsigned char* lds = F.lds;
    const int lane = lane_, w = F.wave, hi = lane >> 5, r32 = lane & 31;
    const size_t tokbase = (size_t)b * SEQ;
    const int qa0 = qb * 512 + 32 * w, qb0 = qb * 512 + 32 * (15 - w), qidxa = qa0 + r32, qidxb = qb0 + r32;
    const int NT = 8 * (qb + 1);
    const size_t hbase = ((size_t)b * 16 + h) * SEQ;
    const __amdgpu_buffer_rsrc_t rsK = __builtin_amdgcn_make_buffer_rsrc((void*)(Kt + hbase * 96), (short)0, SEQ * 96 * 2, 0x00020000);
    const __amdgpu_buffer_rsrc_t rsV = __builtin_amdgcn_make_buffer_rsrc((void*)(V + hbase * 64), (short)0, SEQ * 64 * 2, 0x00020000);
    const int k16 = lane >> 2, pc = lane & 3, swz = pc ^ ((k16 >> 2) & 3);
    unsigned vo0, vo1, vo2;
    { const int kg = w / 3, cg = w % 3; vo0 = (unsigned)((kg * 16 + k16) * 192 + (cg * 4 + swz) * 16); }
    if (w < 4) { const int id = w + 8, kg = id / 3, cg = id % 3; vo1 = (unsigned)((kg * 16 + k16) * 192 + (cg * 4 + swz) * 16);
                 const int j = w + 4, d0 = j >> 2, kgv = j & 3; vo2 = (unsigned)((kgv * 16 + k16) * 128 + (d0 * 4 + pc) * 16); }
    else { const int j = w - 4, d0 = j >> 2, kgv = j & 3; vo1 = (unsigned)((kgv * 16 + k16) * 128 + (d0 * 4 + pc) * 16); vo2 = 0; }
    const unsigned lds0 = (unsigned)(uintptr_t)lds;
#define ML_DMA(t, st) do { const unsigned so_k = (unsigned)((t) * 64 * 192), so_v = (unsigned)((t) * 64 * 128); \
        dma_piece(rsK, lds0 + (st) + w * 1024, vo0, so_k); \
        if (w < 4) { dma_piece(rsK, lds0 + (st) + (w + 8) * 1024, vo1, so_k); dma_piece(rsV, lds0 + (st) + ML_KB + (w + 4) * 1024, vo2, so_v); } \
        else { dma_piece(rsV, lds0 + (st) + ML_KB + (w - 4) * 1024, vo1, so_v); } } while (0)
    ML_DMA(0, 0);
    bf16x8 qa[6], qb2[6];
    { const __amdgpu_buffer_rsrc_t rsQ = __builtin_amdgcn_make_buffer_rsrc((void*)(Q + hbase * 96), (short)0, SEQ * 96 * 2, 0x00020000);
      const unsigned qoa = (unsigned)(qidxa * 192 + hi * 16), qob = (unsigned)(qidxb * 192 + hi * 16);
#pragma unroll
      for (int kk = 0; kk < 6; ++kk) { qa[kk] = __builtin_bit_cast(bf16x8, __builtin_amdgcn_raw_buffer_load_b128(rsQ, qoa + kk * 32, 0, 0)); qb2[kk] = __builtin_bit_cast(bf16x8, __builtin_amdgcn_raw_buffer_load_b128(rsQ, qob + kk * 32, 0, 0)); } }
    { const float* cc_ = (const float*)(F.ws + WS_ROPEC); mla_q_prep(qa, F.in[I_L1_C_QN], cc_, cc_ + (size_t)NTOK * 16, tokbase + qidxa, hi); mla_q_prep(qb2, F.in[I_L1_C_QN], cc_, cc_ + (size_t)NTOK * 16, tokbase + qidxb, hi); }
    float la = 0.f, lb = 0.f; f32x16 oa0, oa1, ob0, ob1;
#pragma unroll
    for (int r = 0; r < 16; ++r) { oa0[r] = 0.f; oa1[r] = 0.f; ob0[r] = 0.f; ob1[r] = 0.f; }
    const int vlane = (4 * hi + ((lane & 15) >> 2)) * 64 + ((lane >> 4) & 1) * 32 + (lane & 3) * 8;
    const int klane = (r32 >> 4) * 3072 + (r32 & 15) * 64, ksw = (r32 >> 2) & 3, ke0 = ((hi) ^ ksw) * 16, ke1 = ((2 + hi) ^ ksw) * 16;
    asm volatile("s_waitcnt vmcnt(0) lgkmcnt(0)\n\ts_barrier" ::: "memory");
#define ML_TILE(t, CUR, NXT) do { \
        if ((t) + 1 < NT) ML_DMA((t) + 1, NXT); \
        const int kidx0 = 64 * (t); \
          \
        if (kidx0 <= qa0 + 31) attn_step2<96, false>(lds + (CUR) + klane, ke0, ke1, lds + (CUR) + ML_KB + vlane, 4096, qa, qb2, la, lb, oa0, oa1, ob0, ob1, kidx0 + 31 > qa0, kidx0 + 31 > qb0, qidxa, qidxb, kidx0, hi); \
        else if (kidx0 <= qb0 + 31) attn_step2<96, true>(lds + (CUR) + klane, ke0, ke1, lds + (CUR) + ML_KB + vlane, 4096, qa, qb2, la, lb, oa0, oa1, ob0, ob1, false, kidx0 + 31 > qb0, qidxa, qidxb, kidx0, hi); \
        if (kidx0 + 32 <= qa0 + 31) attn_step2<96, false>(lds + (CUR) + klane + 6144, ke0, ke1, lds + (CUR) + ML_KB + vlane + 32 * 64, 4096, qa, qb2, la, lb, oa0, oa1, ob0, ob1, kidx0 + 63 > qa0, kidx0 + 63 > qb0, qidxa, qidxb, kidx0 + 32, hi); \
        else if (kidx0 + 32 <= qb0 + 31) attn_step2<96, true>(lds + (CUR) + klane + 6144, ke0, ke1, lds + (CUR) + ML_KB + vlane + 32 * 64, 4096, qa, qb2, la, lb, oa0, oa1, ob0, ob1, false, kidx0 + 63 > qb0, qidxa, qidxb, kidx0 + 32, hi); \
        asm volatile("s_waitcnt vmcnt(0) lgkmcnt(0)\n\ts_barrier" ::: "memory"); } while (0)
#pragma unroll 1
    for (int t = 0; t < NT; t += 2) {
        ML_TILE(t, 0, ML_STAGE);
        ML_TILE(t + 1, ML_STAGE, 0);
    }
#undef ML_TILE
#undef ML_DMA
    la = swap32_sum(la); lb = swap32_sum(lb);
    const float ia = 1.0f / la, ib = 1.0f / lb;
    { LAS unsigned char* st = lds + 2 * ML_STAGE + w * 2 * OST_WAVE;
      ostage_write(st, oa0, oa1, ia, r32, hi); ostage_write(st + OST_WAVE, ob0, ob1, ib, r32, hi);
      asm volatile("s_waitcnt lgkmcnt(0)" ::: "memory");
      bf16_t* obasea = (bf16_t*)(F.ws + WS_ATT) + (tokbase + qa0) * DM + h * 64; bf16_t* obaseb = (bf16_t*)(F.ws + WS_ATT) + (tokbase + qb0) * DM + h * 64;
#pragma unroll
      for (int i = 0; i < 8; ++i) { const int row = 8 * i + (lane >> 3); *(u32x4*)((i < 4 ? obasea : obaseb - (size_t)32 * DM) + (size_t)row * DM + (lane & 7) * 8) = *(const LAS u32x4*)(st + row * OST_ROW + (lane & 7) * 16); } }
}
__device__ __forceinline__ void mla_phase(const Frame& F) {
    float gq = 0.f, gk = 0.f;
    for (int i = 0; i < 96; ++i) { gq = fmaxf(gq, fabsf(F.in[I_L1_C_QN][i])); gk = fmaxf(gk, fabsf(F.in[I_L1_C_KN][i])); }
    const bool fix = gq * gk * 9.797959f * LOG2E < ATT_FIX_BOUND;
    if (fix) {
        for (int idx = F.bid; idx < 1024; idx += F.G) {
            const int bh = idx >> 1, s = idx & 1;
#pragma nounroll
            for (int u = 0; u < 2; ++u) mla_unit2(F, bh >> 4, bh & 15, u ? s : 3 - s);
        }
    } else {
        for (int idx = F.bid; idx < 2048; idx += F.G) {
            const int bh = idx >> 2, s = idx & 3;
#pragma nounroll
            for (int u = 0; u < 2; ++u) mla_unit<false>(F, bh >> 4, bh & 15, u ? s : 7 - s);
        }
    }
}

__device__ __forceinline__ void mla_rowstats(const Frame& F) {
    const int lane_ = lane_id_v();
    const bf16_t* P1 = (const bf16_t*)(F.ws + WS_PROJ1); float* rs = (float*)(F.ws + RT_ROWST);
    for (int t = F.bid * 8 + F.wave; t < NTOK; t += F.G * 8) {
        const bf16_t* pr = P1 + (size_t)t * L1_INP;
        const u32x2 a = *(const u32x2*)(pr + lane_ * 4); const unsigned a2 = *(const unsigned*)(pr + 256 + lane_ * 2); const u32x2 c = *(const u32x2*)(pr + CQ + lane_ * 4);
        const float s1 = bf_lo(a.x) * bf_lo(a.x) + bf_hi(a.x) * bf_hi(a.x) + bf_lo(a.y) * bf_lo(a.y) + bf_hi(a.y) * bf_hi(a.y) + bf_lo(a2) * bf_lo(a2) + bf_hi(a2) * bf_hi(a2);
        const float s2 = bf_lo(c.x) * bf_lo(c.x) + bf_hi(c.x) * bf_hi(c.x) + bf_lo(c.y) * bf_lo(c.y) + bf_hi(c.y) * bf_hi(c.y);
        const float rq = __builtin_amdgcn_rsqf(wave_sum(s1) * (1.f / CQ) + EPS), rkv = __builtin_amdgcn_rsqf(wave_sum(s2) * (1.f / CKV) + EPS);
        if (lane_ == 0) *(f32x2*)(rs + 2 * t) = (f32x2){rq, rkv};
    }
}
__device__ __forceinline__ void moe_route1(const Frame& F) {
    const int lane_ = lane_id_v(), tid_ = F.wave * 64 + lane_; (void)tid_;
    const bf16_t* x = (const bf16_t*)(F.ws + WS_X3); const float* gain = F.in[I_L1_FFN_NORM]; const float* router = F.in[I_L1_ROUTER];
    unsigned char* dst = (unsigned char*)(F.ws + WS_H3F8);
    int* tok_e = (int*)(F.ws + RT_TOKE); float* tok_g = (float*)(F.ws + RT_TOKG); int* wgcnt = (int*)(F.ws + RT_WGCNT);
    LAS int* cnt = (LAS int*)(F.lds + 32768);
    if (tid_ < 8) cnt[tid_] = 0;
    __syncthreads();
    f32x4 rr[4][4][2];
#pragma unroll
    for (int j = 0; j < 4; ++j)
#pragma unroll
        for (int c = 0; c < 4; ++c) { const int d = (lane_ + 64 * j) * 4 + c; rr[j][c][0] = *(const f32x4*)(router + d * 8); rr[j][c][1] = *(const f32x4*)(router + d * 8 + 4); }
    f32x4 gv[4];
#pragma unroll
    for (int j = 0; j < 4; ++j) gv[j] = ((const f32x4*)gain)[lane_ + 64 * j];
    u32x2 nx[4];
    { const int m0 = F.bid * 8 + F.wave; const u32x2* xr = (const u32x2*)(x + (size_t)m0 * DM) + lane_;
#pragma unroll
      for (int j = 0; j < 4; ++j) nx[j] = xr[64 * j]; }
    for (int m = F.bid * 8 + F.wave; m < NTOK; m += F.G * 8) {
        u32x2 cx[4];
#pragma unroll
        for (int j = 0; j < 4; ++j) cx[j] = nx[j];
        if (m + F.G * 8 < NTOK) { const u32x2* xr = (const u32x2*)(x + (size_t)(m + F.G * 8) * DM) + lane_;
#pragma unroll
            for (int j = 0; j < 4; ++j) nx[j] = xr[64 * j]; }
        f32x4 v[4]; float s = 0.f;
#pragma unroll
        for (int j = 0; j < 4; ++j) { const u32x2 xx = cx[j]; v[j] = (f32x4){bf_lo(xx.x), bf_hi(xx.x), bf_lo(xx.y), bf_hi(xx.y)}; s += (v[j].x * v[j].x + v[j].y * v[j].y) + (v[j].z * v[j].z + v[j].w * v[j].w); }
        const float rstd = __builtin_amdgcn_rsqf(wave_sum(s) * (1.f / DM) + EPS);
        float lg[8];
#pragma unroll
        for (int e = 0; e < 8; ++e) lg[e] = 0.f;
        unsigned* o8 = (unsigned*)(dst + (size_t)m * DM) + lane_;
#pragma unroll
        for (int j = 0; j < 4; ++j) {
            f32x4 hv = v[j] * rstd * gv[j];
            o8[64 * j] = pk4_fp8(hv.x, hv.y, hv.z, hv.w);
#pragma unroll
            for (int c = 0; c < 4; ++c) { const f32x4 r0 = rr[j][c][0], r1 = rr[j][c][1];
                lg[0] += hv[c] * r0.x; lg[1] += hv[c] * r0.y; lg[2] += hv[c] * r0.z; lg[3] += hv[c] * r0.w; lg[4] += hv[c] * r1.x; lg[5] += hv[c] * r1.y; lg[6] += hv[c] * r1.z; lg[7] += hv[c] * r1.w; }
        }
        { const bool b0 = lane_ & 1, b1 = (lane_ >> 1) & 1, b2 = (lane_ >> 2) & 1;
          float k4[4], k2[2], k1;
#pragma unroll
          for (int i = 0; i < 4; ++i) { const float keep = b0 ? lg[4 + i] : lg[i], send = b0 ? lg[i] : lg[4 + i]; k4[i] = keep + __shfl_xor(send, 1); }
#pragma unroll
          for (int i = 0; i < 2; ++i) { const float keep = b1 ? k4[2 + i] : k4[i], send = b1 ? k4[i] : k4[2 + i]; k2[i] = keep + __shfl_xor(send, 2); }
          { const float keep = b2 ? k2[1] : k2[0], send = b2 ? k2[0] : k2[1]; k1 = keep + __shfl_xor(send, 4); }
          k1 += __shfl_xor(k1, 8); k1 += __shfl_xor(k1, 16); k1 += __shfl_xor(k1, 32);
#pragma unroll
          for (int e = 0; e < 8; ++e) lg[e] = __uint_as_float(__builtin_amdgcn_readlane(__float_as_uint(k1), (e >> 2) | (((e >> 1) & 1) << 1) | ((e & 1) << 2))); }
        int e0 = 0; float v0 = lg[0];
#pragma unroll
        for (int e = 1; e < 8; ++e) if (lg[e] > v0) { v0 = lg[e]; e0 = e; }
        int e1 = -1; float v1 = -INFINITY;
#pragma unroll
        for (int e = 0; e < 8; ++e) if (e != e0 && lg[e] > v1) { v1 = lg[e]; e1 = e; }
        const float p1 = __expf(v1 - v0), g0 = 1.0f / (1.0f + p1), g1 = p1 * g0;
        if (lane_ == 0) { tok_e[2 * m] = e0; tok_e[2 * m + 1] = e1; tok_g[2 * m] = g0; tok_g[2 * m + 1] = g1;
            __hip_atomic_fetch_add(cnt + e0, 1, __ATOMIC_RELAXED, __HIP_MEMORY_SCOPE_WORKGROUP); __hip_atomic_fetch_add(cnt + e1, 1, __ATOMIC_RELAXED, __HIP_MEMORY_SCOPE_WORKGROUP); }
    }
    __syncthreads();
    if (tid_ < 8) wgcnt[F.bid * 8 + tid_] = cnt[tid_];
}
__device__ __forceinline__ void moe_route2(const Frame& F) {
    const int lane_ = lane_id_v(), tid_ = F.wave * 64 + lane_; (void)tid_;
    const int* tok_e = (const int*)(F.ws + RT_TOKE); int* tok_s = (int*)(F.ws + RT_TOKS); int* row_tok = (int*)(F.ws + RT_ROWTOK);
    const int* wgcnt = (const int*)(F.ws + RT_WGCNT); int* tile_e = (int*)(F.ws + RT_TILEE);
    LAS int* tot = (LAS int*)F.lds;
    if (tid_ < 32) tot[tid_] = 0;
    __syncthreads();
    { const int e = tid_ & 7; int a = 0, b = 0;
      for (int wg = tid_ >> 3; wg < F.G; wg += 64) { const int c = wgcnt[wg * 8 + e]; a += c; if (wg < F.bid) b += c; }
      __hip_atomic_fetch_add(tot + e, a, __ATOMIC_RELAXED, __HIP_MEMORY_SCOPE_WORKGROUP); __hip_atomic_fetch_add(tot + 8 + e, b, __ATOMIC_RELAXED, __HIP_MEMORY_SCOPE_WORKGROUP); }
    __syncthreads();
    if (tid_ == 0) { int ps = 0; for (int e = 0; e < 8; ++e) { tot[16 + e] = ps; ps += (tot[e] + 255) / 256 * 256; } tot[32] = ps; }
    __syncthreads();
    if (F.bid == 0) {
        const int used = tot[32] / 256;
        for (int t = tid_; t < MOE_TILES_MAX; t += 512) { int e = -1; if (t < used) { e = 7; for (int q = 7; q >= 1; --q) if (t * 256 < tot[16 + q]) e = q - 1; } tile_e[t] = e < 0 ? 0 : e; }
        if (tid_ == 0) tile_e[MOE_TILES_MAX] = used;
    }
    if (F.bid < 8) {
        const int e = F.bid, lo = tot[16 + e] + tot[e], hi = tot[16 + e] + (tot[e] + 255) / 256 * 256;
        for (int p = lo + tid_; p < hi; p += 512) row_tok[p] = -1;
    }
    { const int gw = F.bid * 8 + F.wave, NGW = F.G * 8;
      for (int j0 = 0; gw + j0 * NGW < NTOK; j0 += 32) {
          const int m = gw + (j0 + (lane_ >> 1)) * NGW, k = lane_ & 1;
          if (m < NTOK) { const int e = tok_e[2 * m + k];
              const int slot = tot[16 + e] + tot[8 + e] + __hip_atomic_fetch_add(tot + 24 + e, 1, __ATOMIC_RELAXED, __HIP_MEMORY_SCOPE_WORKGROUP);
              row_tok[slot] = m; tok_s[2 * m + k] = slot; } } }
    __syncthreads();
}
__device__ __forceinline__ void moe_combine(const Frame& F, bool dry) {
    const int lane_ = lane_id_v();
    const f32x2* tok_g = (const f32x2*)(F.ws + RT_TOKG); const u32x2* tok_s = (const u32x2*)(F.ws + RT_TOKS); const bf16_t* Y = (const bf16_t*)(F.ws + WS_Y);
    for (int m = (F.bid * 8 + F.wave) * 2; m < NTOK; m += F.G * 16) {
        const f32x2 ga = tok_g[m], gb = tok_g[m + 1]; const u32x2 sa = tok_s[m], sb = tok_s[m + 1];
        f32x4* xa = (f32x4*)(F.out + (size_t)m * DM) + lane_; f32x4* xb = xa + DM / 4;
        const u32x2* x3a = (const u32x2*)((const bf16_t*)(F.ws + WS_X3) + (size_t)m * DM) + lane_; const u32x2* x3b = x3a + DM / 4;
        const u32x2* ya0 = (const u32x2*)(Y + (size_t)sa.x * DM) + lane_; const u32x2* ya1 = (const u32x2*)(Y + (size_t)sa.y * DM) + lane_;
        const u32x2* yb0 = (const u32x2*)(Y + (size_t)sb.x * DM) + lane_; const u32x2* yb1 = (const u32x2*)(Y + (size_t)sb.y * DM) + lane_;
        f32x4 va[4], vb[4]; u32x2 a0[4], a1[4], b0[4], b1[4];
#pragma unroll
        for (int j = 0; j < 4; ++j) { { const u32x2 p = x3a[64 * j], q = x3b[64 * j]; va[j] = (f32x4){bf_lo(p.x), bf_hi(p.x), bf_lo(p.y), bf_hi(p.y)}; vb[j] = (f32x4){bf_lo(q.x), bf_hi(q.x), bf_lo(q.y), bf_hi(q.y)}; } a0[j] = ya0[64 * j]; a1[j] = ya1[64 * j]; b0[j] = yb0[64 * j]; b1[j] = yb1[64 * j]; }
#pragma unroll
        for (int j = 0; j < 4; ++j) {
            f32x4 v = va[j];
            v.x += ga.x * bf_lo(a0[j].x) + ga.y * bf_lo(a1[j].x); v.y += ga.x * bf_hi(a0[j].x) + ga.y * bf_hi(a1[j].x); v.z += ga.x * bf_lo(a0[j].y) + ga.y * bf_lo(a1[j].y); v.w += ga.x * bf_hi(a0[j].y) + ga.y * bf_hi(a1[j].y);
            if (!dry) xa[64 * j] = v;
            v = vb[j];
            v.x += gb.x * bf_lo(b0[j].x) + gb.y * bf_lo(b1[j].x); v.y += gb.x * bf_hi(b0[j].x) + gb.y * bf_hi(b1[j].x); v.z += gb.x * bf_lo(b0[j].y) + gb.y * bf_lo(b1[j].y); v.w += gb.x * bf_hi(b0[j].y) + gb.y * bf_hi(b1[j].y);
            if (!dry) xb[64 * j] = v; }
    }
}

constexpr int NPHASE = 21;
__global__ void __launch_bounds__(512, 2) mk_fwd(Args args) {
    extern __shared__ __attribute__((aligned(16))) unsigned char lds_raw[];
    Frame F;
    F.lds = (LAS unsigned char*)lds_raw;
    F.wave = __builtin_amdgcn_readfirstlane((int)threadIdx.x >> 6);
    F.G = gridDim.x; F.bid = blockIdx.x; F.ws = args.ws; F.out = args.out; F.in = args.in;
    volatile LAS unsigned* MISC = (volatile LAS unsigned*)(F.lds + LDS_MISC);
    { const int l0 = lane_id_v(); if (F.wave == 0) MISC[l0] = 0u; }
    __syncthreads();
    unsigned* ctl = (unsigned*)(args.ws + WS_CTL);
    XcdBarrier bar; bar.bar = ctl + CW_BAR; bar.x = 0; bar.st = nullptr; bar.wave = F.wave;
    if (!MK_PER_PHASE) bar = xcd_barrier_post(ctl + CW_BAR, MISC, F.wave);
    const int lo = args.ph_lo, hi = args.ph_hi; const unsigned probe = args.probe; (void)probe;
    unsigned char* ws = args.ws;
#define IN(k) (lo <= (k) && (k) < hi)
#if PROBE_MASK != 0
#define DRY(k) (rep_ < (int)((probe >> (k)) & 1u))
#define REPS(k) _Pragma("nounroll") for (int rep_ = 0; rep_ <= (int)((probe >> (k)) & 1u); ++rep_)
#else
#define DRY(k) false
#define REPS(k)
#endif
#define SEAM(k) do { if (IN(k) && IN((k) + 1)) { if (!MK_PER_PHASE) xcd_barrier(bar); } } while (0)
    int ph = 0;
    if (IN(0)) REPS(0) { p0_weights(F); p0_rope(F); x_rows(F, F.in[I_X], (bf16_t*)(ws + WS_H), (float*)(ws + RT_ROWST)); } SEAM(0);
    if (IN(1)) REPS(1) { pg8::Gemm g{(const bf16_t*)(ws + WS_H), (const bf16_t*)(ws + W0_IN), DM, DM, 0, nullptr}; pg8::StaticOrder S; S.init(NTOK / 256, L0_IN / 256, F.G, F.bid);
        pg8::EpiQKV0 E{(bf16_t*)(ws + WS_PROJ0), (const float*)(ws + WS_ROPEH), (const float*)(ws + WS_ROPEH) + (size_t)NTOK * 32, (const float*)(ws + RT_ROWST), F.in[I_L0_A_QN], F.in[I_L0_A_KN], F.in[I_L0_B_QN], F.in[I_L0_B_KN]};
        pg8::gemm_phase<pg8::EpiQKV0, false, 2, L0_IN / 256>(F.lds, g, S, E, 0, F.wave); } SEAM(1);
    if (IN(2)) REPS(2) { band_phase(F, 0); } SEAM(2);
    if (IN(3)) REPS(3) { band_phase(F, 1); } SEAM(3);
    if (IN(4)) REPS(4) { pg8::Gemm g{(const bf16_t*)(ws + WS_MIX), (const bf16_t*)(ws + W0_OUT), DM, DM, 0, nullptr}; pg8::StaticOrder S; S.init(NTOK / 256, DM / 256, F.G, F.bid);
        pg8::EpiRes<true, true, true> E{ws + WS_H, ws + WS_X12, false, (float*)(ws + WS_SSX), (LAS float*)(F.lds + RING_BYTES + 2048)}; pg8::gemm_phase<pg8::EpiRes<true, true, true>, false, 2, DM / 256>(F.lds, g, S, E, 0, F.wave); } SEAM(4);
    if (IN(6)) REPS(6) { pg8::Gemm g{(const bf16_t*)(ws + WS_X12), (const bf16_t*)(ws + W0_GU), DM, DM, 0, nullptr}; pg8::StaticOrder S; S.init(NTOK / 256, 2 * DFF / 256, F.G, F.bid);
        pg8::EpiSwiGLU E{(bf16_t*)(ws + WS_HID0), DFF, 0, (const float*)(ws + WS_SSX)}; pg8::gemm_phase<pg8::EpiSwiGLU, false, 2, 2 * DFF / 256>(F.lds, g, S, E, 0, F.wave); } SEAM(6);
    if (IN(7)) REPS(7) { pg8::Gemm g{(const bf16_t*)(ws + WS_HID0), (const bf16_t*)(ws + W0_DN), DFF, DFF, 0, nullptr}; pg8::StaticOrder S; S.init(NTOK / 256, DM / 256, F.G, F.bid);
        pg8::EpiRes<true, true, true> E{ws + WS_X12, ws + WS_X12, DRY(7), (float*)(ws + WS_SSX), (LAS float*)(F.lds + RING_BYTES + 2048)}; pg8::gemm_phase<pg8::EpiRes<true, true, true>, false, 2, DM / 256>(F.lds, g, S, E, 0, F.wave); } SEAM(7);
    if (IN(9)) REPS(9) { pg8::Gemm g{(const bf16_t*)(ws + WS_X12), (const bf16_t*)(ws + W1_IN), DM, DM, 0, nullptr}; pg8::StaticOrder S; S.init(NTOK / 256, L1_INP / 256, F.G, F.bid);
        pg8::EpiProj1 E{(bf16_t*)(ws + WS_PROJ1), (float*)(ws + WS_ROPEH), (LAS float*)(F.lds + RING_BYTES + 2048), (const float*)(ws + WS_SSX)}; pg8::gemm_phase<pg8::EpiProj1, false, 2, L1_INP / 256>(F.lds, g, S, E, 0, F.wave); } SEAM(9);
    if (IN(11)) REPS(11) {
        { pg8::Gemm g{(const bf16_t*)(ws + WS_PROJ1), (const bf16_t*)(ws + W1_UQ), L1_INP, CQ, 0, nullptr}; pg8::StaticOrder S; S.init(NTOK / 256, NUQ / 256, F.G, F.bid);
          pg8::EpiBf16Row E{(bf16_t*)(ws + WS_Q), NUQ, (const float*)(ws + WS_ROPEH), 0}; pg8::gemm_phase<pg8::EpiBf16Row, false, 2, NUQ / 256>(F.lds, g, S, E, 0, F.wave); } }
    if (IN(12)) REPS(12) {
        { pg8::Gemm g{(const bf16_t*)(ws + WS_PROJ1) + CQ, (const bf16_t*)(ws + W1_UKV), L1_INP, CKV, 0, nullptr}; pg8::StaticOrder S; S.init(NTOK / 256, NUKV / 256, F.G, F.bid);
          const float* cc_ = (const float*)(ws + WS_ROPEC);
          pg8::EpiKV1 E{(bf16_t*)(ws + WS_K), (bf16_t*)(ws + WS_KV), (const float*)(ws + WS_ROPEH), (const bf16_t*)(ws + WS_PROJ1), cc_, cc_ + (size_t)NTOK * 16, F.in[I_L1_C_KN]};
          pg8::gemm_phase<pg8::EpiKV1, false, 2, NUKV / 256>(F.lds, g, S, E, 0, F.wave); } } SEAM(12);
    if (IN(14)) REPS(14) { mla_phase(F); } SEAM(14);
    if (IN(15)) REPS(15) { pg8::Gemm g{(const bf16_t*)(ws + WS_ATT), (const bf16_t*)(ws + W1_OUT), DM, DM, 0, nullptr}; pg8::StaticOrder S; S.init(NTOK / 256, DM / 256, F.G, F.bid);
        pg8::EpiRes<true, true> E{ws + WS_X12, ws + WS_X3, false, nullptr, nullptr}; pg8::gemm_phase<pg8::EpiRes<true, true>, false, 2, DM / 256>(F.lds, g, S, E, 0, F.wave); } SEAM(15);
    if (IN(16)) REPS(16) { moe_route1(F); } SEAM(16);
    if (IN(17)) REPS(17) { moe_route2(F); } SEAM(17);
    if (IN(18)) REPS(18) {
        const int* tile_e = (const int*)(ws + RT_TILEE); const int used = tile_e[MOE_TILES_MAX];
        pg8::Gemm g{(const bf16_t*)(ws + WS_H3F8), (const bf16_t*)(ws + WE_GU), DM, DM, (size_t)2 * DFE * DM, (const int*)(ws + RT_ROWTOK)}; pg8::StaticOrder S; S.init(used, 2 * DFE / 256, F.G, F.bid, 0, tile_e);
        static_assert(WGU_SCALE == 32.0f && WDN_SCALE == 64.0f, "MFMA block scales below");
        pg8::EpiSwiGLU8 E{(unsigned char*)(ws + WS_HIDE), DFE, DRY(18)}; pg8::gemm_phase<pg8::EpiSwiGLU8, true, 1, 0, 0x7a7a7a7a>(F.lds, g, S, E, 0, F.wave); } SEAM(18);
    if (IN(19)) REPS(19) {
        const int* tile_e = (const int*)(ws + RT_TILEE); const int used = tile_e[MOE_TILES_MAX];
        pg8::Gemm g{(const bf16_t*)(ws + WS_HIDE), (const bf16_t*)(ws + WE_DN), DFE, DFE, (size_t)DM * DFE, nullptr}; pg8::StaticOrder S; S.init(used, DM / 256, F.G, F.bid, 0, tile_e);
        pg8::EpiBf16 E{(bf16_t*)(ws + WS_Y), DM, 1.0f}; pg8::gemm_phase<pg8::EpiBf16, false, 1, 0, 0x79797979>(F.lds, g, S, E, 0, F.wave); } SEAM(19);
    if (IN(20)) REPS(20) { moe_combine(F, DRY(20)); }
    (void)ph;
#undef IN
#undef SEAM
}

extern "C" void kernel_launch(void* const* d_in, const int* in_sizes, int n_in, void* d_out, int out_size, void* d_ws, size_t ws_size, hipStream_t stream) {
    static int grid = 0;
    if (grid == 0) {
        if (n_in != 28 || in_sizes[0] != NTOK * DM || out_size != NTOK * DM || ws_size < WS_END) {
            fprintf(stderr, "kernel_launch: unexpected shapes (n_in %d, in0 %d, out %d, ws %zu < %zu); nothing launched\n", n_in, n_in > 0 ? in_sizes[0] : -1, out_size, ws_size, (size_t)WS_END); grid = -1; return; }
        int dev = 0, cus = 0, per_cu = 0;
        if (hipGetDevice(&dev) != hipSuccess || hipDeviceGetAttribute(&cus, hipDeviceAttributeMultiprocessorCount, dev) != hipSuccess) { grid = -1; return; }
        if (hipFuncSetAttribute((const void*)mk_fwd, hipFuncAttributeMaxDynamicSharedMemorySize, LDS_BYTES) != hipSuccess) { fprintf(stderr, "kernel_launch: hipFuncSetAttribute failed\n"); grid = -1; return; }
        if (hipOccupancyMaxActiveBlocksPerMultiprocessor(&per_cu, (const void*)mk_fwd, 512, LDS_BYTES) != hipSuccess || per_cu < 1) fprintf(stderr, "kernel_launch: occupancy query reports %d\n", per_cu);
        (void)hipGetLastError();
        grid = cus;
    }
    if (grid < 0) return;
    if (hipMemsetAsync((char*)d_ws + WS_CTL, 0, CTL_ZERO_BYTES, stream) != hipSuccess) return;
    Args a{};
    for (int i = 0; i < 28; ++i) a.in[i] = (const float*)d_in[i];
    a.out = (float*)d_out; a.ws = (unsigned char*)d_ws; a.probe = PROBE_MASK; a.pad = 0;
    if (MK_PER_PHASE) {
        for (int p = 0; p < NPHASE; ++p) { a.ph_lo = p; a.ph_hi = p + 1; hipLaunchKernelGGL(mk_fwd, dim3(grid), dim3(512), LDS_BYTES, stream, a); }
    } else {
        a.ph_lo = 0; a.ph_hi = NPHASE; hipLaunchKernelGGL(mk_fwd, dim3(grid), dim3(512), LDS_BYTES, stream, a);
    }
}
```

```cpp
#include <hip/hip_runtime.h>
#include <cstdio>
#include <cstdint>

#ifndef PROBE_MASK
#define PROBE_MASK 0u
#endif
#ifndef MK_PER_PHASE
#define MK_PER_PHASE 0
#endif

#define LAS __attribute__((address_space(3)))
#define GAS __attribute__((address_space(1)))
typedef unsigned short bf16_t;
typedef short bf16x8 __attribute__((ext_vector_type(8)));
typedef short s16x4 __attribute__((ext_vector_type(4)));
typedef float f32x2 __attribute__((ext_vector_type(2)));
typedef float f32x4 __attribute__((ext_vector_type(4)));
typedef float f32x16 __attribute__((ext_vector_type(16)));
typedef unsigned u32x2 __attribute__((ext_vector_type(2)));
typedef unsigned u32x4 __attribute__((ext_vector_type(4)));
typedef int v8i_t __attribute__((ext_vector_type(8)));
typedef int v4i_t __attribute__((ext_vector_type(4)));
typedef short bf16x16_t __attribute__((ext_vector_type(16)));

constexpr int NTOK = 65536, DM = 1024, SEQ = 2048, NBATCH = 32;
constexpr int L0_IN = 2304, DFF = 2816, L1_INP = 768  , CQ = 384, CKV = 256, NUQ = 1536, NUKV = 2048;
constexpr int NEXP = 8, DFE = 3584, MOE_ROWS_MAX = 133120  , MOE_TILES_MAX = 520, MOE_CHUNK_TILES = 130;
constexpr float EPS = 1e-6f;
constexpr float LOG2E = 1.4426950408889634f;
constexpr float WGU_SCALE = 32.0f, WDN_SCALE = 64.0f;

constexpr size_t MiB = 1u << 20;
constexpr size_t WS_CTL = 0, CTL_ZERO_BYTES = 64 * 1024;
constexpr size_t WS_ROUTE = 1 * MiB;
constexpr size_t RT_TOKE = WS_ROUTE;
constexpr size_t RT_TOKG = RT_TOKE + (size_t)NTOK * 8;
constexpr size_t RT_TOKS = RT_TOKG + (size_t)NTOK * 8;
constexpr size_t RT_ROWTOK = RT_TOKS + (size_t)NTOK * 8;
constexpr size_t RT_WGCNT = RT_ROWTOK + (size_t)MOE_ROWS_MAX * 4;
constexpr size_t RT_TILEE = RT_WGCNT + 1024 * 8 * 4;
constexpr size_t RT_ROWST = RT_TILEE + 4096;
constexpr size_t RT_END = RT_ROWST + (size_t)NTOK * 8;
static_assert(RT_END <= 4 * MiB, "route tables");
constexpr size_t WS_W = 4 * MiB;
constexpr size_t W0_IN = WS_W;
constexpr size_t W0_OUT = W0_IN + (size_t)L0_IN * DM * 2;
constexpr size_t W0_GU = W0_OUT + (size_t)DM * DM * 2;
constexpr size_t W0_DN = W0_GU + (size_t)2 * DFF * DM * 2;
constexpr size_t W1_IN = W0_DN + (size_t)DM * DFF * 2;
constexpr size_t W1_UQ = W1_IN + (size_t)L1_INP * DM * 2;
constexpr size_t W1_UKV = W1_UQ + (size_t)NUQ * CQ * 2;
constexpr size_t W1_OUT = W1_UKV + (size_t)NUKV * CKV * 2;
constexpr size_t WE_GU = W1_OUT + (size_t)DM * DM * 2;
constexpr size_t WE_DN = WE_GU + (size_t)NEXP * 2 * DFE * DM;
constexpr size_t WS_W_END = WE_DN + (size_t)NEXP * DM * DFE;
static_assert(WS_W_END <= 202 * MiB, "weights");
constexpr size_t WS_H = 202 * MiB;
constexpr size_t WS_PROJ0 = 330 * MiB;
constexpr size_t WS_MIX = 618 * MiB;
constexpr size_t WS_PART = 746 * MiB;
constexpr size_t WS_LSE = 874 * MiB;
constexpr size_t WS_X12 = 746 * MiB;
constexpr size_t WS_SSX = 1004 * MiB;
constexpr size_t WS_ROPEH = 1000 * MiB;
constexpr size_t WS_ROPEC = 1016 * MiB;
constexpr size_t WS_HID0 = 330 * MiB;
constexpr size_t WS_PROJ1 = 878 * MiB;
constexpr size_t WS_Q = 426 * MiB;
constexpr size_t WS_KV = 618 * MiB;
constexpr size_t WS_K = 202 * MiB;
constexpr size_t WS_ATT = 874 * MiB;
constexpr size_t WS_X3 = 117 * MiB;
constexpr size_t WS_H3F8 = 245 * MiB;
constexpr size_t WS_HIDE = 309 * MiB;
constexpr size_t WS_Y = 764 * MiB;
static_assert(WE_DN + (size_t)NEXP * DM * DFE <= WS_X3 && WS_X3 + (size_t)NTOK * DM * 2 <= WS_H3F8, "x3 map");
constexpr size_t WS_END = 1024 * MiB;
static_assert(WS_H3F8 + (size_t)NTOK * DM <= WS_HIDE && WS_HIDE + (size_t)MOE_ROWS_MAX * DFE <= WS_Y && WS_Y + (size_t)MOE_ROWS_MAX * DM * 2 <= WS_END, "moe map");
static_assert(WS_ATT + (size_t)NTOK * DM * 2 <= WS_ROPEC, "att map");

constexpr int CW_BAR = 1024;

constexpr int RING_BYTES = 131072;
constexpr int LDS_ROWTAB = RING_BYTES;
constexpr int LDS_BYTES = 147456;
constexpr int LDS_MISC = LDS_BYTES - 256;

#define RLX_AGENT __ATOMIC_RELAXED, __HIP_MEMORY_SCOPE_AGENT
#define LDS_WAIT() asm volatile("s_waitcnt lgkmcnt(0)" ::: "memory")
#define VM_WAIT() asm volatile("s_waitcnt vmcnt(0)" ::: "memory")
__device__ __forceinline__ unsigned cvt_pk_bf16(float lo, float hi) { unsigned r; asm volatile("v_cvt_pk_bf16_f32 %0, %1, %2" : "=v"(r) : "v"(lo), "v"(hi)); return r; }
__device__ __forceinline__ unsigned pk4_fp8(float a, float b, float c, float d) { int w = 0; w = __builtin_amdgcn_cvt_pk_fp8_f32(a, b, w, false); w = __builtin_amdgcn_cvt_pk_fp8_f32(c, d, w, true); return (unsigned)w; }
__device__ __forceinline__ float bf_lo(unsigned u) { return __uint_as_float(u << 16); }
__device__ __forceinline__ float bf_hi(unsigned u) { return __uint_as_float(u & 0xffff0000u); }
__device__ __forceinline__ int lane_id() { return (int)__builtin_amdgcn_mbcnt_hi(~0u, __builtin_amdgcn_mbcnt_lo(~0u, 0u)); }
__device__ __forceinline__ int lane_id_v() { int l; asm volatile("v_mbcnt_lo_u32_b32 %0, -1, 0\n\tv_mbcnt_hi_u32_b32 %0, -1, %0" : "=v"(l)); return l; }
__device__ __forceinline__ float wave_sum(float v) {
#pragma unroll
    for (int o = 1; o < 64; o <<= 1) v += __shfl_xor(v, o);
    return v;
}
__device__ __forceinline__ float fq_sum(float v) {
    auto a = __builtin_amdgcn_permlane16_swap(__float_as_uint(v), __float_as_uint(v), false, false); v = __uint_as_float(a[0]) + __uint_as_float(a[1]);
    auto b = __builtin_amdgcn_permlane32_swap(__float_as_uint(v), __float_as_uint(v), false, false); return __uint_as_float(b[0]) + __uint_as_float(b[1]); }
__device__ __forceinline__ float swap32_max(float v) { auto rr = __builtin_amdgcn_permlane32_swap(__float_as_uint(v), __float_as_uint(v), false, false); return fmaxf(__uint_as_float(rr[0]), __uint_as_float(rr[1])); }
__device__ __forceinline__ float swap32_sum(float v) { auto rr = __builtin_amdgcn_permlane32_swap(__float_as_uint(v), __float_as_uint(v), false, false); return __uint_as_float(rr[0]) + __uint_as_float(rr[1]); }

#define XB_TMO      128
#define XB_XCNT(j)  (256  + 64 * (j))
#define XB_XSUB(j)  (1280 + 64 * (j))
#define XB_XGEN(j)  (2304 + 64 * (j))
#define XB_TOP      3328
#define XB_TOPGEN   3392
#define XCD_BAR_WORDS 3456
#define XB_SPIN_CAP (1u << 18)
__device__ __forceinline__ unsigned xb_ld(unsigned* p)              { return __hip_atomic_load(p, __ATOMIC_RELAXED, __HIP_MEMORY_SCOPE_AGENT); }
__device__ __forceinline__ unsigned xb_add(unsigned* p, unsigned v) { return __hip_atomic_fetch_add(p, v, __ATOMIC_RELAXED, __HIP_MEMORY_SCOPE_AGENT); }
__device__ __forceinline__ unsigned xb_xcc_id() { return (unsigned)__builtin_amdgcn_s_getreg((3 << 11) | 20) & 0xFu; }
#define XB_SPIN(cond, bar) do { unsigned _sp = 0; while (cond) { __builtin_amdgcn_s_sleep(1); \
    if ((++_sp & 255u) == 0u) { if (xb_ld(&(bar)[XB_TMO])) break; if (_sp > XB_SPIN_CAP) { atomicAdd(&(bar)[XB_TMO], 1u); break; } } } } while (0)
struct XcdBarrier { unsigned* bar; unsigned x; volatile LAS unsigned* st; int wave; };
__device__ __forceinline__ XcdBarrier xcd_barrier_post(unsigned* bar, volatile LAS unsigned* st, int wave) {
    XcdBarrier b; b.bar = bar; b.x = xb_xcc_id(); b.st = st; b.wave = wave;
    if (wave == 0 && lane_id() == 0) (void)xb_add(&bar[XB_XCNT(b.x)], 1u);
    return b;
}
__device__ __forceinline__ void xcd_barrier_complete(unsigned* bar, unsigned x, unsigned& nloc, unsigned& nx) {
    const unsigned G = gridDim.x * gridDim.y * gridDim.z;
    unsigned sum, cnt, mine, sp = 0u;
    for (;;) {
        sum = 0u; cnt = 0u; mine = 0u;
#pragma unroll
        for (unsigned j = 0; j < 16; ++j) { const unsigned c = xb_ld(&bar[XB_XCNT(j)]); sum += c; cnt += (c > 0u) ? 1u : 0u; mine = (j == x) ? c : mine; }
        if (sum == G) break;
        __builtin_amdgcn_s_sleep(1);
        if ((++sp & 255u) == 0u) { if (xb_ld(&bar[XB_TMO])) break; if (sp > XB_SPIN_CAP) { atomicAdd(&bar[XB_TMO], 1u); break; } }
    }
    nloc = mine > 0u ? mine : 1u; nx = cnt > 0u ? cnt : 1u;
}
__device__ __forceinline__ void xcd_barrier(const XcdBarrier& b) {
    asm volatile("s_waitcnt vmcnt(0)" ::: "memory");
    __syncthreads();
    if (b.wave == 0 && lane_id() == 0) {
        unsigned* bar = b.bar;
        __builtin_amdgcn_s_waitcnt(0);
        unsigned nloc = b.st[0], nx = b.st[1];
        if (nloc == 0u) { xcd_barrier_complete(bar, b.x, nloc, nx); b.st[0] = nloc; b.st[1] = nx; }
        const unsigned old = xb_add(&bar[XB_XSUB(b.x)], 1u);
        const unsigned gen = old / nloc;
        if (old + 1u == (gen + 1u) * nloc) {
            __builtin_amdgcn_fence(__ATOMIC_RELEASE, "agent");
            asm volatile("s_waitcnt vmcnt(0)" ::: "memory");
            const unsigned og = xb_add(&bar[XB_TOP], 1u);
            const unsigned tg = og / nx;
            if (og + 1u == (tg + 1u) * nx) xb_add(&bar[XB_TOPGEN], 1u);
            else XB_SPIN(xb_ld(&bar[XB_TOPGEN]) == tg, bar);
            __builtin_amdgcn_fence(__ATOMIC_ACQUIRE, "agent");
            xb_add(&bar[XB_XGEN(b.x)], 1u);
            asm volatile("s_waitcnt vmcnt(0)" ::: "memory");
        } else {
            XB_SPIN(xb_ld(&bar[XB_XGEN(b.x)]) == gen, bar);
            __builtin_amdgcn_fence(__ATOMIC_ACQUIRE, "agent");
            asm volatile("s_waitcnt vmcnt(0)" ::: "memory");
        }
    }
    __syncthreads();
}

namespace pg8 {
constexpr int BM = 256, BK = 64, HALF = 128, HTB = HALF * BK * 2, STAGE_BYTES = 8 * HTB, NXCD = 8, WGM = 8;
__host__ __device__ __forceinline__ int lds_byte(int r, int c) { const int st = (r >> 4) * 2 + (c >> 5), rr = r & 15, cc = c & 31, ob = rr * 64 + cc * 2; return st * 1024 + (ob ^ (((ob >> 9) & 1) << 5)); }
__host__ __device__ __forceinline__ void stage_rc(int b, int& R, int& C) { const int st = b / 1024, sb = b % 1024, swz = sb ^ (((sb >> 9) & 1) << 5); R = (st >> 1) * 16 + swz / 64; C = (st & 1) * 32 + (swz % 64) / 2; }
__host__ __device__ __forceinline__ int perm32(int rho) { const int n = rho >> 4, i = rho & 15; return 8 * (i >> 2) + 4 * n + (i & 3); }

struct Unit { int pm, pn, e; };
struct Gemm { const bf16_t* A; const bf16_t* Bt; int lda, K; size_t bstride; const int* rowtab; };

struct StaticOrder {
    int nM, nN, nwg, G, c, pm0; const int* tile_e;
    __device__ void init(int nM_, int nN_, int G_, int c_, int pm0_ = 0, const int* te = nullptr) { nM = nM_; nN = nN_; nwg = nM * nN; G = G_; c = c_; pm0 = pm0_; tile_e = te; }
    template <int NN> __device__ bool next_dense(int i, Unit& u) const {
        const int L = i * G + c; if (L >= nwg) return false;
        const int wgid = (L % NXCD) * ((NTOK / 256) * NN / NXCD) + L / NXCD;
        const int gid = wgid / (WGM * NN), w = wgid % (WGM * NN);
        u.pm = gid * WGM + (w % WGM); u.pn = w / WGM; u.e = 0; return true;
    }
    __device__ bool next(int i, Unit& u) const {
        const int L = i * G + c; if (L >= nwg) return false;
        int wgid = L; { const int q = nwg / NXCD, r = nwg % NXCD, xcd = wgid % NXCD, off = wgid / NXCD; wgid = (xcd < r ? xcd * (q + 1) : r * (q + 1) + (xcd - r) * q) + off; }
        const int nig = WGM * nN, gid = wgid / nig, fm = gid * WGM, gsz = (nM - fm) < WGM ? (nM - fm) : WGM;
        u.pm = pm0 + fm + ((wgid % nig) % gsz); u.pn = (wgid % nig) / gsz;
        u.e = tile_e ? __builtin_amdgcn_readfirstlane(tile_e[u.pm]) : 0;
        return true;
    }
};

template <class Epi, bool GATHER, int ESZ = 2, int NNC = 0, int WSC = 0x7f7f7f7f  >
__device__ __forceinline__ void gemm_phase(LAS unsigned char* lds, const Gemm g, const StaticOrder& S, const Epi& E, int a_row0  , int wave_id) {
    const int wid = wave_id, wr = wid >> 2, wc = wid & 3;
    const int K = g.K, nt = K * ESZ / 128, lda = g.lda;
    const unsigned hstepA = (unsigned)(HALF * lda * ESZ), hstepB = (unsigned)(HALF * K * ESZ);
    const unsigned ldsw0 = (unsigned)wid * 1024u;
    const __amdgpu_buffer_rsrc_t rsA = __builtin_amdgcn_make_buffer_rsrc((void*)g.A, (short)0, 0x7ffffff0, 0x00020000);
    const __amdgpu_buffer_rsrc_t rsB = __builtin_amdgcn_make_buffer_rsrc((void*)g.Bt, (short)0, 0x7ffffff0, 0x00020000);
#define PG8_SA(b, h) (((b) * 2 + (h)) * HTB)
#define PG8_SB(b, h) ((4 + (b) * 2 + (h)) * HTB)
#define PG8_STAGE_B(bufoff, soff) do { _Pragma("unroll") for (int _i = 0; _i < 2; ++_i) \
        __builtin_amdgcn_raw_ptr_buffer_load_lds(rsB, (LAS unsigned*)(lds + (bufoff) + ldsw + _i * 8192), 16, voffB[_i], (soff), 0, 0); } while (0)
#define PG8_STAGE_A(bufoff, abase, h, kofs, VO) do { _Pragma("unroll") for (int _i = 0; _i < 2; ++_i) { if constexpr (GATHER) \
        __builtin_amdgcn_raw_ptr_buffer_load_lds(rsA, (LAS unsigned*)(lds + (bufoff) + ldsw + _i * 8192), 16, VO[h][_i], (kofs), 0, 0); else \
        __builtin_amdgcn_raw_ptr_buffer_load_lds(rsA, (LAS unsigned*)(lds + (bufoff) + ldsw + _i * 8192), 16, voffA[_i], (abase) + (h) * hstepA + (kofs), 0, 0); } } while (0)
#define PG8_LD1(base, i) __builtin_shufflevector(*(const LAS v4i_t*)(lds + (base) + (i) * 2048), *(const LAS v4i_t*)(lds + (base) + (i) * 2048 + 1024), 0, 1, 2, 3, 4, 5, 6, 7)
#define PG8_LD1H(off, i) __builtin_shufflevector(*(const LAS v4i_t*)(ldsB + (off) + (i) * 2048), *(const LAS v4i_t*)(ldsB + (off) + (i) * 2048 + 1024), 0, 1, 2, 3, 4, 5, 6, 7)
#define PG8_LDA(dst, b, h) do { _Pragma("unroll") for (int m = 0; m < 4; ++m) dst[m] = PG8_LD1(PG8_SA(b, h) + aoff, m); } while (0)
#define PG8_LDB(dst, b, h) do { _Pragma("unroll") for (int n = 0; n < 2; ++n) dst[n] = PG8_LD1H(PG8_SB(b, h) - 65536, n); } while (0)
#define PG8_LO(x) __builtin_bit_cast(bf16x8, __builtin_shufflevector(x, x, 0, 1, 2, 3))
#define PG8_HI(x) __builtin_bit_cast(bf16x8, __builtin_shufflevector(x, x, 4, 5, 6, 7))
#define PG8_MMA(ai, bj, At, Bt) do { __builtin_amdgcn_s_setprio(1); if constexpr (ESZ == 2) { _Pragma("unroll") for (int m = 0; m < 4; ++m) _Pragma("unroll") for (int n = 0; n < 2; ++n) { \
        acc[ai][bj][m][n] = __builtin_amdgcn_mfma_f32_16x16x32_bf16(PG8_LO(Bt[n]), PG8_LO(At[m]), acc[ai][bj][m][n], 0, 0, 0); \
        acc[ai][bj][m][n] = __builtin_amdgcn_mfma_f32_16x16x32_bf16(PG8_HI(Bt[n]), PG8_HI(At[m]), acc[ai][bj][m][n], 0, 0, 0); } } \
        else { _Pragma("unroll") for (int m = 0; m < 4; ++m) _Pragma("unroll") for (int n = 0; n < 2; ++n) \
        acc[ai][bj][m][n] = __builtin_amdgcn_mfma_scale_f32_16x16x128_f8f6f4(Bt[n], At[m], acc[ai][bj][m][n], 0, 0, 0, WSC, 0, 0x7f7f7f7f); } \
        __builtin_amdgcn_s_setprio(0); } while (0)
#define PG8_WAIT_V(n) asm volatile("s_waitcnt vmcnt(" #n ")" ::: "memory")
#define PG8_WAIT_L(n) asm volatile("s_waitcnt lgkmcnt(" #n ")" ::: "memory")
#define PG8_BAR __builtin_amdgcn_s_barrier()
#define PG8_SCHED __builtin_amdgcn_sched_barrier(0)
    Unit cur, nxt; int ui = 0;
    if (!(NNC > 0 ? S.template next_dense<NNC ? NNC : 1>(0, cur) : S.next(0, cur))) return;
    f32x4 acc[2][2][4][2];
    v8i_t At[4], B0[2], B1[2];
    unsigned voC[2][2];
    LAS int* rtab = (LAS int*)(lds + RING_BYTES);
#pragma unroll
    for (int h = 0; h < 2; ++h)
#pragma unroll
        for (int i = 0; i < 2; ++i) voC[h][i] = 0;
    unsigned cA = (unsigned)((cur.pm * BM - a_row0) * lda * ESZ), cB = (unsigned)((cur.e * (int)g.bstride + cur.pn * BM * K) * ESZ);
    for (;;) {
        float zr; asm volatile("v_mov_b32 %0, 0" : "=v"(zr));
#pragma unroll
        for (int a = 0; a < 2; ++a)
#pragma unroll
            for (int b = 0; b < 2; ++b)
#pragma unroll
                for (int m = 0; m < 4; ++m)
#pragma unroll
                    for (int n = 0; n < 2; ++n) { acc[a][b][m][n] = (f32x4){zr, zr, zr, zr}; }
        const int lane = lane_id_v(), tid = wid * 64 + lane, fr = lane & 15, fq = lane >> 4;
        unsigned voffA[2], voffB[2];
#pragma unroll
        for (int i = 0; i < 2; ++i) { int R_, C_; stage_rc(tid * 16 + i * 8192, R_, C_); voffA[i] = (unsigned)(R_ * lda * ESZ + C_ * 2); voffB[i] = (unsigned)(R_ * K * ESZ + C_ * 2); }
        const int aoff = lds_byte(wr * 64 + fr, fq * 8), boff = lds_byte(wc * 32 + fr, fq * 8);
        LAS unsigned char* ldsB = lds + 65536 + boff;
        if (ui == 0) {
            const unsigned ldsw = ldsw0;
            if constexpr (GATHER) {
#pragma unroll
                for (int h = 0; h < 2; ++h)
#pragma unroll
                    for (int i = 0; i < 2; ++i) { int R_, C_; stage_rc(tid * 16 + i * 8192, R_, C_); int t = g.rowtab[cur.pm * BM + h * HALF + R_]; t = t < 0 ? 0 : t; voC[h][i] = (unsigned)t * (unsigned)(lda * ESZ) + (unsigned)C_ * 2u; }
                VM_WAIT();
            }
            PG8_STAGE_B(PG8_SB(0, 0), cB); PG8_STAGE_B(PG8_SB(0, 1), cB + hstepB); PG8_STAGE_A(PG8_SA(0, 0), cA, 0, 0u, voC); PG8_STAGE_A(PG8_SA(0, 1), cA, 1, 0u, voC);
            if (wr == 1) PG8_BAR;
            PG8_WAIT_V(2); PG8_BAR;
            PG8_STAGE_B(PG8_SB(1, 0), cB + 128u); PG8_STAGE_A(PG8_SA(1, 0), cA, 0, 128u, voC); PG8_STAGE_B(PG8_SB(1, 1), cB + hstepB + 128u);
            PG8_WAIT_V(6); PG8_BAR;
        }
        const bool has_next = NNC > 0 ? S.template next_dense<NNC ? NNC : 1>(ui + 1, nxt) : S.next(ui + 1, nxt);
        const unsigned nA = has_next ? (unsigned)((nxt.pm * BM - a_row0) * lda * ESZ) : cA, nB = has_next ? (unsigned)((nxt.e * (int)g.bstride + nxt.pn * BM * K) * ESZ) : cB;
        if constexpr (GATHER) {
            if (has_next && wid == 0) __builtin_amdgcn_global_load_lds((const unsigned*)(g.rowtab + nxt.pm * BM + lane * 4), (LAS unsigned*)(lds + RING_BYTES + ((ui + 1) & 1) * 1024), 16, 0, 0);
        }
#pragma unroll 1
        for (int t = 0; t < nt; t += 2) {
            unsigned ldsw = ldsw0; asm volatile("" : "+s"(ldsw));
            int last_i = __builtin_amdgcn_readfirstlane((t == nt - 2) ? 1 : 0); asm volatile("" : "+s"(last_i));
            const bool last = last_i != 0;
            const unsigned k1 = (unsigned)(t + 1) * 128u;
            const unsigned a2 = last ? nA : cA, k2 = last ? 0u : (unsigned)(t + 2) * 128u;
            const unsigned b2 = last ? nB : cB + (unsigned)(t + 2) * 128u;
            const unsigned b3 = b2 + 128u, k3 = k2 + 128u;
            PG8_LDB(B0, 0, 0); PG8_LDB(B1, 0, 1); PG8_SCHED; PG8_LDA(At, 0, 0); PG8_STAGE_A(PG8_SA(1, 1), cA, 1, k1, voC);
            PG8_WAIT_V(8); PG8_WAIT_L(0); PG8_BAR; PG8_MMA(0, 0, At, B0); PG8_MMA(0, 1, At, B1); PG8_BAR; PG8_SCHED;
            if constexpr (GATHER) {
                if (last && has_next) {
#pragma unroll
                    for (int h = 0; h < 2; ++h)
#pragma unroll
                        for (int i = 0; i < 2; ++i) { int R_, C_; stage_rc(tid * 16 + i * 8192, R_, C_); int tk = rtab[((ui + 1) & 1) * 256 + h * HALF + R_]; tk = tk < 0 ? 0 : tk; voC[h][i] = (unsigned)tk * (unsigned)(lda * ESZ) + (unsigned)C_ * 2u; }
                }
            }
            PG8_LDA(At, 0, 1); PG8_STAGE_B(PG8_SB(0, 0), b2); PG8_STAGE_B(PG8_SB(0, 1), b2 + hstepB);
            PG8_STAGE_A(PG8_SA(0, 0), a2, 0, k2, voC);
            PG8_WAIT_V(8); PG8_WAIT_L(0); PG8_BAR; PG8_MMA(1, 0, At, B0); PG8_MMA(1, 1, At, B1); PG8_BAR; PG8_SCHED;
            PG8_LDB(B0, 1, 0); PG8_LDB(B1, 1, 1); PG8_SCHED; PG8_LDA(At, 1, 0);
            PG8_STAGE_A(PG8_SA(0, 1), a2, 1, k2, voC);
            PG8_WAIT_V(8); PG8_WAIT_L(0); PG8_BAR; PG8_MMA(0, 0, At, B0); PG8_MMA(0, 1, At, B1); PG8_BAR; PG8_SCHED;
            PG8_LDA(At, 1, 1); PG8_STAGE_B(PG8_SB(1, 0), b3); PG8_STAGE_B(PG8_SB(1, 1), b3 + hstepB);
            PG8_STAGE_A(PG8_SA(1, 0), a2, 0, k3, voC);
            PG8_WAIT_V(8); PG8_WAIT_L(0); PG8_BAR; PG8_MMA(1, 0, At, B0); PG8_MMA(1, 1, At, B1); PG8_BAR; PG8_SCHED;
        }
        if (wr == 0) PG8_BAR;
        { const int l2 = lane_id_v(); E(acc, cur, wr, wc, l2 & 15, l2 >> 4); }
        if (!has_next) break;
        cur = nxt; cA = nA; cB = nB; ++ui;
        if (wr == 1) PG8_BAR;
    }
    PG8_WAIT_V(0);
    PG8_BAR;
#undef PG8_SA
#undef PG8_SB
#undef PG8_STAGE_A
#undef PG8_STAGE_B
#undef PG8_LD1
#undef PG8_LD1H
#undef PG8_LDA
#undef PG8_LDB
#undef PG8_LO
#undef PG8_HI
#undef PG8_MMA
#undef PG8_WAIT_V
#undef PG8_WAIT_L
#undef PG8_BAR
#undef PG8_SCHED
}


struct EpiBf16 {
    bf16_t* O; int ldc; float sc;
    __device__ __forceinline__ void operator()(const f32x4 (&acc)[2][2][4][2], const Unit& u, int wr, int wc, int fr, int fq) const {
        const int row0 = u.pm * BM + wr * 64 + fr, col0 = u.pn * BM + wc * 32 + 8 * fq;
#pragma unroll
        for (int ai = 0; ai < 2; ++ai)
#pragma unroll
            for (int m = 0; m < 4; ++m) { bf16_t* rowp = O + (size_t)(row0 + ai * HALF + m * 16) * ldc + col0;
#pragma unroll
                for (int bj = 0; bj < 2; ++bj) { const f32x4 v0 = acc[ai][bj][m][0] * sc, v1 = acc[ai][bj][m][1] * sc;
                    u32x4 w; w.x = cvt_pk_bf16(v0[0], v0[1]); w.y = cvt_pk_bf16(v0[2], v0[3]); w.z = cvt_pk_bf16(v1[0], v1[1]); w.w = cvt_pk_bf16(v1[2], v1[3]);
                    *(u32x4*)(rowp + bj * HALF) = w; } }
    }
};
struct EpiProj1 {
    bf16_t* O; float* SS; LAS float* part; const float* ssx;
    __device__ __forceinline__ void operator()(const f32x4 (&acc)[2][2][4][2], const Unit& u, int wr, int wc, int fr, int fq) const {
        const int row0 = u.pm * BM + wr * 64 + fr, col0 = u.pn * BM + wc * 32 + 8 * fq, wid = wr * 4 + wc;
        float rsv[8];
#pragma unroll
        for (int i = 0; i < 8; ++i) { const f32x4 x4 = *(const f32x4*)(ssx + (size_t)(row0 + (i >> 2) * HALF + (i & 3) * 16) * 4); rsv[i] = __builtin_amdgcn_rsqf(((x4[0] + x4[1]) + (x4[2] + x4[3])) * (1.f / DM) + EPS); }
#pragma unroll
        for (int ai = 0; ai < 2; ++ai)
#pragma unroll
            for (int m = 0; m < 4; ++m) { bf16_t* rowp = O + (size_t)(row0 + ai * HALF + m * 16) * L1_INP + col0;
                const float rstd = rsv[ai * 4 + m];
#pragma unroll
                for (int bj = 0; bj < 2; ++bj) { const f32x4 v0 = acc[ai][bj][m][0] * rstd, v1 = acc[ai][bj][m][1] * rstd;
                    u32x4 w; w.x = cvt_pk_bf16(v0[0], v0[1]); w.y = cvt_pk_bf16(v0[2], v0[3]); w.z = cvt_pk_bf16(v1[0], v1[1]); w.w = cvt_pk_bf16(v1[2], v1[3]);
                    *(u32x4*)(rowp + bj * HALF) = w;
                    float ss = (bf_lo(w.x) * bf_lo(w.x) + bf_hi(w.x) * bf_hi(w.x)) + (bf_lo(w.y) * bf_lo(w.y) + bf_hi(w.y) * bf_hi(w.y)) + (bf_lo(w.z) * bf_lo(w.z) + bf_hi(w.z) * bf_hi(w.z)) + (bf_lo(w.w) * bf_lo(w.w) + bf_hi(w.w) * bf_hi(w.w));
                    ss = fq_sum(ss);
                    if (fq == 0) part[((wid * 2 + bj) * 8 + ai * 4 + m) * 16 + fr] = ss; } }
        asm volatile("s_waitcnt lgkmcnt(0)\n\ts_barrier" ::: "memory");
        { const int t = wid * 64 + fq * 16 + fr, bj = t >> 8, wr2 = (t >> 7) & 1, am = (t >> 4) & 7, fr2 = t & 15;
          const LAS float* pp = part + ((wr2 * 4 * 2 + bj) * 8 + am) * 16 + fr2;
          const float ssum = (pp[0] + pp[2 * 8 * 16]) + (pp[2 * 2 * 8 * 16] + pp[3 * 2 * 8 * 16]);
          const int row = u.pm * BM + (am >> 2) * HALF + wr2 * 64 + (am & 3) * 16 + fr2, sl = u.pn * 2 + bj;
          SS[(size_t)row * 8 + sl + (sl >= 3 ? 1 : 0)] = ssum; }
    }
};
struct EpiBf16Row {
    bf16_t* O; int ldc; const float* rs; int which;
    __device__ __forceinline__ void operator()(const f32x4 (&acc)[2][2][4][2], const Unit& u, int wr, int wc, int fr, int fq) const {
        const int row0 = u.pm * BM + wr * 64 + fr;
        float scv[8];
#pragma unroll
        for (int i = 0; i < 8; ++i) { const f32x4 s4 = *(const f32x4*)(rs + (size_t)(row0 + (i >> 2) * HALF + (i & 3) * 16) * 8); scv[i] = __builtin_amdgcn_rsqf(((s4[0] + s4[1]) + s4[2]) * (1.f / CQ) + EPS); }
#pragma unroll
        for (int ai = 0; ai < 2; ++ai)
#pragma unroll
            for (int m = 0; m < 4; ++m) { const int row = row0 + ai * HALF + m * 16; const float sc = scv[ai * 4 + m]; const int b = row >> 11, t = row & (SEQ - 1);
#pragma unroll
                for (int bj = 0; bj < 2; ++bj) { const f32x4 v0 = acc[ai][bj][m][0] * sc, v1 = acc[ai][bj][m][1] * sc;
                    u32x4 w; w.x = cvt_pk_bf16(v0[0], v0[1]); w.y = cvt_pk_bf16(v0[2], v0[3]); w.z = cvt_pk_bf16(v1[0], v1[1]); w.w = cvt_pk_bf16(v1[2], v1[3]);
                    const int col = u.pn * BM + bj * HALF + wc * 32 + 8 * fq;
                    bf16_t* dst;
                    if (which == 0) { const int hd = col / 96, d = col - hd * 96; dst = O + (((size_t)b * 16 + hd) * SEQ + t) * 96 + d; }
                    else { const int hd = col >> 7, d = col & 127;
                        dst = d < 64 ? O + (size_t)row * 1024 + hd * 64 + d : O + (size_t)NTOK * 1024 + (((size_t)b * 16 + hd) * SEQ + t) * 64 + (d - 64); }
                    *(u32x4*)dst = w; } }
    }
};
template <bool RB, bool OB, bool ST = false>
struct EpiRes {
    const void* res; void* out; bool dry; float* SS; LAS float* part;
    __device__ __forceinline__ void operator()(const f32x4 (&acc)[2][2][4][2], const Unit& u, int wr, int wc, int fr, int fq) const {
        const int row0 = u.pm * BM + wr * 64 + fr, col0 = u.pn * BM + wc * 32 + 8 * fq;
#pragma unroll
        for (int ai = 0; ai < 2; ++ai) {
            u32x4 xb_[4][2]; f32x4 xf_[4][2][2];
#pragma unroll
            for (int m = 0; m < 4; ++m)
#pragma unroll
                for (int bj = 0; bj < 2; ++bj) { const size_t o = (size_t)(row0 + ai * HALF + m * 16) * DM + col0 + bj * HALF;
                    if constexpr (RB) xb_[m][bj] = *(const u32x4*)((const bf16_t*)res + o); else { xf_[m][bj][0] = *(const f32x4*)((const float*)res + o); xf_[m][bj][1] = *(const f32x4*)((const float*)res + o + 4); } }
            __builtin_amdgcn_sched_barrier(0);
#pragma unroll
            for (int m = 0; m < 4; ++m) { const size_t off = (size_t)(row0 + ai * HALF + m * 16) * DM + col0; float ssr = 0.f;
#pragma unroll
                for (int bj = 0; bj < 2; ++bj) { const size_t o = off + bj * HALF;
                    f32x4 r0, r1;
                    if constexpr (RB) { const u32x4 x = xb_[m][bj]; r0 = (f32x4){bf_lo(x.x), bf_hi(x.x), bf_lo(x.y), bf_hi(x.y)}; r1 = (f32x4){bf_lo(x.z), bf_hi(x.z), bf_lo(x.w), bf_hi(x.w)}; }
                    else { r0 = xf_[m][bj][0]; r1 = xf_[m][bj][1]; }
                    r0 += acc[ai][bj][m][0]; r1 += acc[ai][bj][m][1];
                    if (!dry) {
                        if constexpr (OB) { u32x4 w; w.x = cvt_pk_bf16(r0[0], r0[1]); w.y = cvt_pk_bf16(r0[2], r0[3]); w.z = cvt_pk_bf16(r1[0], r1[1]); w.w = cvt_pk_bf16(r1[2], r1[3]); *(u32x4*)((bf16_t*)out + o) = w;
                            if constexpr (ST) ssr += (bf_lo(w.x) * bf_lo(w.x) + bf_hi(w.x) * bf_hi(w.x)) + (bf_lo(w.y) * bf_lo(w.y) + bf_hi(w.y) * bf_hi(w.y)) + (bf_lo(w.z) * bf_lo(w.z) + bf_hi(w.z) * bf_hi(w.z)) + (bf_lo(w.w) * bf_lo(w.w) + bf_hi(w.w) * bf_hi(w.w)); }
                        else { *(f32x4*)((float*)out + o) = r0; *(f32x4*)((float*)out + o + 4) = r1; } } }
                if constexpr (ST) { ssr = fq_sum(ssr); if (fq == 0) part[((wr * 4 + wc) * 8 + ai * 4 + m) * 16 + fr] = ssr; } }
        }
        if constexpr (ST) {
            asm volatile("s_waitcnt lgkmcnt(0)\n\ts_barrier" ::: "memory");
            const int t = (wr * 4 + wc) * 64 + fq * 16 + fr;
            if (t < 256) { const int wr2 = t >> 7, am = (t >> 4) & 7, fr2 = t & 15; const LAS float* pp = part + (wr2 * 4 * 8 + am) * 16 + fr2;
                const float ssum = (pp[0] + pp[8 * 16]) + (pp[2 * 8 * 16] + pp[3 * 8 * 16]);
                SS[(size_t)(u.pm * BM + (am >> 2) * HALF + wr2 * 64 + (am & 3) * 16 + fr2) * 4 + u.pn] = ssum; }
        }
    }
};
struct EpiSwiGLU {
    bf16_t* H; int ldc; int row_sub; const float* ss;
    __device__ __forceinline__ void operator()(const f32x4 (&acc)[2][2][4][2], const Unit& u, int wr, int wc, int fr, int fq) const {
        const int row0 = u.pm * BM - row_sub + wr * 64 + fr, col0 = u.pn * HALF + wc * 32 + 8 * fq;
        float rsv[8];
#pragma unroll
        for (int i = 0; i < 8; ++i) { const f32x4 s4 = *(const f32x4*)(ss + (size_t)(row0 + (i >> 2) * HALF + (i & 3) * 16) * 4); rsv[i] = __builtin_amdgcn_rsqf(((s4[0] + s4[1]) + (s4[2] + s4[3])) * (1.f / DM) + EPS); }
#pragma unroll
        for (int ai = 0; ai < 2; ++ai)
#pragma unroll
            for (int m = 0; m < 4; ++m) { bf16_t* rowp = H + (size_t)(row0 + ai * HALF + m * 16) * ldc + col0;
                const float rstd = rsv[ai * 4 + m];
                float r[8];
#pragma unroll
                for (int n = 0; n < 2; ++n)
#pragma unroll
                    for (int j = 0; j < 4; ++j) { const float gt = acc[ai][0][m][n][j] * rstd, up = acc[ai][1][m][n][j] * rstd;
                        r[n * 4 + j] = gt * __builtin_amdgcn_rcpf(1.0f + __builtin_amdgcn_exp2f(-gt * LOG2E)) * up; }
                u32x4 w; w.x = cvt_pk_bf16(r[0], r[1]); w.y = cvt_pk_bf16(r[2], r[3]); w.z = cvt_pk_bf16(r[4], r[5]); w.w = cvt_pk_bf16(r[6], r[7]);
                *(u32x4*)rowp = w; }
    }
};
struct EpiSwiGLU8 {
    unsigned char* H; int ldc; bool dry;
    __device__ __forceinline__ void operator()(const f32x4 (&acc)[2][2][4][2], const Unit& u, int wr, int wc, int fr, int fq) const {
        const int row0 = u.pm * BM + wr * 64 + fr, col0 = u.pn * HALF + wc * 32 + 8 * fq;
#pragma unroll
        for (int ai = 0; ai < 2; ++ai)
#pragma unroll
            for (int m = 0; m < 4; ++m) { unsigned char* rowp = H + (size_t)(row0 + ai * HALF + m * 16) * ldc + col0;
                float r[8];
#pragma unroll
                for (int n = 0; n < 2; ++n)
#pragma unroll
                    for (int j = 0; j < 4; ++j) { const float ga = acc[ai][0][m][n][j], ua = acc[ai][1][m][n][j];
                        const float e = __builtin_amdgcn_exp2f(-ga); const float q = __builtin_amdgcn_rcpf(__builtin_fmaf(e, LOG2E, LOG2E));
                        r[n * 4 + j] = __builtin_amdgcn_fmed3f((ga * ua) * q, -448.f, 448.f); }
                u32x2 w; w.x = pk4_fp8(r[0], r[1], r[2], r[3]); w.y = pk4_fp8(r[4], r[5], r[6], r[7]);
                if (!dry) *(u32x2*)rowp = w; }
    }
};
struct EpiQKV0 {
    bf16_t* O; const float* cosT; const float* sinT;
    const float* rs0;
    const float* g_aq; const float* g_ak; const float* g_bq; const float* g_bk;
    __device__ __forceinline__ void operator()(const f32x4 (&acc)[2][2][4][2], const Unit& u, int wr, int wc, int fr, int fq) const {
        const int hd = u.pn * 4 + wc;
        const float* g = hd < 8 ? g_aq : hd < 10 ? g_ak : hd < 12 ? nullptr : hd < 20 ? g_bq : hd < 28 ? g_bk : nullptr;
        const float qs = (hd < 8 || (hd >= 12 && hd < 20)) ? 0.125f * LOG2E : 1.0f;
        const int row0 = u.pm * BM + wr * 64 + fr;
        float r0v[8];
#pragma unroll
        for (int i = 0; i < 8; ++i) r0v[i] = rs0[row0 + (i >> 2) * HALF + (i & 3) * 16];
        if (g == nullptr) {
#pragma unroll
            for (int ai = 0; ai < 2; ++ai)
#pragma unroll
                for (int m = 0; m < 4; ++m) { const int row_ = row0 + ai * HALF + m * 16; bf16_t* rowp = O + (((size_t)(row_ >> 11) * 36 + hd) * SEQ + (row_ & (SEQ - 1))) * 64 + 8 * fq; const float r0 = r0v[ai * 4 + m];
#pragma unroll
                    for (int bj = 0; bj < 2; ++bj) { const f32x4 v0 = acc[ai][bj][m][0] * r0, v1 = acc[ai][bj][m][1] * r0;
                        u32x4 w; w.x = cvt_pk_bf16(v0[0], v0[1]); w.y = cvt_pk_bf16(v0[2], v0[3]); w.z = cvt_pk_bf16(v1[0], v1[1]); w.w = cvt_pk_bf16(v1[2], v1[3]);
                        *(u32x4*)(rowp + bj * 32) = w; } }
            return;
        }
        f32x4 gl[2], gh[2];
#pragma unroll
        for (int n = 0; n < 2; ++n) { gl[n] = *(const f32x4*)(g + 8 * fq + 4 * n); gh[n] = *(const f32x4*)(g + 32 + 8 * fq + 4 * n); }
        f32x4 ctb[2][2], stb[2][2];
#pragma unroll
        for (int n = 0; n < 2; ++n) { ctb[0][n] = *(const f32x4*)(cosT + (size_t)row0 * 32 + 8 * fq + 4 * n); stb[0][n] = *(const f32x4*)(sinT + (size_t)row0 * 32 + 8 * fq + 4 * n); }
#pragma unroll
        for (int ai = 0; ai < 2; ++ai)
#pragma unroll
            for (int m = 0; m < 4; ++m) {
                const int row = row0 + ai * HALF + m * 16, cb_ = (ai * 4 + m) & 1;
                if (ai * 4 + m < 7) { const int nr = row0 + ((ai * 4 + m + 1) >> 2) * HALF + ((ai * 4 + m + 1) & 3) * 16;
#pragma unroll
                    for (int n = 0; n < 2; ++n) { ctb[cb_ ^ 1][n] = *(const f32x4*)(cosT + (size_t)nr * 32 + 8 * fq + 4 * n); stb[cb_ ^ 1][n] = *(const f32x4*)(sinT + (size_t)nr * 32 + 8 * fq + 4 * n); } }
                __builtin_amdgcn_sched_barrier(0);
                float ss = 0.f;
#pragma unroll
                for (int bj = 0; bj < 2; ++bj)
#pragma unroll
                    for (int n = 0; n < 2; ++n) { const f32x4 x = acc[ai][bj][m][n]; ss += (x[0] * x[0] + x[1] * x[1]) + (x[2] * x[2] + x[3] * x[3]); }
                ss = fq_sum(ss);
                const float r0 = r0v[ai * 4 + m]; const float rstd = r0 * __builtin_amdgcn_rsqf(ss * (r0 * r0) * (1.0f / 64.0f) + EPS);
                float lo[8], hi[8];
#pragma unroll
                for (int n = 0; n < 2; ++n) { const f32x4 c = ctb[cb_][n], s = stb[cb_][n];
#pragma unroll
                    for (int j = 0; j < 4; ++j) { const float a = acc[ai][0][m][n][j] * rstd * gl[n][j], b = acc[ai][1][m][n][j] * rstd * gh[n][j];
                        lo[n * 4 + j] = (a * c[j] - b * s[j]) * qs; hi[n * 4 + j] = (b * c[j] + a * s[j]) * qs; } }
                bf16_t* rowp = O + (((size_t)(row >> 11) * 36 + hd) * SEQ + (row & (SEQ - 1))) * 64 + 8 * fq;
                u32x4 w; w.x = cvt_pk_bf16(lo[0], lo[1]); w.y = cvt_pk_bf16(lo[2], lo[3]); w.z = cvt_pk_bf16(lo[4], lo[5]); w.w = cvt_pk_bf16(lo[6], lo[7]);
                *(u32x4*)rowp = w;
                w.x = cvt_pk_bf16(hi[0], hi[1]); w.y = cvt_pk_bf16(hi[2], hi[3]); w.z = cvt_pk_bf16(hi[4], hi[5]); w.w = cvt_pk_bf16(hi[6], hi[7]);
                *(u32x4*)(rowp + 32) = w;
            }
    }
};
struct EpiKV1 {
    bf16_t* Ko; bf16_t* Vo; const float* rs; const bf16_t* P1; const float* cc; const float* sc; const float* gk;
    __device__ __forceinline__ void operator()(const f32x4 (&acc)[2][2][4][2], const Unit& u, int wr, int wc, int fr, int fq) const {
        const int hd = 2 * u.pn + (wc & 1);
        const int row0 = u.pm * BM + wr * 64 + fr;
        float sv[8];
#pragma unroll
        for (int i = 0; i < 8; ++i) { const f32x2 s2 = *(const f32x2*)(rs + (size_t)(row0 + (i >> 2) * HALF + (i & 3) * 16) * 8 + 4); sv[i] = __builtin_amdgcn_rsqf((s2[0] + s2[1]) * (1.f / CKV) + EPS); }
        if (wc >= 2) {
#pragma unroll
            for (int ai = 0; ai < 2; ++ai)
#pragma unroll
                for (int m = 0; m < 4; ++m) { const int row = row0 + ai * HALF + m * 16; const float s = sv[ai * 4 + m];
                    bf16_t* dst = Vo + (((size_t)(row >> 11) * 16 + hd) * SEQ + (row & (SEQ - 1))) * 64 + 8 * fq;
#pragma unroll
                    for (int bj = 0; bj < 2; ++bj) { const f32x4 v0 = acc[ai][bj][m][0] * s, v1 = acc[ai][bj][m][1] * s;
                        u32x4 w; w.x = cvt_pk_bf16(v0[0], v0[1]); w.y = cvt_pk_bf16(v0[2], v0[3]); w.z = cvt_pk_bf16(v1[0], v1[1]); w.w = cvt_pk_bf16(v1[2], v1[3]);
                        *(u32x4*)(dst + bj * 32) = w; } }
            return;
        }
        f32x4 gl[2], gh[2];
#pragma unroll
        for (int n = 0; n < 2; ++n) { gl[n] = *(const f32x4*)(gk + 8 * fq + 4 * n); gh[n] = *(const f32x4*)(gk + 32 + 8 * fq + 4 * n); }
        const f32x4 gr0 = *(const f32x4*)(gk + 64 + 4 * fq), gr1 = *(const f32x4*)(gk + 80 + 4 * fq);
#pragma unroll
        for (int ai2 = 0; ai2 < 4; ++ai2) { const int ai = ai2 >> 1, mh = ai2 & 1;
            u32x2 kr0v[2], kr1v[2]; f32x4 csv[2], snv[2];
#pragma unroll
            for (int m2 = 0; m2 < 2; ++m2) { const int row = row0 + ai * HALF + (2 * mh + m2) * 16; const bf16_t* kp = P1 + (size_t)row * L1_INP + CQ + CKV + 4 * fq;
                kr0v[m2] = *(const u32x2*)kp; kr1v[m2] = *(const u32x2*)(kp + 16); csv[m2] = *(const f32x4*)(cc + (size_t)row * 16 + 4 * fq); snv[m2] = *(const f32x4*)(sc + (size_t)row * 16 + 4 * fq); }
            __builtin_amdgcn_sched_barrier(0);
#pragma unroll
            for (int m2 = 0; m2 < 2; ++m2) { const int m = 2 * mh + m2;
                const int row = row0 + ai * HALF + m * 16; const float s = sv[ai * 4 + m];
                const u32x2 kr0 = kr0v[m2], kr1 = kr1v[m2];
                const f32x4 cs = csv[m2], sn = snv[m2];
                const f32x4 ra = (f32x4){bf_lo(kr0.x), bf_hi(kr0.x), bf_lo(kr0.y), bf_hi(kr0.y)}, rb = (f32x4){bf_lo(kr1.x), bf_hi(kr1.x), bf_lo(kr1.y), bf_hi(kr1.y)};
                float ss = (ra[0] * ra[0] + ra[1] * ra[1]) + (ra[2] * ra[2] + ra[3] * ra[3]) + (rb[0] * rb[0] + rb[1] * rb[1]) + (rb[2] * rb[2] + rb[3] * rb[3]);
#pragma unroll
                for (int bj = 0; bj < 2; ++bj)
#pragma unroll
                    for (int n = 0; n < 2; ++n) { const f32x4 x = acc[ai][bj][m][n] * s; ss += (x[0] * x[0] + x[1] * x[1]) + (x[2] * x[2] + x[3] * x[3]); }
                ss = fq_sum(ss);
                const float rstd = __builtin_amdgcn_rsqf(ss * (1.0f / 96.0f) + EPS), rl = rstd * s;
                bf16_t* dst = Ko + (((size_t)(row >> 11) * 16 + hd) * SEQ + (row & (SEQ - 1))) * 96;
                { const f32x4 a0 = acc[ai][0][m][0] * rl * gl[0], a1 = acc[ai][0][m][1] * rl * gl[1], b0 = acc[ai][1][m][0] * rl * gh[0], b1 = acc[ai][1][m][1] * rl * gh[1];
                  u32x4 w; w.x = cvt_pk_bf16(a0[0], a0[1]); w.y = cvt_pk_bf16(a0[2], a0[3]); w.z = cvt_pk_bf16(a1[0], a1[1]); w.w = cvt_pk_bf16(a1[2], a1[3]);
                  *(u32x4*)(dst + 8 * fq) = w;
                  w.x = cvt_pk_bf16(b0[0], b0[1]); w.y = cvt_pk_bf16(b0[2], b0[3]); w.z = cvt_pk_bf16(b1[0], b1[1]); w.w = cvt_pk_bf16(b1[2], b1[3]);
                  *(u32x4*)(dst + 32 + 8 * fq) = w; }
                { const f32x4 a = ra * rstd * gr0, b = rb * rstd * gr1; const f32x4 oa = a * cs - b * sn, ob = b * cs + a * sn;
                  u32x2 p; p.x = cvt_pk_bf16(oa[0], oa[1]); p.y = cvt_pk_bf16(oa[2], oa[3]); *(u32x2*)(dst + 64 + 4 * fq) = p;
                  p.x = cvt_pk_bf16(ob[0], ob[1]); p.y = cvt_pk_bf16(ob[2], ob[3]); *(u32x2*)(dst + 80 + 4 * fq) = p; }
            }
        }
    }
};
}

__device__ __forceinline__ void dma_piece(__amdgpu_buffer_rsrc_t rs, unsigned lds_dst, unsigned voff, unsigned soff) {
    asm volatile("s_mov_b32 m0, %0\n\ts_nop 0\n\tbuffer_load_dwordx4 %1, %2, %3 offen lds" :: "s"(lds_dst), "v"(voff), "s"(rs), "s"(soff) : "m0", "memory");
}
__device__ __forceinline__ int crow(int r, int hi) { return (r & 3) + 8 * (r >> 2) + 4 * hi; }
typedef short v4i16_t __attribute__((ext_vector_type(4)));
__device__ __forceinline__ s16x4 vtr(LAS unsigned char* p) { return __builtin_bit_cast(s16x4, __builtin_amdgcn_ds_read_tr16_b64_v4i16((LAS v4i16_t*)p)); }
constexpr float ATT_THR = 8.0f, ATT_FIX_BOUND = 60.0f;
template <int DQK, bool TWO, bool FIXREF>
__device__ __forceinline__ void attn_step(LAS unsigned char* kp0, LAS unsigned char* kp1, int ke0, int ke1, LAS unsigned char* vp0, LAS unsigned char* vp1, int vd0,
                                          const bf16x8 (&qf)[DQK / 16], f32x16& negm, float& mref, float& l, f32x16& o0, f32x16& o1,
                                          bool mask0, bool mask1, int qidx, int kidx0, int maxd, int hi) {
    f32x16 s0, s1;
    const f32x16 zf = (f32x16){0.f, 0.f, 0.f, 0.f, 0.f, 0.f, 0.f, 0.f, 0.f, 0.f, 0.f, 0.f, 0.f, 0.f, 0.f, 0.f};
    if constexpr (FIXREF) { s1 = zf; } else { s0 = negm; s1 = negm; }
    bf16x8 kfa[DQK / 16];
#pragma unroll
    for (int kk = 0; kk < DQK / 16; ++kk) kfa[kk] = *(const LAS bf16x8*)(kp0 + (kk >> 1) * 1024 + ((kk & 1) ? ke1 : ke0));
#pragma unroll
    for (int kk = 0; kk < DQK / 16; ++kk) s0 = __builtin_amdgcn_mfma_f32_32x32x16_bf16(kfa[kk], qf[kk], (FIXREF && kk == 0) ? zf : s0, 0, 0, 0);
    if constexpr (TWO) {
#pragma unroll
        for (int kk = 0; kk < DQK / 16; ++kk) kfa[kk] = *(const LAS bf16x8*)(kp1 + (kk >> 1) * 1024 + ((kk & 1) ? ke1 : ke0));
#pragma unroll
        for (int kk = 0; kk < DQK / 16; ++kk) s1 = __builtin_amdgcn_mfma_f32_32x32x16_bf16(kfa[kk], qf[kk], (FIXREF && kk == 0) ? zf : s1, 0, 0, 0);
    }
    if (mask0) {
#pragma unroll
        for (int r = 0; r < 16; ++r) { const int d = qidx - (kidx0 + crow(r, hi)); if (d < 0 || d > maxd) s0[r] = -INFINITY; }
    }
    if constexpr (TWO) { if (mask1) {
#pragma unroll
        for (int r = 0; r < 16; ++r) { const int d = qidx - (kidx0 + 32 + crow(r, hi)); if (d < 0 || d > maxd) s1[r] = -INFINITY; }
    } }
    if constexpr (!FIXREF) {
    float rm = fmaxf(fmaxf(s0[0], s0[1]), fmaxf(s0[2], s0[3]));
#pragma unroll
    for (int r = 4; r < 16; r += 4) rm = fmaxf(rm, fmaxf(fmaxf(s0[r], s0[r + 1]), fmaxf(s0[r + 2], s0[r + 3])));
    if constexpr (TWO) {
#pragma unroll
        for (int r = 0; r < 16; r += 4) rm = fmaxf(rm, fmaxf(fmaxf(s1[r], s1[r + 1]), fmaxf(s1[r + 2], s1[r + 3])));
    }
    rm = swap32_max(rm);
    if (__builtin_expect(__any(rm > ATT_THR), 0)) {
        const float dl = fmaxf(rm, 0.f); mref += dl;
#pragma unroll
        for (int r = 0; r < 16; ++r) { s0[r] -= dl; negm[r] -= dl; if constexpr (TWO) s1[r] -= dl; }
        const float f = __builtin_amdgcn_exp2f(-dl); l *= f;
#pragma unroll
        for (int r = 0; r < 16; ++r) { o0[r] *= f; o1[r] *= f; }
    }
    }
    float ps = 0.f;
#pragma unroll
    for (int r = 0; r < 16; ++r) { s0[r] = __builtin_amdgcn_exp2f(s0[r]); ps += s0[r]; }
    if constexpr (TWO) {
#pragma unroll
        for (int r = 0; r < 16; ++r) { s1[r] = __builtin_amdgcn_exp2f(s1[r]); ps += s1[r]; }
    }
    l += ps;
    {
        u32x4 pw0, pw1;
        pw0.x = cvt_pk_bf16(s0[0], s0[1]); pw0.y = cvt_pk_bf16(s0[2], s0[3]); pw0.z = cvt_pk_bf16(s0[4], s0[5]); pw0.w = cvt_pk_bf16(s0[6], s0[7]);
        pw1.x = cvt_pk_bf16(s0[8], s0[9]); pw1.y = cvt_pk_bf16(s0[10], s0[11]); pw1.z = cvt_pk_bf16(s0[12], s0[13]); pw1.w = cvt_pk_bf16(s0[14], s0[15]);
        const bf16x8 pf0 = __builtin_bit_cast(bf16x8, pw0), pf1 = __builtin_bit_cast(bf16x8, pw1);
#pragma unroll
        for (int ks = 0; ks < 2; ++ks) {
            const s16x4 a0 = vtr(vp0 + ks * 1024), a1 = vtr(vp0 + ks * 1024 + 512);
            const s16x4 b0 = vtr(vp0 + vd0 + ks * 1024), b1 = vtr(vp0 + vd0 + ks * 1024 + 512);
            const bf16x8 va = (bf16x8){a0[0], a0[1], a0[2], a0[3], a1[0], a1[1], a1[2], a1[3]};
            const bf16x8 vb = (bf16x8){b0[0], b0[1], b0[2], b0[3], b1[0], b1[1], b1[2], b1[3]};
            o0 = __builtin_amdgcn_mfma_f32_32x32x16_bf16(va, ks ? pf1 : pf0, o0, 0, 0, 0);
            o1 = __builtin_amdgcn_mfma_f32_32x32x16_bf16(vb, ks ? pf1 : pf0, o1, 0, 0, 0);
        }
    }
    if constexpr (TWO) {
        u32x4 pw0, pw1;
        pw0.x = cvt_pk_bf16(s1[0], s1[1]); pw0.y = cvt_pk_bf16(s1[2], s1[3]); pw0.z = cvt_pk_bf16(s1[4], s1[5]); pw0.w = cvt_pk_bf16(s1[6], s1[7]);
        pw1.x = cvt_pk_bf16(s1[8], s1[9]); pw1.y = cvt_pk_bf16(s1[10], s1[11]); pw1.z = cvt_pk_bf16(s1[12], s1[13]); pw1.w = cvt_pk_bf16(s1[14], s1[15]);
        const bf16x8 pf0 = __builtin_bit_cast(bf16x8, pw0), pf1 = __builtin_bit_cast(bf16x8, pw1);
#pragma unroll
        for (int ks = 0; ks < 2; ++ks) {
            const s16x4 a0 = vtr(vp1 + ks * 1024), a1 = vtr(vp1 + ks * 1024 + 512);
            const s16x4 b0 = vtr(vp1 + vd0 + ks * 1024), b1 = vtr(vp1 + vd0 + ks * 1024 + 512);
            const bf16x8 va = (bf16x8){a0[0], a0[1], a0[2], a0[3], a1[0], a1[1], a1[2], a1[3]};
            const bf16x8 vb = (bf16x8){b0[0], b0[1], b0[2], b0[3], b1[0], b1[1], b1[2], b1[3]};
            o0 = __builtin_amdgcn_mfma_f32_32x32x16_bf16(va, ks ? pf1 : pf0, o0, 0, 0, 0);
            o1 = __builtin_amdgcn_mfma_f32_32x32x16_bf16(vb, ks ? pf1 : pf0, o1, 0, 0, 0);
        }
    }
}

template <int DQK>
__device__ __forceinline__ void attn_step2(LAS unsigned char* kp, int ke0, int ke1, LAS unsigned char* vp, int vd0, const bf16x8 (&qa)[DQK / 16], const bf16x8 (&qb)[DQK / 16],
                                           float& la, float& lb, f32x16& oa0, f32x16& oa1, f32x16& ob0, f32x16& ob1, bool maska, bool maskb, int qidx, int kidx0, int hi) {
    f32x16 sa, sb;
    const f32x16 zf = (f32x16){0.f, 0.f, 0.f, 0.f, 0.f, 0.f, 0.f, 0.f, 0.f, 0.f, 0.f, 0.f, 0.f, 0.f, 0.f, 0.f};
    bf16x8 kf[DQK / 16];
#pragma unroll
    for (int kk = 0; kk < DQK / 16; ++kk) kf[kk] = *(const LAS bf16x8*)(kp + (kk >> 1) * 1024 + ((kk & 1) ? ke1 : ke0));
    sa = __builtin_amdgcn_mfma_f32_32x32x16_bf16(kf[0], qa[0], zf, 0, 0, 0); sb = __builtin_amdgcn_mfma_f32_32x32x16_bf16(kf[0], qb[0], zf, 0, 0, 0);
#pragma unroll
    for (int kk = 1; kk < DQK / 16; ++kk) { sa = __builtin_amdgcn_mfma_f32_32x32x16_bf16(kf[kk], qa[kk], sa, 0, 0, 0); sb = __builtin_amdgcn_mfma_f32_32x32x16_bf16(kf[kk], qb[kk], sb, 0, 0, 0); }
    if (maska) {
#pragma unroll
        for (int r = 0; r < 16; ++r) { if (qidx - (kidx0 + crow(r, hi)) < 0) sa[r] = -INFINITY; }
    }
    if (maskb) {
#pragma unroll
        for (int r = 0; r < 16; ++r) { if (qidx + 32 - (kidx0 + crow(r, hi)) < 0) sb[r] = -INFINITY; }
    }
    s16x4 vfr[2][4];
#pragma unroll
    for (int ks = 0; ks < 2; ++ks) { vfr[ks][0] = vtr(vp + ks * 1024); vfr[ks][1] = vtr(vp + ks * 1024 + 512); vfr[ks][2] = vtr(vp + vd0 + ks * 1024); vfr[ks][3] = vtr(vp + vd0 + ks * 1024 + 512); }
    __builtin_amdgcn_sched_barrier(0);
    float pa = 0.f, pb = 0.f;
#pragma unroll
    for (int r = 0; r < 16; ++r) { sa[r] = __builtin_amdgcn_exp2f(sa[r]); pa += sa[r]; sb[r] = __builtin_amdgcn_exp2f(sb[r]); pb += sb[r]; }
    la += pa; lb += pb;
    u32x4 wa0, wa1, wb0, wb1;
    wa0.x = cvt_pk_bf16(sa[0], sa[1]); wa0.y = cvt_pk_bf16(sa[2], sa[3]); wa0.z = cvt_pk_bf16(sa[4], sa[5]); wa0.w = cvt_pk_bf16(sa[6], sa[7]);
    wa1.x = cvt_pk_bf16(sa[8], sa[9]); wa1.y = cvt_pk_bf16(sa[10], sa[11]); wa1.z = cvt_pk_bf16(sa[12], sa[13]); wa1.w = cvt_pk_bf16(sa[14], sa[15]);
    wb0.x = cvt_pk_bf16(sb[0], sb[1]); wb0.y = cvt_pk_bf16(sb[2], sb[3]); wb0.z = cvt_pk_bf16(sb[4], sb[5]); wb0.w = cvt_pk_bf16(sb[6], sb[7]);
    wb1.x = cvt_pk_bf16(sb[8], sb[9]); wb1.y = cvt_pk_bf16(sb[10], sb[11]); wb1.z = cvt_pk_bf16(sb[12], sb[13]); wb1.w = cvt_pk_bf16(sb[14], sb[15]);
#pragma unroll
    for (int ks = 0; ks < 2; ++ks) {
        const s16x4 a0 = vfr[ks][0], a1 = vfr[ks][1], b0 = vfr[ks][2], b1 = vfr[ks][3];
        const bf16x8 va = (bf16x8){a0[0], a0[1], a0[2], a0[3], a1[0], a1[1], a1[2], a1[3]};
        const bf16x8 vb = (bf16x8){b0[0], b0[1], b0[2], b0[3], b1[0], b1[1], b1[2], b1[3]};
        const bf16x8 pfa = __builtin_bit_cast(bf16x8, ks ? wa1 : wa0), pfb = __builtin_bit_cast(bf16x8, ks ? wb1 : wb0);
        oa0 = __builtin_amdgcn_mfma_f32_32x32x16_bf16(va, pfa, oa0, 0, 0, 0);
        ob0 = __builtin_amdgcn_mfma_f32_32x32x16_bf16(va, pfb, ob0, 0, 0, 0);
        oa1 = __builtin_amdgcn_mfma_f32_32x32x16_bf16(vb, pfa, oa1, 0, 0, 0);
        ob1 = __builtin_amdgcn_mfma_f32_32x32x16_bf16(vb, pfb, ob1, 0, 0, 0);
    }
}

constexpr int OST_ROW = 144, OST_WAVE = 32 * OST_ROW;
__device__ __forceinline__ void ostage_write(LAS unsigned char* st, const f32x16& o0, const f32x16& o1, float sc, int r32, int hi) {
#pragma unroll
    for (int g4 = 0; g4 < 4; ++g4) { u32x2 a, b2; a.x = cvt_pk_bf16(o0[4 * g4] * sc, o0[4 * g4 + 1] * sc); a.y = cvt_pk_bf16(o0[4 * g4 + 2] * sc, o0[4 * g4 + 3] * sc);
        b2.x = cvt_pk_bf16(o1[4 * g4] * sc, o1[4 * g4 + 1] * sc); b2.y = cvt_pk_bf16(o1[4 * g4 + 2] * sc, o1[4 * g4 + 3] * sc);
        *(LAS u32x2*)(st + r32 * OST_ROW + (8 * g4 + 4 * hi) * 2) = a; *(LAS u32x2*)(st + r32 * OST_ROW + (32 + 8 * g4 + 4 * hi) * 2) = b2; }
}
struct Args {
    const float* in[28]; float* out; unsigned char* ws; int ph_lo, ph_hi; unsigned probe; int pad;
};
struct Frame {
    LAS unsigned char* lds; int wave, G, bid;
    unsigned char* ws; float* out; const float* const* in;
};
enum { I_X = 0, I_POS, I_L0_ATTN_NORM, I_L0_W_IN, I_L0_A_QN, I_L0_A_KN, I_L0_A_SINKS, I_L0_B_QN, I_L0_B_KN, I_L0_W_OUT, I_L0_FFN_NORM, I_L0_W_GATE, I_L0_W_UP, I_L0_W_DOWN,
       I_L1_ATTN_NORM, I_L1_W_IN, I_L1_QA_NORM, I_L1_W_UQ, I_L1_KVA_NORM, I_L1_W_UKV, I_L1_C_QN, I_L1_C_KN, I_L1_W_OUT, I_L1_FFN_NORM, I_L1_ROUTER, I_L1_WE_GATE, I_L1_WE_UP, I_L1_WE_DOWN };

__device__ __forceinline__ void cvt_item(const float* W, int ldw, int srccol0  , const float* kgain, bf16_t* Bt, int K, int dstrow0, bool perm, int k0, LAS float* scr, int lane) {
#pragma unroll
    for (int i = 0; i < 8; ++i) { const int kk = 8 * i + (lane >> 3), c4 = (lane & 7) * 4; f32x4 v = (f32x4){0.f, 0.f, 0.f, 0.f};
        if (srccol0 >= 0) { v = *(const f32x4*)(W + (size_t)(k0 + kk) * ldw + srccol0 + c4); if (kgain) v = v * kgain[k0 + kk]; }
        scr[kk * 33 + c4] = v[0]; scr[kk * 33 + c4 + 1] = v[1]; scr[kk * 33 + c4 + 2] = v[2]; scr[kk * 33 + c4 + 3] = v[3]; }
    LDS_WAIT(); asm volatile("" ::: "memory");
    const int c = lane & 7;
#pragma unroll
    for (int j = 0; j < 4; ++j) { const int rho = (lane >> 3) + 8 * j; const int sc = perm ? pg8::perm32(rho) : rho; const LAS float* s = scr + (8 * c) * 33 + sc;
        u32x4 o; o.x = cvt_pk_bf16(s[0 * 33], s[1 * 33]); o.y = cvt_pk_bf16(s[2 * 33], s[3 * 33]); o.z = cvt_pk_bf16(s[4 * 33], s[5 * 33]); o.w = cvt_pk_bf16(s[6 * 33], s[7 * 33]);
        *(u32x4*)(Bt + (size_t)(dstrow0 + rho) * K + k0 + 8 * c) = o; }
    LDS_WAIT(); asm volatile("" ::: "memory");
}
__device__ __forceinline__ void cvt_item8(const float* W, int ldw, int srccol0, unsigned char* Bt, int K, int dstrow0, bool perm, int k0, float scale, LAS float* scr, int lane) {
#pragma unroll
    for (int i = 0; i < 8; ++i) { const int kk = 8 * i + (lane >> 3), c4 = (lane & 7) * 4; const f32x4 v = *(const f32x4*)(W + (size_t)(k0 + kk) * ldw + srccol0 + c4) * scale;
        scr[kk * 33 + c4] = v[0]; scr[kk * 33 + c4 + 1] = v[1]; scr[kk * 33 + c4 + 2] = v[2]; scr[kk * 33 + c4 + 3] = v[3]; }
    LDS_WAIT(); asm volatile("" ::: "memory");
    const int rho = lane >> 1, kh = (lane & 1) * 32; const int sc = perm ? pg8::perm32(rho) : rho; const LAS float* s = scr + kh * 33 + sc;
    u32x4 o0, o1;
    o0.x = pk4_fp8(s[0 * 33], s[1 * 33], s[2 * 33], s[3 * 33]); o0.y = pk4_fp8(s[4 * 33], s[5 * 33], s[6 * 33], s[7 * 33]); o0.z = pk4_fp8(s[8 * 33], s[9 * 33], s[10 * 33], s[11 * 33]); o0.w = pk4_fp8(s[12 * 33], s[13 * 33], s[14 * 33], s[15 * 33]);
    o1.x = pk4_fp8(s[16 * 33], s[17 * 33], s[18 * 33], s[19 * 33]); o1.y = pk4_fp8(s[20 * 33], s[21 * 33], s[22 * 33], s[23 * 33]); o1.z = pk4_fp8(s[24 * 33], s[25 * 33], s[26 * 33], s[27 * 33]); o1.w = pk4_fp8(s[28 * 33], s[29 * 33], s[30 * 33], s[31 * 33]);
    unsigned char* dp = Bt + (size_t)(dstrow0 + rho) * K + k0 + kh;
    *(u32x4*)dp = o0; *(u32x4*)(dp + 16) = o1;
    LDS_WAIT(); asm volatile("" ::: "memory");
}
__device__ __forceinline__ void p0_weights(const Frame& F) {
    const int lane_ = lane_id_v(), tid_ = F.wave * 64 + lane_; (void)tid_;
    LAS float* scr = (LAS float*)(F.lds + F.wave * 16384);
    const int gw = F.bid * 8 + F.wave, NGW = F.G * 8;
    constexpr int N0 = (L0_IN / 32) * (DM / 64);
    constexpr int N1 = (DM / 32) * (DM / 64);
    constexpr int N2 = (2 * DFF / 32) * (DM / 64);
    constexpr int N3 = (DM / 32) * (DFF / 64);
    constexpr int N4 = (L1_INP / 32) * (DM / 64);
    constexpr int N5 = (NUQ / 32) * (CQ / 64);
    constexpr int N6 = (NUKV / 32) * (CKV / 64);
    constexpr int N7 = N1;
    constexpr int N8 = NEXP * (2 * DFE / 32) * (DM / 64);
    constexpr int N9 = NEXP * (DM / 32) * (DFE / 64);
    constexpr int NT = N0 + N1 + N2 + N3 + N4 + N5 + N6 + N7 + N8 + N9;
    unsigned char* ws = F.ws;
    for (int it = gw; it < NT; it += NGW) {
        int r = it;
        if (r < N0) { const int g = r % (L0_IN / 32), kb = r / (L0_IN / 32); const int pn = g >> 3, bj = (g >> 2) & 1, wc = g & 3;
            cvt_item(F.in[I_L0_W_IN], L0_IN, pn * 256 + wc * 64 + bj * 32, F.in[I_L0_ATTN_NORM], (bf16_t*)(ws + W0_IN), DM, g * 32, true, kb * 64, scr, lane_); continue; } r -= N0;
        if (r < N1) { const int g = r % (DM / 32), kb = r / (DM / 32);
            cvt_item(F.in[I_L0_W_OUT], DM, g * 32, nullptr, (bf16_t*)(ws + W0_OUT), DM, g * 32, true, kb * 64, scr, lane_); continue; } r -= N1;
        if (r < N2) { const int g = r % (2 * DFF / 32), kb = r / (2 * DFF / 32); const int pn = g >> 3, bj = (g >> 2) & 1, wc = g & 3;
            cvt_item(bj ? F.in[I_L0_W_UP] : F.in[I_L0_W_GATE], DFF, pn * 128 + wc * 32, F.in[I_L0_FFN_NORM], (bf16_t*)(ws + W0_GU), DM, g * 32, true, kb * 64, scr, lane_); continue; } r -= N2;
        if (r < N3) { const int g = r % (DM / 32), kb = r / (DM / 32);
            cvt_item(F.in[I_L0_W_DOWN], DM, g * 32, nullptr, (bf16_t*)(ws + W0_DN), DFF, g * 32, true, kb * 64, scr, lane_); continue; } r -= N3;
        if (r < N4) { const int g = r % (L1_INP / 32), kb = r / (L1_INP / 32);
            cvt_item(F.in[I_L1_W_IN], 672, g < 21 ? g * 32 : -1, F.in[I_L1_ATTN_NORM], (bf16_t*)(ws + W1_IN), DM, g * 32, true, kb * 64, scr, lane_); continue; } r -= N4;
        if (r < N5) { const int g = r % (NUQ / 32), kb = r / (NUQ / 32);
            cvt_item(F.in[I_L1_W_UQ], NUQ, g * 32, F.in[I_L1_QA_NORM], (bf16_t*)(ws + W1_UQ), CQ, g * 32, true, kb * 64, scr, lane_); continue; } r -= N5;
        if (r < N6) { const int g = r % (NUKV / 32), kb = r / (NUKV / 32); const int pn = g >> 3, bj = (g >> 2) & 1, wc = g & 3;
            cvt_item(F.in[I_L1_W_UKV], NUKV, (2 * pn + (wc & 1)) * 128 + (wc >> 1) * 64 + bj * 32, F.in[I_L1_KVA_NORM], (bf16_t*)(ws + W1_UKV), CKV, g * 32, true, kb * 64, scr, lane_); continue; } r -= N6;
        if (r < N7) { const int g = r % (DM / 32), kb = r / (DM / 32);
            cvt_item(F.in[I_L1_W_OUT], DM, g * 32, nullptr, (bf16_t*)(ws + W1_OUT), DM, g * 32, true, kb * 64, scr, lane_); continue; } r -= N7;
        if (r < N8) { constexpr int PE = (2 * DFE / 32) * (DM / 64); const int e = r / PE, q = r % PE; const int g = q % (2 * DFE / 32), kb = q / (2 * DFE / 32); const int pn = g >> 3, bj = (g >> 2) & 1, wc = g & 3;
            cvt_item8((bj ? F.in[I_L1_WE_UP] : F.in[I_L1_WE_GATE]) + (size_t)e * DM * DFE, DFE, pn * 128 + wc * 32, (unsigned char*)(ws + WE_GU) + (size_t)e * 2 * DFE * DM, DM, g * 32, true, kb * 64, bj ? WGU_SCALE : WGU_SCALE * LOG2E, scr, lane_); continue; } r -= N8;
        { constexpr int PE = (DM / 32) * (DFE / 64); const int e = r / PE, q = r % PE; const int g = q % (DM / 32), kb = q / (DM / 32);
            cvt_item8(F.in[I_L1_WE_DOWN] + (size_t)e * DFE * DM, DM, g * 32, (unsigned char*)(ws + WE_DN) + (size_t)e * DM * DFE, DFE, g * 32, true, kb * 64, WDN_SCALE, scr, lane_); }
    }
}
__device__ __forceinline__ void p0_rope(const Frame& F) {
    const int lane_ = lane_id_v(), tid_ = F.wave * 64 + lane_; (void)tid_;
    const int* pos = (const int*)F.in[I_POS];
    float* ch = (float*)(F.ws + WS_ROPEH); float* sh = ch + (size_t)NTOK * 32;
    float* cc = (float*)(F.ws + WS_ROPEC); float* sc = cc + (size_t)NTOK * 16;
    const size_t stride = (size_t)F.G * 512;
    const int f = tid_ & 31;
    const float inv = powf(10000.0f, -(float)(2 * f) / 64.0f), inv2 = powf(10000.0f, -(float)(2 * (f & 15)) / 32.0f);
    for (size_t i = (size_t)F.bid * 512 + tid_; i < (size_t)NTOK * 32; i += stride) {
        const int t = (int)(i >> 5); const float p = (float)pos[t];
        float s, c; sincosf(p * inv, &s, &c); ch[i] = c; sh[i] = s;
        if (f < 16) { sincosf(p * inv2, &s, &c); cc[(size_t)t * 16 + f] = c; sc[(size_t)t * 16 + f] = s; }
    }
}
__device__ __forceinline__ void x_rows(const Frame& F, const float* src, bf16_t* dst, float* rs0) {
    const int lane_ = lane_id_v();
    const int gw = F.bid * 8 + F.wave, NGW = F.G * 8;
    for (int m = gw * 4; m < NTOK; m += NGW * 4) {
        f32x4 v[4][4]; float s[4];
#pragma unroll
        for (int r = 0; r < 4; ++r) { const f32x4* xr = (const f32x4*)(src + (size_t)(m + r) * DM) + lane_;
#pragma unroll
            for (int j = 0; j < 4; ++j) v[r][j] = xr[64 * j]; }
#pragma unroll
        for (int r = 0; r < 4; ++r) { s[r] = 0.f;
#pragma unroll
            for (int j = 0; j < 4; ++j) s[r] += (v[r][j].x * v[r][j].x + v[r][j].y * v[r][j].y) + (v[r][j].z * v[r][j].z + v[r][j].w * v[r][j].w); }
#pragma unroll
        for (int r = 0; r < 4; ++r) {
            const float rstd = __builtin_amdgcn_rsqf(wave_sum(s[r]) * (1.f / DM) + EPS);
            if (lane_ == 0) rs0[m + r] = rstd;
            u32x2* o8 = (u32x2*)(dst + (size_t)(m + r) * DM) + lane_;
#pragma unroll
            for (int j = 0; j < 4; ++j) { u32x2 w; w.x = cvt_pk_bf16(v[r][j].x, v[r][j].y); w.y = cvt_pk_bf16(v[r][j].z, v[r][j].w); o8[64 * j] = w; }
        }
    }
}

constexpr int BK_ROWS = 384, BK_VOFF = BK_ROWS * 128, BK_VD0 = BK_ROWS * 64;
struct BandItem { int b, qcol, kcol, vcol, dil, cls0, cls1, tq0, tq1, maxd, mode  , outcol, pidx, head; float sink; bool has_sink, split_rows, keep  ; };
template <bool FIXREF>
__device__ __forceinline__ void band_item(const Frame& F, const BandItem it) {
    const int lane_ = lane_id_v();
    const bf16_t* P = (const bf16_t*)(F.ws + WS_PROJ0);
    LAS unsigned char* lds = F.lds;
    const int lane = lane_, w = F.wave, hq = w >> 2, wq = w & 3, hi = lane >> 5, r32 = lane & 31;
    const size_t tokbase = (size_t)it.b * SEQ;
    if (!it.keep) {
        const __amdgpu_buffer_rsrc_t rsP = __builtin_amdgcn_make_buffer_rsrc((void*)(P + tokbase * L0_IN), (short)0, SEQ * L0_IN * 2, 0x00020000);
        const int k16 = lane >> 2, pc = lane & 3;
        const unsigned vok = (unsigned)(k16 * it.dil * 128 + (pc ^ ((k16 >> 2) & 3)) * 16), vov = (unsigned)(k16 * it.dil * 128 + pc * 16);
#pragma unroll 1
        for (int i = 0; i < 12; ++i) {
            const int p = w + 8 * i; const bool isv = p >= 48; const int j = isv ? p - 48 : p;
            const int kg = isv ? j % 24 : j >> 1, sub = isv ? j / 24 : j & 1;
            const int R0 = kg * 16; const bool second = it.split_rows && R0 >= 256;
            const int kidx = second ? R0 - 256 : it.tq0 - 128 + R0; const int cls = second ? it.cls1 : it.cls0;
            if (kidx >= 0 && kidx < SEQ / it.dil) {
                const unsigned so = (unsigned)((((isv ? it.vcol : it.kcol) >> 6) * SEQ + cls + it.dil * kidx) * 128 + sub * 64);
                dma_piece(rsP, (unsigned)(uintptr_t)lds + (unsigned)(isv ? BK_VOFF + j * 1024 : p * 1024), isv ? vov : vok, so);
            }
        }
    }
    const int tq = hq ? it.tq1 : it.tq0, cls = hq ? it.cls1 : it.cls0;
    const int qidx0 = tq + 32 * wq, qidx = qidx0 + r32;
    const size_t qtok = tokbase + cls + (size_t)it.dil * qidx;
    bf16x8 qf[4];
#pragma unroll
    for (int kk = 0; kk < 4; ++kk) qf[kk] = *(const bf16x8*)(P + (((size_t)it.b * 36 + (it.qcol >> 6)) * SEQ + cls + (size_t)it.dil * qidx) * 64 + 16 * kk + 8 * hi);
    float m = it.has_sink ? it.sink : 0.f, l = (it.has_sink && hi == 0) ? 1.f : 0.f;
    f32x16 o0, o1, negm;
#pragma unroll
    for (int r = 0; r < 16; ++r) { o0[r] = 0.f; o1[r] = 0.f; negm[r] = -m; }
    asm volatile("s_waitcnt vmcnt(0) lgkmcnt(0)\n\ts_barrier" ::: "memory");
    {
        const int vlane = (4 * hi + ((lane & 15) >> 2)) * 64 + ((lane >> 4) & 1) * 32 + (lane & 3) * 8;
        const int ksw = (r32 >> 2) & 3, ke0 = ((hi) ^ ksw) * 16, ke1 = ((2 + hi) ^ ksw) * 16;
#define BK_KP(kb) (lds + (8 * hq + 2 * (kb) + (r32 >> 4)) * 2048 + (r32 & 15) * 64)
#define BK_VP(kb) (lds + BK_VOFF + (128 * hq + 32 * (kb)) * 64 + vlane)
        const int kx0 = tq - 128 + 32 * wq;
        if (kx0 >= 0) {
            attn_step<64, true, FIXREF>(BK_KP(wq), BK_KP(wq + 1), ke0, ke1, BK_VP(wq), BK_VP(wq + 1), BK_VD0, qf, negm, m, l, o0, o1, true, false, qidx, kx0, it.maxd, hi);
            attn_step<64, true, FIXREF>(BK_KP(wq + 2), BK_KP(wq + 3), ke0, ke1, BK_VP(wq + 2), BK_VP(wq + 3), BK_VD0, qf, negm, m, l, o0, o1, false, false, qidx, kx0 + 64, it.maxd, hi);
            attn_step<64, false, FIXREF>(BK_KP(wq + 4), BK_KP(wq + 4), ke0, ke1, BK_VP(wq + 4), BK_VP(wq + 4), BK_VD0, qf, negm, m, l, o0, o1, true, false, qidx, kx0 + 128, it.maxd, hi);
        } else {
#pragma unroll 1
            for (int kb = 4; kb < wq + 4; ++kb) attn_step<64, false, FIXREF>(BK_KP(kb), BK_KP(kb), ke0, ke1, BK_VP(kb), BK_VP(kb), BK_VD0, qf, negm, m, l, o0, o1, false, false, qidx, tq - 128 + 32 * kb, it.maxd, hi);
            attn_step<64, false, FIXREF>(BK_KP(wq + 4), BK_KP(wq + 4), ke0, ke1, BK_VP(wq + 4), BK_VP(wq + 4), BK_VD0, qf, negm, m, l, o0, o1, true, false, qidx, kx0 + 128, it.maxd, hi);
        }
#undef BK_KP
#undef BK_VP
    }
    l = swap32_sum(l);
    const float inv = 1.0f / l;
    const float lse = m + __builtin_amdgcn_logf(l);
    LAS unsigned char* st = lds + 98304 + w * OST_WAVE;
    LAS float* wst = (LAS float*)(lds + 98304 + 8 * OST_WAVE) + w * 128;
    const int srow = lane >> 3, sch = lane & 7;
    if (it.mode != 2) {
        ostage_write(st, o0, o1, inv, r32, hi);
        asm volatile("s_waitcnt lgkmcnt(0)" ::: "memory");
        bf16_t* obase = it.mode == 0 ? (bf16_t*)(F.ws + WS_MIX) + it.outcol : (bf16_t*)(F.ws + WS_PART) + (size_t)it.pidx * NTOK * 512 + it.head * 64;
        const int opitch = it.mode == 0 ? DM : 512;
#pragma unroll
        for (int i = 0; i < 4; ++i) { const int row = 8 * i + srow; const u32x4 v = *(const LAS u32x4*)(st + row * OST_ROW + sch * 16);
            *(u32x4*)(obase + (tokbase + cls + (size_t)it.dil * (qidx0 + row)) * opitch + sch * 8) = v; }
        if (it.mode == 1 && hi == 0) ((float*)(F.ws + WS_LSE))[(size_t)it.pidx * NTOK * 8 + qtok * 8 + it.head] = lse;
    } else {
        const float* lsep = (const float*)(F.ws + WS_LSE);
        const float l1 = lsep[qtok * 8 + it.head], l2 = lsep[(size_t)NTOK * 8 + qtok * 8 + it.head];
        const float M = fmaxf(fmaxf(l1, l2), lse);
        float w0 = __builtin_amdgcn_exp2f(lse - M), w1 = __builtin_amdgcn_exp2f(l1 - M), w2 = __builtin_amdgcn_exp2f(l2 - M);
        const float wn = 1.0f / (w0 + w1 + w2); w0 *= wn; w1 *= wn; w2 *= wn;
        ostage_write(st, o0, o1, inv * w0, r32, hi);
        if (hi == 0) { wst[r32 * 4 + 1] = w1; wst[r32 * 4 + 2] = w2; }
        asm volatile("s_waitcnt lgkmcnt(0)" ::: "memory");
        const bf16_t* p1b = (const bf16_t*)(F.ws + WS_PART) + it.head * 64; const bf16_t* p2b = p1b + (size_t)NTOK * 512;
        bf16_t* obase = (bf16_t*)(F.ws + WS_MIX) + it.outcol;
#pragma unroll
        for (int i = 0; i < 4; ++i) { const int row = 8 * i + srow; const size_t tk = tokbase + cls + (size_t)it.dil * (qidx0 + row);
            const u32x4 a = *(const LAS u32x4*)(st + row * OST_ROW + sch * 16); const u32x4 x1 = *(const u32x4*)(p1b + tk * 512 + sch * 8), x2 = *(const u32x4*)(p2b + tk * 512 + sch * 8);
            const float q1 = wst[row * 4 + 1], q2 = wst[row * 4 + 2];
            u32x4 o;
            o.x = cvt_pk_bf16(bf_lo(a.x) + bf_lo(x1.x) * q1 + bf_lo(x2.x) * q2, bf_hi(a.x) + bf_hi(x1.x) * q1 + bf_hi(x2.x) * q2);
            o.y = cvt_pk_bf16(bf_lo(a.y) + bf_lo(x1.y) * q1 + bf_lo(x2.y) * q2, bf_hi(a.y) + bf_hi(x1.y) * q1 + bf_hi(x2.y) * q2);
            o.z = cvt_pk_bf16(bf_lo(a.z) + bf_lo(x1.z) * q1 + bf_lo(x2.z) * q2, bf_hi(a.z) + bf_hi(x1.z) * q1 + bf_hi(x2.z) * q2);
            o.w = cvt_pk_bf16(bf_lo(a.w) + bf_lo(x1.w) * q1 + bf_lo(x2.w) * q2, bf_hi(a.w) + bf_hi(x1.w) * q1 + bf_hi(x2.w) * q2);
            *(u32x4*)(obase + tk * DM + sch * 8) = o; }
    }
    __syncthreads();
}
__device__ __forceinline__ void band_phase(const Frame& F, int which  ) {
    const float* sinks = F.in[I_L0_A_SINKS];
    float gm[4] = {0.f, 0.f, 0.f, 0.f}, smax = 0.f;
    for (int i = 0; i < 64; ++i) { gm[0] = fmaxf(gm[0], fabsf(F.in[I_L0_A_QN][i])); gm[1] = fmaxf(gm[1], fabsf(F.in[I_L0_A_KN][i])); gm[2] = fmaxf(gm[2], fabsf(F.in[I_L0_B_QN][i])); gm[3] = fmaxf(gm[3], fabsf(F.in[I_L0_B_KN][i])); }
    for (int i = 0; i < 8; ++i) smax = fmaxf(smax, fabsf(sinks[i]));
    const bool fix = fmaxf(fmaxf(gm[0] * gm[1], gm[2] * gm[3]) * 8.0f, smax) * LOG2E < ATT_FIX_BOUND;
    const int nitems = which == 0 ? 6144 : 2048;
    for (int idx = F.bid; idx < nitems; idx += F.G) {
        BandItem it;
        const int ty = which == 0 ? idx / 2048 : 3, r = idx % 2048;
        it.b = r >> 6; int h = (r >> 3) & 7, jp = r & 7;
        it.keep = false;
        if (ty == 0 && F.G == 256) {
            const int j = idx >> 8, grp = F.bid + 256 * (j >> 2);
            it.b = grp >> 4; h = 4 * ((grp >> 3) & 1) + (j & 3); jp = grp & 7; it.keep = (j & 3) != 0; }
        it.head = h; it.split_rows = false; it.has_sink = false; it.sink = 0.f; it.pidx = 0;
        if (ty == 0) { it.qcol = 64 * h; it.kcol = 512 + 64 * (h >> 2); it.vcol = 640 + 64 * (h >> 2); it.dil = 1; it.cls0 = it.cls1 = 0; it.tq0 = 256 * jp; it.tq1 = it.tq0 + 128; it.maxd = 127; it.mode = 0; it.outcol = 64 * h;
            it.has_sink = true; it.sink = sinks[h] * LOG2E; }
        else { it.qcol = 768 + 64 * h; it.kcol = 1280 + 64 * h; it.vcol = 1792 + 64 * h; it.maxd = 128; it.outcol = 512 + 64 * h;
            if (ty == 1) { it.dil = 1; it.cls0 = it.cls1 = 0; it.tq0 = 256 * jp; it.tq1 = it.tq0 + 128; it.mode = 1; it.pidx = 0; }
            else if (ty == 2) { it.dil = 4; it.cls0 = it.cls1 = jp >> 1; it.tq0 = 256 * (jp & 1); it.tq1 = it.tq0 + 128; it.mode = 1; it.pidx = 1; }
            else { it.dil = 16; it.cls0 = 2 * jp; it.cls1 = 2 * jp + 1; it.tq0 = 0; it.tq1 = 0; it.mode = 2; it.split_rows = true; } }
        if (fix) band_item<true>(F, it); else band_item<false>(F, it);
    }
}

constexpr int ML_KB = 12288, ML_VB = 8192, ML_STAGE = ML_KB + ML_VB;
__device__ __forceinline__ void mla_q_prep(bf16x8 (&q)[6], const float* gq, const float* cc, const float* sc, size_t t, int hi) {
    float ss = 0.f;
#pragma unroll
    for (int kk = 0; kk < 6; ++kk) { const u32x4 x = __builtin_bit_cast(u32x4, q[kk]);
        ss += bf_lo(x.x) * bf_lo(x.x) + bf_hi(x.x) * bf_hi(x.x) + bf_lo(x.y) * bf_lo(x.y) + bf_hi(x.y) * bf_hi(x.y) + bf_lo(x.z) * bf_lo(x.z) + bf_hi(x.z) * bf_hi(x.z) + bf_lo(x.w) * bf_lo(x.w) + bf_hi(x.w) * bf_hi(x.w); }
    const float rsd = __builtin_amdgcn_rsqf(swap32_sum(ss) * (1.f / 96.f) + EPS) * (0.10206207261596577f * LOG2E);
    float va[8], vb[8];
#pragma unroll
    for (int kk = 0; kk < 6; ++kk) { const u32x4 x = __builtin_bit_cast(u32x4, q[kk]);
        const f32x4 g0 = *(const f32x4*)(gq + 16 * kk + 8 * hi) * rsd, g1 = *(const f32x4*)(gq + 16 * kk + 8 * hi + 4) * rsd;
        float v[8] = {bf_lo(x.x) * g0[0], bf_hi(x.x) * g0[1], bf_lo(x.y) * g0[2], bf_hi(x.y) * g0[3], bf_lo(x.z) * g1[0], bf_hi(x.z) * g1[1], bf_lo(x.w) * g1[2], bf_hi(x.w) * g1[3]};
        if (kk < 4) { u32x4 o; o.x = cvt_pk_bf16(v[0], v[1]); o.y = cvt_pk_bf16(v[2], v[3]); o.z = cvt_pk_bf16(v[4], v[5]); o.w = cvt_pk_bf16(v[6], v[7]); q[kk] = __builtin_bit_cast(bf16x8, o); }
        else {
#pragma unroll
            for (int j = 0; j < 8; ++j) { if (kk == 4) va[j] = v[j]; else vb[j] = v[j]; } } }
    const f32x4 c0 = *(const f32x4*)(cc + t * 16 + 8 * hi), c1 = *(const f32x4*)(cc + t * 16 + 8 * hi + 4), s0 = *(const f32x4*)(sc + t * 16 + 8 * hi), s1 = *(const f32x4*)(sc + t * 16 + 8 * hi + 4);
    float ra[8], rb[8];
#pragma unroll
    for (int j = 0; j < 8; ++j) { const float c = j < 4 ? c0[j & 3] : c1[j & 3], s = j < 4 ? s0[j & 3] : s1[j & 3]; ra[j] = va[j] * c - vb[j] * s; rb[j] = vb[j] * c + va[j] * s; }
    { u32x4 o; o.x = cvt_pk_bf16(ra[0], ra[1]); o.y = cvt_pk_bf16(ra[2], ra[3]); o.z = cvt_pk_bf16(ra[4], ra[5]); o.w = cvt_pk_bf16(ra[6], ra[7]); q[4] = __builtin_bit_cast(bf16x8, o);
      o.x = cvt_pk_bf16(rb[0], rb[1]); o.y = cvt_pk_bf16(rb[2], rb[3]); o.z = cvt_pk_bf16(rb[4], rb[5]); o.w = cvt_pk_bf16(rb[6], rb[7]); q[5] = __builtin_bit_cast(bf16x8, o); }
}
template <bool FIXREF>
__device__ __forceinline__ void mla_unit(const Frame& F, int b, int h, int qb) {
    const int lane_ = lane_id_v();
    const bf16_t* Q = (const bf16_t*)(F.ws + WS_Q); const bf16_t* Kt = (const bf16_t*)(F.ws + WS_K); const bf16_t* V = (const bf16_t*)(F.ws + WS_KV);
    LAS unsigned char* lds = F.lds;
    const int lane = lane_, w = F.wave, hi = lane >> 5, r32 = lane & 31;
    const size_t tokbase = (size_t)b * SEQ;
    const int q0 = qb * 256, qidx0 = q0 + 32 * w, qidx = qidx0 + r32;
    const int NT = 4 * (qb + 1);
    const size_t hbase = ((size_t)b * 16 + h) * SEQ;
    const __amdgpu_buffer_rsrc_t rsK = __builtin_amdgcn_make_buffer_rsrc((void*)(Kt + hbase * 96), (short)0, SEQ * 96 * 2, 0x00020000);
    const __amdgpu_buffer_rsrc_t rsV = __builtin_amdgcn_make_buffer_rsrc((void*)(V + hbase * 64), (short)0, SEQ * 64 * 2, 0x00020000);
    const int k16 = lane >> 2, pc = lane & 3, swz = pc ^ ((k16 >> 2) & 3);
    unsigned vo0, vo1, vo2;
    { const int kg = w / 3, cg = w % 3; vo0 = (unsigned)((kg * 16 + k16) * 192 + (cg * 4 + swz) * 16); }
    if (w < 4) { const int id = w + 8, kg = id / 3, cg = id % 3; vo1 = (unsigned)((kg * 16 + k16) * 192 + (cg * 4 + swz) * 16);
                 const int j = w + 4, d0 = j >> 2, kgv = j & 3; vo2 = (unsigned)((kgv * 16 + k16) * 128 + (d0 * 4 + pc) * 16); }
    else { const int j = w - 4, d0 = j >> 2, kgv = j & 3; vo1 = (unsigned)((kgv * 16 + k16) * 128 + (d0 * 4 + pc) * 16); vo2 = 0; }
    const unsigned lds0 = (unsigned)(uintptr_t)lds;
#define ML_DMA(t, st) do { const unsigned so_k = (unsigned)((t) * 64 * 192), so_v = (unsigned)((t) * 64 * 128); \
        dma_piece(rsK, lds0 + (st) + w * 1024, vo0, so_k); \
        if (w < 4) { dma_piece(rsK, lds0 + (st) + (w + 8) * 1024, vo1, so_k); dma_piece(rsV, lds0 + (st) + ML_KB + (w + 4) * 1024, vo2, so_v); } \
        else { dma_piece(rsV, lds0 + (st) + ML_KB + (w - 4) * 1024, vo1, so_v); } } while (0)
    ML_DMA(0, 0);
    bf16x8 qf[6];
#pragma unroll
    for (int kk = 0; kk < 6; ++kk) qf[kk] = *(const bf16x8*)(Q + (hbase + qidx) * 96 + 16 * kk + 8 * hi);
    mla_q_prep(qf, F.in[I_L1_C_QN], (const float*)(F.ws + WS_ROPEC), (const float*)(F.ws + WS_ROPEC) + (size_t)NTOK * 16, tokbase + qidx, hi);
    float m = 0.f, l = 0.f; f32x16 o0, o1, negm;
#pragma unroll
    for (int r = 0; r < 16; ++r) { o0[r] = 0.f; o1[r] = 0.f; negm[r] = 0.f; }
    const int vlane = (4 * hi + ((lane & 15) >> 2)) * 64 + ((lane >> 4) & 1) * 32 + (lane & 3) * 8;
    const int klane = (r32 >> 4) * 3072 + (r32 & 15) * 64, ksw = (r32 >> 2) & 3, ke0 = ((hi) ^ ksw) * 16, ke1 = ((2 + hi) ^ ksw) * 16;
    asm volatile("s_waitcnt vmcnt(0) lgkmcnt(0)\n\ts_barrier" ::: "memory");
#define ML_TILE(t, CUR, NXT) do { \
        if ((t) + 1 < NT) ML_DMA((t) + 1, NXT); \
        const int kidx0 = 64 * (t); \
        LAS unsigned char* kp0 = lds + (CUR) + klane; LAS unsigned char* kp1 = kp0 + 6144; \
        LAS unsigned char* vp0 = lds + (CUR) + ML_KB + vlane; LAS unsigned char* vp1 = vp0 + 32 * 64; \
        if (kidx0 <= qidx0 + 31) \
            attn_step<96, true, FIXREF>(kp0, kp1, ke0, ke1, vp0, vp1, 4096, qf, negm, m, l, o0, o1, kidx0 + 31 > qidx0, kidx0 + 63 > qidx0, qidx, kidx0, 1 << 30, hi); \
        asm volatile("s_waitcnt vmcnt(0) lgkmcnt(0)\n\ts_barrier" ::: "memory"); } while (0)
#pragma unroll 1
    for (int t = 0; t < NT; t += 2) {
        ML_TILE(t, 0, ML_STAGE);
        ML_TILE(t + 1, ML_STAGE, 0);
    }
#undef ML_TILE
#undef ML_DMA
    l = swap32_sum(l);
    const float inv = 1.0f / l;
    { LAS unsigned char* st = lds + 2 * ML_STAGE + w * OST_WAVE;
      ostage_write(st, o0, o1, inv, r32, hi);
      asm volatile("s_waitcnt lgkmcnt(0)" ::: "memory");
      bf16_t* obase = (bf16_t*)(F.ws + WS_ATT) + (tokbase + qidx0) * DM + h * 64;
#pragma unroll
      for (int i = 0; i < 4; ++i) { const int row = 8 * i + (lane >> 3); *(u32x4*)(obase + (size_t)row * DM + (lane & 7) * 8) = *(const LAS u32x4*)(st + row * OST_ROW + (lane & 7) * 16); } }
}
__device__ __forceinline__ void mla_unit2(const Frame& F, int b, int h, int qb  ) {
    const int lane_ = lane_id_v();
    const bf16_t* Q = (const bf16_t*)(F.ws + WS_Q); const bf16_t* Kt = (const bf16_t*)(F.ws + WS_K); const bf16_t* V = (const bf16_t*)(F.ws + WS_KV);
    LAS unsigned char* lds = F.lds;
    const int lane = lane_, w = F.wave, hi = lane >> 5, r32 = lane & 31;
    const size_t tokbase = (size_t)b * SEQ;
    const int qidx0 = qb * 512 + 64 * w, qidx = qidx0 + r32;
    const int NT = 8 * (qb + 1);
    const size_t hbase = ((size_t)b * 16 + h) * SEQ;
    const __amdgpu_buffer_rsrc_t rsK = __builtin_amdgcn_make_buffer_rsrc((void*)(Kt + hbase * 96), (short)0, SEQ * 96 * 2, 0x00020000);
    const __amdgpu_buffer_rsrc_t rsV = __builtin_amdgcn_make_buffer_rsrc((void*)(V + hbase * 64), (short)0, SEQ * 64 * 2, 0x00020000);
    const int k16 = lane >> 2, pc = lane & 3, swz = pc ^ ((k16 >> 2) & 3);
    unsigned vo0, vo1, vo2;
    { const int kg = w / 3, cg = w % 3; vo0 = (unsigned)((kg * 16 + k16) * 192 + (cg * 4 + swz) * 16); }
    if (w < 4) { const int id = w + 8, kg = id / 3, cg = id % 3; vo1 = (unsigned)((kg * 16 + k16) * 192 + (cg * 4 + swz) * 16);
                 const int j = w + 4, d0 = j >> 2, kgv = j & 3; vo2 = (unsigned)((kgv * 16 + k16) * 128 + (d0 * 4 + pc) * 16); }
    else { const int j = w - 4, d0 = j >> 2, kgv = j & 3; vo1 = (unsigned)((kgv * 16 + k16) * 128 + (d0 * 4 + pc) * 16); vo2 = 0; }
    const unsigned lds0 = (unsigned)(uintptr_t)lds;
#define ML_DMA(t, st) do { const unsigned so_k = (unsigned)((t) * 64 * 192), so_v = (unsigned)((t) * 64 * 128); \
        dma_piece(rsK, lds0 + (st) + w * 1024, vo0, so_k); \
        if (w < 4) { dma_piece(rsK, lds0 + (st) + (w + 8) * 1024, vo1, so_k); dma_piece(rsV, lds0 + (st) + ML_KB + (w + 4) * 1024, vo2, so_v); } \
        else { dma_piece(rsV, lds0 + (st) + ML_KB + (w - 4) * 1024, vo1, so_v); } } while (0)
    ML_DMA(0, 0);
    bf16x8 qa[6], qb2[6];
    { const __amdgpu_buffer_rsrc_t rsQ = __builtin_amdgcn_make_buffer_rsrc((void*)(Q + hbase * 96), (short)0, SEQ * 96 * 2, 0x00020000);
      const unsigned qo = (unsigned)(qidx * 192 + hi * 16);
#pragma unroll
      for (int kk = 0; kk < 6; ++kk) { qa[kk] = __builtin_bit_cast(bf16x8, __builtin_amdgcn_raw_buffer_load_b128(rsQ, qo + kk * 32, 0, 0)); qb2[kk] = __builtin_bit_cast(bf16x8, __builtin_amdgcn_raw_buffer_load_b128(rsQ, qo + 32 * 192 + kk * 32, 0, 0)); } }
    { const float* cc_ = (const float*)(F.ws + WS_ROPEC); mla_q_prep(qa, F.in[I_L1_C_QN], cc_, cc_ + (size_t)NTOK * 16, tokbase + qidx, hi); mla_q_prep(qb2, F.in[I_L1_C_QN], cc_, cc_ + (size_t)NTOK * 16, tokbase + qidx + 32, hi); }
    float la = 0.f, lb = 0.f; f32x16 oa0, oa1, ob0, ob1;
#pragma unroll
    for (int r = 0; r < 16; ++r) { oa0[r] = 0.f; oa1[r] = 0.f; ob0[r] = 0.f; ob1[r] = 0.f; }
    const int vlane = (4 * hi + ((lane & 15) >> 2)) * 64 + ((lane >> 4) & 1) * 32 + (lane & 3) * 8;
    const int klane = (r32 >> 4) * 3072 + (r32 & 15) * 64, ksw = (r32 >> 2) & 3, ke0 = ((hi) ^ ksw) * 16, ke1 = ((2 + hi) ^ ksw) * 16;
    asm volatile("s_waitcnt vmcnt(0) lgkmcnt(0)\n\ts_barrier" ::: "memory");
#define ML_TILE(t, CUR, NXT) do { \
        if ((t) + 1 < NT) ML_DMA((t) + 1, NXT); \
        const int kidx0 = 64 * (t); \
        if (kidx0 <= qidx0 + 63) { \
            attn_step2<96>(lds + (CUR) + klane, ke0, ke1, lds + (CUR) + ML_KB + vlane, 4096, qa, qb2, la, lb, oa0, oa1, ob0, ob1, kidx0 + 31 > qidx0, kidx0 + 31 > qidx0 + 32, qidx, kidx0, hi); \
            attn_step2<96>(lds + (CUR) + klane + 6144, ke0, ke1, lds + (CUR) + ML_KB + vlane + 32 * 64, 4096, qa, qb2, la, lb, oa0, oa1, ob0, ob1, kidx0 + 63 > qidx0, kidx0 + 63 > qidx0 + 32, qidx, kidx0 + 32, hi); } \
        asm volatile("s_waitcnt vmcnt(0) lgkmcnt(0)\n\ts_barrier" ::: "memory"); } while (0)
#pragma unroll 1
    for (int t = 0; t < NT; t += 2) {
        ML_TILE(t, 0, ML_STAGE);
        ML_TILE(t + 1, ML_STAGE, 0);
    }
#undef ML_TILE
#undef ML_DMA
    la = swap32_sum(la); lb = swap32_sum(lb);
    const float ia = 1.0f / la, ib = 1.0f / lb;
    { LAS unsigned char* st = lds + 2 * ML_STAGE + w * 2 * OST_WAVE;
      ostage_write(st, oa0, oa1, ia, r32, hi); ostage_write(st + OST_WAVE, ob0, ob1, ib, r32, hi);
      asm volatile("s_waitcnt lgkmcnt(0)" ::: "memory");
      bf16_t* obase = (bf16_t*)(F.ws + WS_ATT) + (tokbase + qidx0) * DM + h * 64;
#pragma unroll
      for (int i = 0; i < 8; ++i) { const int row = 8 * i + (lane >> 3); *(u32x4*)(obase + (size_t)row * DM + (lane & 7) * 8) = *(const LAS u32x4*)(st + row * OST_ROW + (lane & 7) * 16); } }
}
__device__ __forceinline__ void mla_phase(const Frame& F) {
    float gq = 0.f, gk = 0.f;
    for (int i = 0; i < 96; ++i) { gq = fmaxf(gq, fabsf(F.in[I_L1_C_QN][i])); gk = fmaxf(gk, fabsf(F.in[I_L1_C_KN][i])); }
    const bool fix = gq * gk * 9.797959f * LOG2E < ATT_FIX_BOUND;
    if (fix) {
        for (int idx = F.bid; idx < 1024; idx += F.G) {
            const int bh = idx >> 1, s = idx & 1;
#pragma nounroll
            for (int u = 0; u < 2; ++u) mla_unit2(F, bh >> 4, bh & 15, u ? s : 3 - s);
        }
    } else {
        for (int idx = F.bid; idx < 2048; idx += F.G) {
            const int bh = idx >> 2, s = idx & 3;
#pragma nounroll
            for (int u = 0; u < 2; ++u) mla_unit<false>(F, bh >> 4, bh & 15, u ? s : 7 - s);
        }
    }
}

__device__ __forceinline__ void mla_rowstats(const Frame& F) {
    const int lane_ = lane_id_v();
    const bf16_t* P1 = (const bf16_t*)(F.ws + WS_PROJ1); float* rs = (float*)(F.ws + RT_ROWST);
    for (int t = F.bid * 8 + F.wave; t < NTOK; t += F.G * 8) {
        const bf16_t* pr = P1 + (size_t)t * L1_INP;
        const u32x2 a = *(const u32x2*)(pr + lane_ * 4); const unsigned a2 = *(const unsigned*)(pr + 256 + lane_ * 2); const u32x2 c = *(const u32x2*)(pr + CQ + lane_ * 4);
        const float s1 = bf_lo(a.x) * bf_lo(a.x) + bf_hi(a.x) * bf_hi(a.x) + bf_lo(a.y) * bf_lo(a.y) + bf_hi(a.y) * bf_hi(a.y) + bf_lo(a2) * bf_lo(a2) + bf_hi(a2) * bf_hi(a2);
        const float s2 = bf_lo(c.x) * bf_lo(c.x) + bf_hi(c.x) * bf_hi(c.x) + bf_lo(c.y) * bf_lo(c.y) + bf_hi(c.y) * bf_hi(c.y);
        const float rq = __builtin_amdgcn_rsqf(wave_sum(s1) * (1.f / CQ) + EPS), rkv = __builtin_amdgcn_rsqf(wave_sum(s2) * (1.f / CKV) + EPS);
        if (lane_ == 0) *(f32x2*)(rs + 2 * t) = (f32x2){rq, rkv};
    }
}
__device__ __forceinline__ void moe_route1(const Frame& F) {
    const int lane_ = lane_id_v(), tid_ = F.wave * 64 + lane_; (void)tid_;
    const bf16_t* x = (const bf16_t*)(F.ws + WS_X3); const float* gain = F.in[I_L1_FFN_NORM]; const float* router = F.in[I_L1_ROUTER];
    unsigned char* dst = (unsigned char*)(F.ws + WS_H3F8);
    int* tok_e = (int*)(F.ws + RT_TOKE); float* tok_g = (float*)(F.ws + RT_TOKG); int* wgcnt = (int*)(F.ws + RT_WGCNT);
    LAS int* cnt = (LAS int*)(F.lds + 32768);
    if (tid_ < 8) cnt[tid_] = 0;
    __syncthreads();
    f32x4 rr[4][4][2];
#pragma unroll
    for (int j = 0; j < 4; ++j)
#pragma unroll
        for (int c = 0; c < 4; ++c) { const int d = (lane_ + 64 * j) * 4 + c; rr[j][c][0] = *(const f32x4*)(router + d * 8); rr[j][c][1] = *(const f32x4*)(router + d * 8 + 4); }
    f32x4 gv[4];
#pragma unroll
    for (int j = 0; j < 4; ++j) gv[j] = ((const f32x4*)gain)[lane_ + 64 * j];
    u32x2 nx[4];
    { const int m0 = F.bid * 8 + F.wave; const u32x2* xr = (const u32x2*)(x + (size_t)m0 * DM) + lane_;
#pragma unroll
      for (int j = 0; j < 4; ++j) nx[j] = xr[64 * j]; }
    for (int m = F.bid * 8 + F.wave; m < NTOK; m += F.G * 8) {
        u32x2 cx[4];
#pragma unroll
        for (int j = 0; j < 4; ++j) cx[j] = nx[j];
        if (m + F.G * 8 < NTOK) { const u32x2* xr = (const u32x2*)(x + (size_t)(m + F.G * 8) * DM) + lane_;
#pragma unroll
            for (int j = 0; j < 4; ++j) nx[j] = xr[64 * j]; }
        f32x4 v[4]; float s = 0.f;
#pragma unroll
        for (int j = 0; j < 4; ++j) { const u32x2 xx = cx[j]; v[j] = (f32x4){bf_lo(xx.x), bf_hi(xx.x), bf_lo(xx.y), bf_hi(xx.y)}; s += (v[j].x * v[j].x + v[j].y * v[j].y) + (v[j].z * v[j].z + v[j].w * v[j].w); }
        const float rstd = __builtin_amdgcn_rsqf(wave_sum(s) * (1.f / DM) + EPS);
        float lg[8];
#pragma unroll
        for (int e = 0; e < 8; ++e) lg[e] = 0.f;
        unsigned* o8 = (unsigned*)(dst + (size_t)m * DM) + lane_;
#pragma unroll
        for (int j = 0; j < 4; ++j) {
            f32x4 hv = v[j] * rstd * gv[j];
            o8[64 * j] = pk4_fp8(hv.x, hv.y, hv.z, hv.w);
#pragma unroll
            for (int c = 0; c < 4; ++c) { const f32x4 r0 = rr[j][c][0], r1 = rr[j][c][1];
                lg[0] += hv[c] * r0.x; lg[1] += hv[c] * r0.y; lg[2] += hv[c] * r0.z; lg[3] += hv[c] * r0.w; lg[4] += hv[c] * r1.x; lg[5] += hv[c] * r1.y; lg[6] += hv[c] * r1.z; lg[7] += hv[c] * r1.w; }
        }
        { const bool b0 = lane_ & 1, b1 = (lane_ >> 1) & 1, b2 = (lane_ >> 2) & 1;
          float k4[4], k2[2], k1;
#pragma unroll
          for (int i = 0; i < 4; ++i) { const float keep = b0 ? lg[4 + i] : lg[i], send = b0 ? lg[i] : lg[4 + i]; k4[i] = keep + __shfl_xor(send, 1); }
#pragma unroll
          for (int i = 0; i < 2; ++i) { const float keep = b1 ? k4[2 + i] : k4[i], send = b1 ? k4[i] : k4[2 + i]; k2[i] = keep + __shfl_xor(send, 2); }
          { const float keep = b2 ? k2[1] : k2[0], send = b2 ? k2[0] : k2[1]; k1 = keep + __shfl_xor(send, 4); }
          k1 += __shfl_xor(k1, 8); k1 += __shfl_xor(k1, 16); k1 += __shfl_xor(k1, 32);
#pragma unroll
          for (int e = 0; e < 8; ++e) lg[e] = __uint_as_float(__builtin_amdgcn_readlane(__float_as_uint(k1), (e >> 2) | (((e >> 1) & 1) << 1) | ((e & 1) << 2))); }
        int e0 = 0; float v0 = lg[0];
#pragma unroll
        for (int e = 1; e < 8; ++e) if (lg[e] > v0) { v0 = lg[e]; e0 = e; }
        int e1 = -1; float v1 = -INFINITY;
#pragma unroll
        for (int e = 0; e < 8; ++e) if (e != e0 && lg[e] > v1) { v1 = lg[e]; e1 = e; }
        const float p1 = __expf(v1 - v0), g0 = 1.0f / (1.0f + p1), g1 = p1 * g0;
        if (lane_ == 0) { tok_e[2 * m] = e0; tok_e[2 * m + 1] = e1; tok_g[2 * m] = g0; tok_g[2 * m + 1] = g1;
            __hip_atomic_fetch_add(cnt + e0, 1, __ATOMIC_RELAXED, __HIP_MEMORY_SCOPE_WORKGROUP); __hip_atomic_fetch_add(cnt + e1, 1, __ATOMIC_RELAXED, __HIP_MEMORY_SCOPE_WORKGROUP); }
    }
    __syncthreads();
    if (tid_ < 8) wgcnt[F.bid * 8 + tid_] = cnt[tid_];
}
__device__ __forceinline__ void moe_route2(const Frame& F) {
    const int lane_ = lane_id_v(), tid_ = F.wave * 64 + lane_; (void)tid_;
    const int* tok_e = (const int*)(F.ws + RT_TOKE); int* tok_s = (int*)(F.ws + RT_TOKS); int* row_tok = (int*)(F.ws + RT_ROWTOK);
    const int* wgcnt = (const int*)(F.ws + RT_WGCNT); int* tile_e = (int*)(F.ws + RT_TILEE);
    LAS int* tot = (LAS int*)F.lds;
    if (tid_ < 32) tot[tid_] = 0;
    __syncthreads();
    { const int e = tid_ & 7; int a = 0, b = 0;
      for (int wg = tid_ >> 3; wg < F.G; wg += 64) { const int c = wgcnt[wg * 8 + e]; a += c; if (wg < F.bid) b += c; }
      __hip_atomic_fetch_add(tot + e, a, __ATOMIC_RELAXED, __HIP_MEMORY_SCOPE_WORKGROUP); __hip_atomic_fetch_add(tot + 8 + e, b, __ATOMIC_RELAXED, __HIP_MEMORY_SCOPE_WORKGROUP); }
    __syncthreads();
    if (tid_ == 0) { int ps = 0; for (int e = 0; e < 8; ++e) { tot[16 + e] = ps; ps += (tot[e] + 255) / 256 * 256; } tot[32] = ps; }
    __syncthreads();
    if (F.bid == 0) {
        const int used = tot[32] / 256;
        for (int t = tid_; t < MOE_TILES_MAX; t += 512) { int e = -1; if (t < used) { e = 7; for (int q = 7; q >= 1; --q) if (t * 256 < tot[16 + q]) e = q - 1; } tile_e[t] = e < 0 ? 0 : e; }
        if (tid_ == 0) tile_e[MOE_TILES_MAX] = used;
    }
    if (F.bid < 8) {
        const int e = F.bid, lo = tot[16 + e] + tot[e], hi = tot[16 + e] + (tot[e] + 255) / 256 * 256;
        for (int p = lo + tid_; p < hi; p += 512) row_tok[p] = -1;
    }
    { const int gw = F.bid * 8 + F.wave, NGW = F.G * 8;
      for (int j0 = 0; gw + j0 * NGW < NTOK; j0 += 32) {
          const int m = gw + (j0 + (lane_ >> 1)) * NGW, k = lane_ & 1;
          if (m < NTOK) { const int e = tok_e[2 * m + k];
              const int slot = tot[16 + e] + tot[8 + e] + __hip_atomic_fetch_add(tot + 24 + e, 1, __ATOMIC_RELAXED, __HIP_MEMORY_SCOPE_WORKGROUP);
              row_tok[slot] = m; tok_s[2 * m + k] = slot; } } }
    __syncthreads();
}
__device__ __forceinline__ void moe_combine(const Frame& F, bool dry) {
    const int lane_ = lane_id_v();
    const f32x2* tok_g = (const f32x2*)(F.ws + RT_TOKG); const u32x2* tok_s = (const u32x2*)(F.ws + RT_TOKS); const bf16_t* Y = (const bf16_t*)(F.ws + WS_Y);
    for (int m = (F.bid * 8 + F.wave) * 2; m < NTOK; m += F.G * 16) {
        const f32x2 ga = tok_g[m], gb = tok_g[m + 1]; const u32x2 sa = tok_s[m], sb = tok_s[m + 1];
        f32x4* xa = (f32x4*)(F.out + (size_t)m * DM) + lane_; f32x4* xb = xa + DM / 4;
        const u32x2* x3a = (const u32x2*)((const bf16_t*)(F.ws + WS_X3) + (size_t)m * DM) + lane_; const u32x2* x3b = x3a + DM / 4;
        const u32x2* ya0 = (const u32x2*)(Y + (size_t)sa.x * DM) + lane_; const u32x2* ya1 = (const u32x2*)(Y + (size_t)sa.y * DM) + lane_;
        const u32x2* yb0 = (const u32x2*)(Y + (size_t)sb.x * DM) + lane_; const u32x2* yb1 = (const u32x2*)(Y + (size_t)sb.y * DM) + lane_;
        f32x4 va[4], vb[4]; u32x2 a0[4], a1[4], b0[4], b1[4];
#pragma unroll
        for (int j = 0; j < 4; ++j) { { const u32x2 p = x3a[64 * j], q = x3b[64 * j]; va[j] = (f32x4){bf_lo(p.x), bf_hi(p.x), bf_lo(p.y), bf_hi(p.y)}; vb[j] = (f32x4){bf_lo(q.x), bf_hi(q.x), bf_lo(q.y), bf_hi(q.y)}; } a0[j] = ya0[64 * j]; a1[j] = ya1[64 * j]; b0[j] = yb0[64 * j]; b1[j] = yb1[64 * j]; }
#pragma unroll
        for (int j = 0; j < 4; ++j) {
            f32x4 v = va[j];
            v.x += ga.x * bf_lo(a0[j].x) + ga.y * bf_lo(a1[j].x); v.y += ga.x * bf_hi(a0[j].x) + ga.y * bf_hi(a1[j].x); v.z += ga.x * bf_lo(a0[j].y) + ga.y * bf_lo(a1[j].y); v.w += ga.x * bf_hi(a0[j].y) + ga.y * bf_hi(a1[j].y);
            if (!dry) xa[64 * j] = v;
            v = vb[j];
            v.x += gb.x * bf_lo(b0[j].x) + gb.y * bf_lo(b1[j].x); v.y += gb.x * bf_hi(b0[j].x) + gb.y * bf_hi(b1[j].x); v.z += gb.x * bf_lo(b0[j].y) + gb.y * bf_lo(b1[j].y); v.w += gb.x * bf_hi(b0[j].y) + gb.y * bf_hi(b1[j].y);
            if (!dry) xb[64 * j] = v; }
    }
}

constexpr int NPHASE = 21;
__global__ void __launch_bounds__(512, 2) mk_fwd(Args args) {
    extern __shared__ __attribute__((aligned(16))) unsigned char lds_raw[];
    Frame F;
    F.lds = (LAS unsigned char*)lds_raw;
    F.wave = __builtin_amdgcn_readfirstlane((int)threadIdx.x >> 6);
    F.G = gridDim.x; F.bid = blockIdx.x; F.ws = args.ws; F.out = args.out; F.in = args.in;
    volatile LAS unsigned* MISC = (volatile LAS unsigned*)(F.lds + LDS_MISC);
    { const int l0 = lane_id_v(); if (F.wave == 0) MISC[l0] = 0u; }
    __syncthreads();
    unsigned* ctl = (unsigned*)(args.ws + WS_CTL);
    XcdBarrier bar; bar.bar = ctl + CW_BAR; bar.x = 0; bar.st = nullptr; bar.wave = F.wave;
    if (!MK_PER_PHASE) bar = xcd_barrier_post(ctl + CW_BAR, MISC, F.wave);
    const int lo = args.ph_lo, hi = args.ph_hi; const unsigned probe = args.probe; (void)probe;
    unsigned char* ws = args.ws;
#define IN(k) (lo <= (k) && (k) < hi)
#if PROBE_MASK != 0
#define DRY(k) (rep_ < (int)((probe >> (k)) & 1u))
#define REPS(k) _Pragma("nounroll") for (int rep_ = 0; rep_ <= (int)((probe >> (k)) & 1u); ++rep_)
#else
#define DRY(k) false
#define REPS(k)
#endif
#define SEAM(k) do { if (IN(k) && IN((k) + 1)) { if (!MK_PER_PHASE) xcd_barrier(bar); } } while (0)
    int ph = 0;
    if (IN(0)) REPS(0) { p0_weights(F); p0_rope(F); x_rows(F, F.in[I_X], (bf16_t*)(ws + WS_H), (float*)(ws + RT_ROWST)); } SEAM(0);
    if (IN(1)) REPS(1) { pg8::Gemm g{(const bf16_t*)(ws + WS_H), (const bf16_t*)(ws + W0_IN), DM, DM, 0, nullptr}; pg8::StaticOrder S; S.init(NTOK / 256, L0_IN / 256, F.G, F.bid);
        pg8::EpiQKV0 E{(bf16_t*)(ws + WS_PROJ0), (const float*)(ws + WS_ROPEH), (const float*)(ws + WS_ROPEH) + (size_t)NTOK * 32, (const float*)(ws + RT_ROWST), F.in[I_L0_A_QN], F.in[I_L0_A_KN], F.in[I_L0_B_QN], F.in[I_L0_B_KN]};
        pg8::gemm_phase<pg8::EpiQKV0, false, 2, L0_IN / 256>(F.lds, g, S, E, 0, F.wave); } SEAM(1);
    if (IN(2)) REPS(2) { band_phase(F, 0); } SEAM(2);
    if (IN(3)) REPS(3) { band_phase(F, 1); } SEAM(3);
    if (IN(4)) REPS(4) { pg8::Gemm g{(const bf16_t*)(ws + WS_MIX), (const bf16_t*)(ws + W0_OUT), DM, DM, 0, nullptr}; pg8::StaticOrder S; S.init(NTOK / 256, DM / 256, F.G, F.bid);
        pg8::EpiRes<true, true, true> E{ws + WS_H, ws + WS_X12, false, (float*)(ws + WS_SSX), (LAS float*)(F.lds + RING_BYTES + 2048)}; pg8::gemm_phase<pg8::EpiRes<true, true, true>, false, 2, DM / 256>(F.lds, g, S, E, 0, F.wave); } SEAM(4);
    if (IN(6)) REPS(6) { pg8::Gemm g{(const bf16_t*)(ws + WS_X12), (const bf16_t*)(ws + W0_GU), DM, DM, 0, nullptr}; pg8::StaticOrder S; S.init(NTOK / 256, 2 * DFF / 256, F.G, F.bid);
        pg8::EpiSwiGLU E{(bf16_t*)(ws + WS_HID0), DFF, 0, (const float*)(ws + WS_SSX)}; pg8::gemm_phase<pg8::EpiSwiGLU, false, 2, 2 * DFF / 256>(F.lds, g, S, E, 0, F.wave); } SEAM(6);
    if (IN(7)) REPS(7) { pg8::Gemm g{(const bf16_t*)(ws + WS_HID0), (const bf16_t*)(ws + W0_DN), DFF, DFF, 0, nullptr}; pg8::StaticOrder S; S.init(NTOK / 256, DM / 256, F.G, F.bid);
        pg8::EpiRes<true, true, true> E{ws + WS_X12, ws + WS_X12, DRY(7), (float*)(ws + WS_SSX), (LAS float*)(F.lds + RING_BYTES + 2048)}; pg8::gemm_phase<pg8::EpiRes<true, true, true>, false, 2, DM / 256>(F.lds, g, S, E, 0, F.wave); } SEAM(7);
    if (IN(9)) REPS(9) { pg8::Gemm g{(const bf16_t*)(ws + WS_X12), (const bf16_t*)(ws + W1_IN), DM, DM, 0, nullptr}; pg8::StaticOrder S; S.init(NTOK / 256, L1_INP / 256, F.G, F.bid);
        pg8::EpiProj1 E{(bf16_t*)(ws + WS_PROJ1), (float*)(ws + WS_ROPEH), (LAS float*)(F.lds + RING_BYTES + 2048), (const float*)(ws + WS_SSX)}; pg8::gemm_phase<pg8::EpiProj1, false, 2, L1_INP / 256>(F.lds, g, S, E, 0, F.wave); } SEAM(9);
    if (IN(11)) REPS(11) {
        { pg8::Gemm g{(const bf16_t*)(ws + WS_PROJ1), (const bf16_t*)(ws + W1_UQ), L1_INP, CQ, 0, nullptr}; pg8::StaticOrder S; S.init(NTOK / 256, NUQ / 256, F.G, F.bid);
          pg8::EpiBf16Row E{(bf16_t*)(ws + WS_Q), NUQ, (const float*)(ws + WS_ROPEH), 0}; pg8::gemm_phase<pg8::EpiBf16Row, false, 2, NUQ / 256>(F.lds, g, S, E, 0, F.wave); } }
    if (IN(12)) REPS(12) {
        { pg8::Gemm g{(const bf16_t*)(ws + WS_PROJ1) + CQ, (const bf16_t*)(ws + W1_UKV), L1_INP, CKV, 0, nullptr}; pg8::StaticOrder S; S.init(NTOK / 256, NUKV / 256, F.G, F.bid);
          const float* cc_ = (const float*)(ws + WS_ROPEC);
          pg8::EpiKV1 E{(bf16_t*)(ws + WS_K), (bf16_t*)(ws + WS_KV), (const float*)(ws + WS_ROPEH), (const bf16_t*)(ws + WS_PROJ1), cc_, cc_ + (size_t)NTOK * 16, F.in[I_L1_C_KN]};
          pg8::gemm_phase<pg8::EpiKV1, false, 2, NUKV / 256>(F.lds, g, S, E, 0, F.wave); } } SEAM(12);
    if (IN(14)) REPS(14) { mla_phase(F); } SEAM(14);
    if (IN(15)) REPS(15) { pg8::Gemm g{(const bf16_t*)(ws + WS_ATT), (const bf16_t*)(ws + W1_OUT), DM, DM, 0, nullptr}; pg8::StaticOrder S; S.init(NTOK / 256, DM / 256, F.G, F.bid);
        pg8::EpiRes<true, true> E{ws + WS_X12, ws + WS_X3, false, nullptr, nullptr}; pg8::gemm_phase<pg8::EpiRes<true, true>, false, 2, DM / 256>(F.lds, g, S, E, 0, F.wave); } SEAM(15);
    if (IN(16)) REPS(16) { moe_route1(F); } SEAM(16);
    if (IN(17)) REPS(17) { moe_route2(F); } SEAM(17);
    if (IN(18)) REPS(18) {
        const int* tile_e = (const int*)(ws + RT_TILEE); const int used = tile_e[MOE_TILES_MAX];
        pg8::Gemm g{(const bf16_t*)(ws + WS_H3F8), (const bf16_t*)(ws + WE_GU), DM, DM, (size_t)2 * DFE * DM, (const int*)(ws + RT_ROWTOK)}; pg8::StaticOrder S; S.init(used, 2 * DFE / 256, F.G, F.bid, 0, tile_e);
        static_assert(WGU_SCALE == 32.0f && WDN_SCALE == 64.0f, "MFMA block scales below");
        pg8::EpiSwiGLU8 E{(unsigned char*)(ws + WS_HIDE), DFE, DRY(18)}; pg8::gemm_phase<pg8::EpiSwiGLU8, true, 1, 0, 0x7a7a7a7a>(F.lds, g, S, E, 0, F.wave); } SEAM(18);
    if (IN(19)) REPS(19) {
        const int* tile_e = (const int*)(ws + RT_TILEE); const int used = tile_e[MOE_TILES_MAX];
        pg8::Gemm g{(const bf16_t*)(ws + WS_HIDE), (const bf16_t*)(ws + WE_DN), DFE, DFE, (size_t)DM * DFE, nullptr}; pg8::StaticOrder S; S.init(used, DM / 256, F.G, F.bid, 0, tile_e);
        pg8::EpiBf16 E{(bf16_t*)(ws + WS_Y), DM, 1.0f}; pg8::gemm_phase<pg8::EpiBf16, false, 1, 0, 0x79797979>(F.lds, g, S, E, 0, F.wave); } SEAM(19);
    if (IN(20)) REPS(20) { moe_combine(F, DRY(20)); }
    (void)ph;
#undef IN
#undef SEAM
}

extern "C" void kernel_launch(void* const* d_in, const int* in_sizes, int n_in, void* d_out, int out_size, void* d_ws, size_t ws_size, hipStream_t stream) {
    static int grid = 0;
    if (grid == 0) {
        if (n_in != 28 || in_sizes[0] != NTOK * DM || out_size != NTOK * DM || ws_size < WS_END) {
            fprintf(stderr, "kernel_launch: unexpected shapes (n_in %d, in0 %d, out %d, ws %zu < %zu); nothing launched\n", n_in, n_in > 0 ? in_sizes[0] : -1, out_size, ws_size, (size_t)WS_END); grid = -1; return; }
        int dev = 0, cus = 0, per_cu = 0;
        if (hipGetDevice(&dev) != hipSuccess || hipDeviceGetAttribute(&cus, hipDeviceAttributeMultiprocessorCount, dev) != hipSuccess) { grid = -1; return; }
        if (hipFuncSetAttribute((const void*)mk_fwd, hipFuncAttributeMaxDynamicSharedMemorySize, LDS_BYTES) != hipSuccess) { fprintf(stderr, "kernel_launch: hipFuncSetAttribute failed\n"); grid = -1; return; }
        if (hipOccupancyMaxActiveBlocksPerMultiprocessor(&per_cu, (const void*)mk_fwd, 512, LDS_BYTES) != hipSuccess || per_cu < 1) fprintf(stderr, "kernel_launch: occupancy query reports %d\n", per_cu);
        (void)hipGetLastError();
        grid = cus;
    }
    if (grid < 0) return;
    if (hipMemsetAsync((char*)d_ws + WS_CTL, 0, CTL_ZERO_BYTES, stream) != hipSuccess) return;
    Args a{};
    for (int i = 0; i < 28; ++i) a.in[i] = (const float*)d_in[i];
    a.out = (float*)d_out; a.ws = (unsigned char*)d_ws; a.probe = PROBE_MASK; a.pad = 0;
    if (MK_PER_PHASE) {
        for (int p = 0; p < NPHASE; ++p) { a.ph_lo = p; a.ph_hi = p + 1; hipLaunchKernelGGL(mk_fwd, dim3(grid), dim3(512), LDS_BYTES, stream, a); }
    } else {
        a.ph_lo = 0; a.ph_hi = NPHASE; hipLaunchKernelGGL(mk_fwd, dim3(grid), dim3(512), LDS_BYTES, stream, a);
    }
}
```

```cpp
#include <hip/hip_runtime.h>
#include <cstdio>
#include <cstdint>

#ifndef PROBE_MASK
#define PROBE_MASK 0u
#endif
#ifndef MK_PER_PHASE
#define MK_PER_PHASE 0
#endif

#define LAS __attribute__((address_space(3)))
#define GAS __attribute__((address_space(1)))
typedef unsigned short bf16_t;
typedef short bf16x8 __attribute__((ext_vector_type(8)));
typedef short s16x4 __attribute__((ext_vector_type(4)));
typedef float f32x2 __attribute__((ext_vector_type(2)));
typedef float f32x4 __attribute__((ext_vector_type(4)));
typedef float f32x16 __attribute__((ext_vector_type(16)));
typedef unsigned u32x2 __attribute__((ext_vector_type(2)));
typedef unsigned u32x4 __attribute__((ext_vector_type(4)));
typedef int v8i_t __attribute__((ext_vector_type(8)));
typedef int v4i_t __attribute__((ext_vector_type(4)));
typedef short bf16x16_t __attribute__((ext_vector_type(16)));

constexpr int NTOK = 65536, DM = 1024, SEQ = 2048, NBATCH = 32;
constexpr int L0_IN = 2304, DFF = 2816, L1_INP = 768  , CQ = 384, CKV = 256, NUQ = 1536, NUKV = 2048;
constexpr int NEXP = 8, DFE = 3584, MOE_ROWS_MAX = 133120  , MOE_TILES_MAX = 520, MOE_CHUNK_TILES = 130;
constexpr float EPS = 1e-6f;
constexpr float LOG2E = 1.4426950408889634f;
constexpr float WGU_SCALE = 32.0f, WDN_SCALE = 64.0f;

constexpr size_t MiB = 1u << 20;
constexpr size_t WS_CTL = 0, CTL_ZERO_BYTES = 64 * 1024;
constexpr size_t WS_ROUTE = 1 * MiB;
constexpr size_t RT_TOKE = WS_ROUTE;
constexpr size_t RT_TOKG = RT_TOKE + (size_t)NTOK * 8;
constexpr size_t RT_TOKS = RT_TOKG + (size_t)NTOK * 8;
constexpr size_t RT_ROWTOK = RT_TOKS + (size_t)NTOK * 8;
constexpr size_t RT_WGCNT = RT_ROWTOK + (size_t)MOE_ROWS_MAX * 4;
constexpr size_t RT_TILEE = RT_WGCNT + 1024 * 8 * 4;
constexpr size_t RT_ROWST = RT_TILEE + 4096;
constexpr size_t RT_END = RT_ROWST + (size_t)NTOK * 8;
static_assert(RT_END <= 4 * MiB, "route tables");
constexpr size_t WS_W = 4 * MiB;
constexpr size_t W0_IN = WS_W;
constexpr size_t W0_OUT = W0_IN + (size_t)L0_IN * DM * 2;
constexpr size_t W0_GU = W0_OUT + (size_t)DM * DM * 2;
constexpr size_t W0_DN = W0_GU + (size_t)2 * DFF * DM * 2;
constexpr size_t W1_IN = W0_DN + (size_t)DM * DFF * 2;
constexpr size_t W1_UQ = W1_IN + (size_t)L1_INP * DM * 2;
constexpr size_t W1_UKV = W1_UQ + (size_t)NUQ * CQ * 2;
constexpr size_t W1_OUT = W1_UKV + (size_t)NUKV * CKV * 2;
constexpr size_t WE_GU = W1_OUT + (size_t)DM * DM * 2;
constexpr size_t WE_DN = WE_GU + (size_t)NEXP * 2 * DFE * DM;
constexpr size_t WS_W_END = WE_DN + (size_t)NEXP * DM * DFE;
static_assert(WS_W_END <= 202 * MiB, "weights");
constexpr size_t WS_H = 202 * MiB;
constexpr size_t WS_PROJ0 = 330 * MiB;
constexpr size_t WS_MIX = 618 * MiB;
constexpr size_t WS_PART = 746 * MiB;
constexpr size_t WS_LSE = 874 * MiB;
constexpr size_t WS_X12 = 746 * MiB;
constexpr size_t WS_SSX = 1004 * MiB;
constexpr size_t WS_ROPEH = 1000 * MiB;
constexpr size_t WS_ROPEC = 1016 * MiB;
constexpr size_t WS_HID0 = 330 * MiB;
constexpr size_t WS_PROJ1 = 878 * MiB;
constexpr size_t WS_Q = 426 * MiB;
constexpr size_t WS_KV = 618 * MiB;
constexpr size_t WS_K = 202 * MiB;
constexpr size_t WS_ATT = 874 * MiB;
constexpr size_t WS_X3 = 117 * MiB;
constexpr size_t WS_H3F8 = 245 * MiB;
constexpr size_t WS_HIDE = 309 * MiB;
constexpr size_t WS_Y = 764 * MiB;
static_assert(WE_DN + (size_t)NEXP * DM * DFE <= WS_X3 && WS_X3 + (size_t)NTOK * DM * 2 <= WS_H3F8, "x3 map");
constexpr size_t WS_END = 1024 * MiB;
static_assert(WS_H3F8 + (size_t)NTOK * DM <= WS_HIDE && WS_HIDE + (size_t)MOE_ROWS_MAX * DFE <= WS_Y && WS_Y + (size_t)MOE_ROWS_MAX * DM * 2 <= WS_END, "moe map");
static_assert(WS_ATT + (size_t)NTOK * DM * 2 <= WS_ROPEC, "att map");

constexpr int CW_BAR = 1024;

constexpr int RING_BYTES = 131072;
constexpr int LDS_ROWTAB = RING_BYTES;
constexpr int LDS_BYTES = 147456;
constexpr int LDS_MISC = LDS_BYTES - 256;

#define RLX_AGENT __ATOMIC_RELAXED, __HIP_MEMORY_SCOPE_AGENT
#define LDS_WAIT() asm volatile("s_waitcnt lgkmcnt(0)" ::: "memory")
#define VM_WAIT() asm volatile("s_waitcnt vmcnt(0)" ::: "memory")
__device__ __forceinline__ unsigned cvt_pk_bf16(float lo, float hi) { unsigned r; asm volatile("v_cvt_pk_bf16_f32 %0, %1, %2" : "=v"(r) : "v"(lo), "v"(hi)); return r; }
__device__ __forceinline__ unsigned pk4_fp8(float a, float b, float c, float d) { int w = 0; w = __builtin_amdgcn_cvt_pk_fp8_f32(a, b, w, false); w = __builtin_amdgcn_cvt_pk_fp8_f32(c, d, w, true); return (unsigned)w; }
__device__ __forceinline__ float bf_lo(unsigned u) { return __uint_as_float(u << 16); }
__device__ __forceinline__ float bf_hi(unsigned u) { return __uint_as_float(u & 0xffff0000u); }
__device__ __forceinline__ int lane_id() { return (int)__builtin_amdgcn_mbcnt_hi(~0u, __builtin_amdgcn_mbcnt_lo(~0u, 0u)); }
__device__ __forceinline__ int lane_id_v() { int l; asm volatile("v_mbcnt_lo_u32_b32 %0, -1, 0\n\tv_mbcnt_hi_u32_b32 %0, -1, %0" : "=v"(l)); return l; }
__device__ __forceinline__ float wave_sum(float v) {
#pragma unroll
    for (int o = 1; o < 64; o <<= 1) v += __shfl_xor(v, o);
    return v;
}
__device__ __forceinline__ float fq_sum(float v) {
    auto a = __builtin_amdgcn_permlane16_swap(__float_as_uint(v), __float_as_uint(v), false, false); v = __uint_as_float(a[0]) + __uint_as_float(a[1]);
    auto b = __builtin_amdgcn_permlane32_swap(__float_as_uint(v), __float_as_uint(v), false, false); return __uint_as_float(b[0]) + __uint_as_float(b[1]); }
__device__ __forceinline__ float swap32_max(float v) { auto rr = __builtin_amdgcn_permlane32_swap(__float_as_uint(v), __float_as_uint(v), false, false); return fmaxf(__uint_as_float(rr[0]), __uint_as_float(rr[1])); }
__device__ __forceinline__ float swap32_sum(float v) { auto rr = __builtin_amdgcn_permlane32_swap(__float_as_uint(v), __float_as_uint(v), false, false); return __uint_as_float(rr[0]) + __uint_as_float(rr[1]); }

#define XB_TMO      128
#define XB_XCNT(j)  (256  + 64 * (j))
#define XB_XSUB(j)  (1280 + 64 * (j))
#define XB_XGEN(j)  (2304 + 64 * (j))
#define XB_TOP      3328
#define XB_TOPGEN   3392
#define XCD_BAR_WORDS 3456
#define XB_SPIN_CAP (1u << 18)
__device__ __forceinline__ unsigned xb_ld(unsigned* p)              { return __hip_atomic_load(p, __ATOMIC_RELAXED, __HIP_MEMORY_SCOPE_AGENT); }
__device__ __forceinline__ unsigned xb_add(unsigned* p, unsigned v) { return __hip_atomic_fetch_add(p, v, __ATOMIC_RELAXED, __HIP_MEMORY_SCOPE_AGENT); }
__device__ __forceinline__ unsigned xb_xcc_id() { return (unsigned)__builtin_amdgcn_s_getreg((3 << 11) | 20) & 0xFu; }
#define XB_SPIN(cond, bar) do { unsigned _sp = 0; while (cond) { __builtin_amdgcn_s_sleep(1); \
    if ((++_sp & 255u) == 0u) { if (xb_ld(&(bar)[XB_TMO])) break; if (_sp > XB_SPIN_CAP) { atomicAdd(&(bar)[XB_TMO], 1u); break; } } } } while (0)
struct XcdBarrier { unsigned* bar; unsigned x; volatile LAS unsigned* st; int wave; };
__device__ __forceinline__ XcdBarrier xcd_barrier_post(unsigned* bar, volatile LAS unsigned* st, int wave) {
    XcdBarrier b; b.bar = bar; b.x = xb_xcc_id(); b.st = st; b.wave = wave;
    if (wave == 0 && lane_id() == 0) (void)xb_add(&bar[XB_XCNT(b.x)], 1u);
    return b;
}
__device__ __forceinline__ void xcd_barrier_complete(unsigned* bar, unsigned x, unsigned& nloc, unsigned& nx) {
    const unsigned G = gridDim.x * gridDim.y * gridDim.z;
    unsigned sum, cnt, mine, sp = 0u;
    for (;;) {
        sum = 0u; cnt = 0u; mine = 0u;
#pragma unroll
        for (unsigned j = 0; j < 16; ++j) { const unsigned c = xb_ld(&bar[XB_XCNT(j)]); sum += c; cnt += (c > 0u) ? 1u : 0u; mine = (j == x) ? c : mine; }
        if (sum == G) break;
        __builtin_amdgcn_s_sleep(1);
        if ((++sp & 255u) == 0u) { if (xb_ld(&bar[XB_TMO])) break; if (sp > XB_SPIN_CAP) { atomicAdd(&bar[XB_TMO], 1u); break; } }
    }
    nloc = mine > 0u ? mine : 1u; nx = cnt > 0u ? cnt : 1u;
}
__device__ __forceinline__ void xcd_barrier(const XcdBarrier& b) {
    asm volatile("s_waitcnt vmcnt(0)" ::: "memory");
    __syncthreads();
    if (b.wave == 0 && lane_id() == 0) {
        unsigned* bar = b.bar;
        __builtin_amdgcn_s_waitcnt(0);
        unsigned nloc = b.st[0], nx = b.st[1];
        if (nloc == 0u) { xcd_barrier_complete(bar, b.x, nloc, nx); b.st[0] = nloc; b.st[1] = nx; }
        const unsigned old = xb_add(&bar[XB_XSUB(b.x)], 1u);
        const unsigned gen = old / nloc;
        if (old + 1u == (gen + 1u) * nloc) {
            __builtin_amdgcn_fence(__ATOMIC_RELEASE, "agent");
            asm volatile("s_waitcnt vmcnt(0)" ::: "memory");
            const unsigned og = xb_add(&bar[XB_TOP], 1u);
            const unsigned tg = og / nx;
            if (og + 1u == (tg + 1u) * nx) xb_add(&bar[XB_TOPGEN], 1u);
            else XB_SPIN(xb_ld(&bar[XB_TOPGEN]) == tg, bar);
            __builtin_amdgcn_fence(__ATOMIC_ACQUIRE, "agent");
            xb_add(&bar[XB_XGEN(b.x)], 1u);
            asm volatile("s_waitcnt vmcnt(0)" ::: "memory");
        } else {
            XB_SPIN(xb_ld(&bar[XB_XGEN(b.x)]) == gen, bar);
            __builtin_amdgcn_fence(__ATOMIC_ACQUIRE, "agent");
            asm volatile("s_waitcnt vmcnt(0)" ::: "memory");
        }
    }
    __syncthreads();
}

namespace pg8 {
constexpr int BM = 256, BK = 64, HALF = 128, HTB = HALF * BK * 2, STAGE_BYTES = 8 * HTB, NXCD = 8, WGM = 8;
__host__ __device__ __forceinline__ int lds_byte(int r, int c) { const int st = (r >> 4) * 2 + (c >> 5), rr = r & 15, cc = c & 31, ob = rr * 64 + cc * 2; return st * 1024 + (ob ^ (((ob >> 9) & 1) << 5)); }
__host__ __device__ __forceinline__ void stage_rc(int b, int& R, int& C) { const int st = b / 1024, sb = b % 1024, swz = sb ^ (((sb >> 9) & 1) << 5); R = (st >> 1) * 16 + swz / 64; C = (st & 1) * 32 + (swz % 64) / 2; }
__host__ __device__ __forceinline__ int perm32(int rho) { const int n = rho >> 4, i = rho & 15; return 8 * (i >> 2) + 4 * n + (i & 3); }

struct Unit { int pm, pn, e; };
struct Gemm { const bf16_t* A; const bf16_t* Bt; int lda, K; size_t bstride; const int* rowtab; };

struct StaticOrder {
    int nM, nN, nwg, G, c, pm0; const int* tile_e;
    __device__ void init(int nM_, int nN_, int G_, int c_, int pm0_ = 0, const int* te = nullptr) { nM = nM_; nN = nN_; nwg = nM * nN; G = G_; c = c_; pm0 = pm0_; tile_e = te; }
    template <int NN> __device__ bool next_dense(int i, Unit& u) const {
        const int L = i * G + c; if (L >= nwg) return false;
        const int wgid = (L % NXCD) * ((NTOK / 256) * NN / NXCD) + L / NXCD;
        const int gid = wgid / (WGM * NN), w = wgid % (WGM * NN);
        u.pm = gid * WGM + (w % WGM); u.pn = w / WGM; u.e = 0; return true;
    }
    __device__ bool next(int i, Unit& u) const {
        const int L = i * G + c; if (L >= nwg) return false;
        int wgid = L; { const int q = nwg / NXCD, r = nwg % NXCD, xcd = wgid % NXCD, off = wgid / NXCD; wgid = (xcd < r ? xcd * (q + 1) : r * (q + 1) + (xcd - r) * q) + off; }
        const int nig = WGM * nN, gid = wgid / nig, fm = gid * WGM, gsz = (nM - fm) < WGM ? (nM - fm) : WGM;
        u.pm = pm0 + fm + ((wgid % nig) % gsz); u.pn = (wgid % nig) / gsz;
        u.e = tile_e ? __builtin_amdgcn_readfirstlane(tile_e[u.pm]) : 0;
        return true;
    }
};

template <class Epi, bool GATHER, int ESZ = 2, int NNC = 0, int WSC = 0x7f7f7f7f  >
__device__ __forceinline__ void gemm_phase(LAS unsigned char* lds, const Gemm g, const StaticOrder& S, const Epi& E, int a_row0  , int wave_id) {
    const int wid = wave_id, wr = wid >> 2, wc = wid & 3;
    const int K = g.K, nt = K * ESZ / 128, lda = g.lda;
    const unsigned hstepA = (unsigned)(HALF * lda * ESZ), hstepB = (unsigned)(HALF * K * ESZ);
    const unsigned ldsw0 = (unsigned)wid * 1024u;
    const __amdgpu_buffer_rsrc_t rsA = __builtin_amdgcn_make_buffer_rsrc((void*)g.A, (short)0, 0x7ffffff0, 0x00020000);
    const __amdgpu_buffer_rsrc_t rsB = __builtin_amdgcn_make_buffer_rsrc((void*)g.Bt, (short)0, 0x7ffffff0, 0x00020000);
#define PG8_SA(b, h) (((b) * 2 + (h)) * HTB)
#define PG8_SB(b, h) ((4 + (b) * 2 + (h)) * HTB)
#define PG8_STAGE_B(bufoff, soff) do { _Pragma("unroll") for (int _i = 0; _i < 2; ++_i) \
        __builtin_amdgcn_raw_ptr_buffer_load_lds(rsB, (LAS unsigned*)(lds + (bufoff) + ldsw + _i * 8192), 16, voffB[_i], (soff), 0, 0); } while (0)
#define PG8_STAGE_A(bufoff, abase, h, kofs, VO) do { _Pragma("unroll") for (int _i = 0; _i < 2; ++_i) { if constexpr (GATHER) \
        __builtin_amdgcn_raw_ptr_buffer_load_lds(rsA, (LAS unsigned*)(lds + (bufoff) + ldsw + _i * 8192), 16, VO[h][_i], (kofs), 0, 0); else \
        __builtin_amdgcn_raw_ptr_buffer_load_lds(rsA, (LAS unsigned*)(lds + (bufoff) + ldsw + _i * 8192), 16, voffA[_i], (abase) + (h) * hstepA + (kofs), 0, 0); } } while (0)
#define PG8_LD1(base, i) __builtin_shufflevector(*(const LAS v4i_t*)(lds + (base) + (i) * 2048), *(const LAS v4i_t*)(lds + (base) + (i) * 2048 + 1024), 0, 1, 2, 3, 4, 5, 6, 7)
#define PG8_LD1H(off, i) __builtin_shufflevector(*(const LAS v4i_t*)(ldsB + (off) + (i) * 2048), *(const LAS v4i_t*)(ldsB + (off) + (i) * 2048 + 1024), 0, 1, 2, 3, 4, 5, 6, 7)
#define PG8_LDA(dst, b, h) do { _Pragma("unroll") for (int m = 0; m < 4; ++m) dst[m] = PG8_LD1(PG8_SA(b, h) + aoff, m); } while (0)
#define PG8_LDB(dst, b, h) do { _Pragma("unroll") for (int n = 0; n < 2; ++n) dst[n] = PG8_LD1H(PG8_SB(b, h) - 65536, n); } while (0)
#define PG8_LO(x) __builtin_bit_cast(bf16x8, __builtin_shufflevector(x, x, 0, 1, 2, 3))
#define PG8_HI(x) __builtin_bit_cast(bf16x8, __builtin_shufflevector(x, x, 4, 5, 6, 7))
#define PG8_MMA(ai, bj, At, Bt) do { __builtin_amdgcn_s_setprio(1); if constexpr (ESZ == 2) { _Pragma("unroll") for (int m = 0; m < 4; ++m) _Pragma("unroll") for (int n = 0; n < 2; ++n) { \
        acc[ai][bj][m][n] = __builtin_amdgcn_mfma_f32_16x16x32_bf16(PG8_LO(Bt[n]), PG8_LO(At[m]), acc[ai][bj][m][n], 0, 0, 0); \
        acc[ai][bj][m][n] = __builtin_amdgcn_mfma_f32_16x16x32_bf16(PG8_HI(Bt[n]), PG8_HI(At[m]), acc[ai][bj][m][n], 0, 0, 0); } } \
        else { _Pragma("unroll") for (int m = 0; m < 4; ++m) _Pragma("unroll") for (int n = 0; n < 2; ++n) \
        acc[ai][bj][m][n] = __builtin_amdgcn_mfma_scale_f32_16x16x128_f8f6f4(Bt[n], At[m], acc[ai][bj][m][n], 0, 0, 0, WSC, 0, 0x7f7f7f7f); } \
        __builtin_amdgcn_s_setprio(0); } while (0)
#define PG8_WAIT_V(n) asm volatile("s_waitcnt vmcnt(" #n ")" ::: "memory")
#define PG8_WAIT_L(n) asm volatile("s_waitcnt lgkmcnt(" #n ")" ::: "memory")
#define PG8_BAR __builtin_amdgcn_s_barrier()
#define PG8_SCHED __builtin_amdgcn_sched_barrier(0)
    Unit cur, nxt; int ui = 0;
    if (!(NNC > 0 ? S.template next_dense<NNC ? NNC : 1>(0, cur) : S.next(0, cur))) return;
    f32x4 acc[2][2][4][2];
    v8i_t At[4], B0[2], B1[2];
    unsigned voC[2][2];
    LAS int* rtab = (LAS int*)(lds + RING_BYTES);
#pragma unroll
    for (int h = 0; h < 2; ++h)
#pragma unroll
        for (int i = 0; i < 2; ++i) voC[h][i] = 0;
    unsigned cA = (unsigned)((cur.pm * BM - a_row0) * lda * ESZ), cB = (unsigned)((cur.e * (int)g.bstride + cur.pn * BM * K) * ESZ);
    for (;;) {
        float zr; asm volatile("v_mov_b32 %0, 0" : "=v"(zr));
#pragma unroll
        for (int a = 0; a < 2; ++a)
#pragma unroll
            for (int b = 0; b < 2; ++b)
#pragma unroll
                for (int m = 0; m < 4; ++m)
#pragma unroll
                    for (int n = 0; n < 2; ++n) { acc[a][b][m][n] = (f32x4){zr, zr, zr, zr}; }
        const int lane = lane_id_v(), tid = wid * 64 + lane, fr = lane & 15, fq = lane >> 4;
        unsigned voffA[2], voffB[2];
#pragma unroll
        for (int i = 0; i < 2; ++i) { int R_, C_; stage_rc(tid * 16 + i * 8192, R_, C_); voffA[i] = (unsigned)(R_ * lda * ESZ + C_ * 2); voffB[i] = (unsigned)(R_ * K * ESZ + C_ * 2); }
        const int aoff = lds_byte(wr * 64 + fr, fq * 8), boff = lds_byte(wc * 32 + fr, fq * 8);
        LAS unsigned char* ldsB = lds + 65536 + boff;
        if (ui == 0) {
            const unsigned ldsw = ldsw0;
            if constexpr (GATHER) {
#pragma unroll
                for (int h = 0; h < 2; ++h)
#pragma unroll
                    for (int i = 0; i < 2; ++i) { int R_, C_; stage_rc(tid * 16 + i * 8192, R_, C_); int t = g.rowtab[cur.pm * BM + h * HALF + R_]; t = t < 0 ? 0 : t; voC[h][i] = (unsigned)t * (unsigned)(lda * ESZ) + (unsigned)C_ * 2u; }
                VM_WAIT();
            }
            PG8_STAGE_B(PG8_SB(0, 0), cB); PG8_STAGE_B(PG8_SB(0, 1), cB + hstepB); PG8_STAGE_A(PG8_SA(0, 0), cA, 0, 0u, voC); PG8_STAGE_A(PG8_SA(0, 1), cA, 1, 0u, voC);
            if (wr == 1) PG8_BAR;
            PG8_WAIT_V(2); PG8_BAR;
            PG8_STAGE_B(PG8_SB(1, 0), cB + 128u); PG8_STAGE_A(PG8_SA(1, 0), cA, 0, 128u, voC); PG8_STAGE_B(PG8_SB(1, 1), cB + hstepB + 128u);
            PG8_WAIT_V(6); PG8_BAR;
        }
        const bool has_next = NNC > 0 ? S.template next_dense<NNC ? NNC : 1>(ui + 1, nxt) : S.next(ui + 1, nxt);
        const unsigned nA = has_next ? (unsigned)((nxt.pm * BM - a_row0) * lda * ESZ) : cA, nB = has_next ? (unsigned)((nxt.e * (int)g.bstride + nxt.pn * BM * K) * ESZ) : cB;
        if constexpr (GATHER) {
            if (has_next && wid == 0) __builtin_amdgcn_global_load_lds((const unsigned*)(g.rowtab + nxt.pm * BM + lane * 4), (LAS unsigned*)(lds + RING_BYTES + ((ui + 1) & 1) * 1024), 16, 0, 0);
        }
#pragma unroll 1
        for (int t = 0; t < nt; t += 2) {
            unsigned ldsw = ldsw0; asm volatile("" : "+s"(ldsw));
            int last_i = __builtin_amdgcn_readfirstlane((t == nt - 2) ? 1 : 0); asm volatile("" : "+s"(last_i));
            const bool last = last_i != 0;
            const unsigned k1 = (unsigned)(t + 1) * 128u;
            const unsigned a2 = last ? nA : cA, k2 = last ? 0u : (unsigned)(t + 2) * 128u;
            const unsigned b2 = last ? nB : cB + (unsigned)(t + 2) * 128u;
            const unsigned b3 = b2 + 128u, k3 = k2 + 128u;
            PG8_LDB(B0, 0, 0); PG8_LDB(B1, 0, 1); PG8_SCHED; PG8_LDA(At, 0, 0); PG8_STAGE_A(PG8_SA(1, 1), cA, 1, k1, voC);
            PG8_WAIT_V(8); PG8_WAIT_L(0); PG8_BAR; PG8_MMA(0, 0, At, B0); PG8_MMA(0, 1, At, B1); PG8_BAR; PG8_SCHED;
            if constexpr (GATHER) {
                if (last && has_next) {
#pragma unroll
                    for (int h = 0; h < 2; ++h)
#pragma unroll
                        for (int i = 0; i < 2; ++i) { int R_, C_; stage_rc(tid * 16 + i * 8192, R_, C_); int tk = rtab[((ui + 1) & 1) * 256 + h * HALF + R_]; tk = tk < 0 ? 0 : tk; voC[h][i] = (unsigned)tk * (unsigned)(lda * ESZ) + (unsigned)C_ * 2u; }
                }
            }
            PG8_LDA(At, 0, 1); PG8_STAGE_B(PG8_SB(0, 0), b2); PG8_STAGE_B(PG8_SB(0, 1), b2 + hstepB);
            PG8_STAGE_A(PG8_SA(0, 0), a2, 0, k2, voC);
            PG8_WAIT_V(8); PG8_WAIT_L(0); PG8_BAR; PG8_MMA(1, 0, At, B0); PG8_MMA(1, 1, At, B1); PG8_BAR; PG8_SCHED;
            PG8_LDB(B0, 1, 0); PG8_LDB(B1, 1, 1); PG8_SCHED; PG8_LDA(At, 1, 0);
            PG8_STAGE_A(PG8_SA(0, 1), a2, 1, k2, voC);
            PG8_WAIT_V(8); PG8_WAIT_L(0); PG8_BAR; PG8_MMA(0, 0, At, B0); PG8_MMA(0, 1, At, B1); PG8_BAR; PG8_SCHED;
            PG8_LDA(At, 1, 1); PG8_STAGE_B(PG8_SB(1, 0), b3); PG8_STAGE_B(PG8_SB(1, 1), b3 + hstepB);
            PG8_STAGE_A(PG8_SA(1, 0), a2, 0, k3, voC);
            PG8_WAIT_V(8); PG8_WAIT_L(0); PG8_BAR; PG8_MMA(1, 0, At, B0); PG8_MMA(1, 1, At, B1); PG8_BAR; PG8_SCHED;
        }
        if (wr == 0) PG8_BAR;
        { const int l2 = lane_id_v(); E(acc, cur, wr, wc, l2 & 15, l2 >> 4); }
        if (!has_next) break;
        cur = nxt; cA = nA; cB = nB; ++ui;
        if (wr == 1) PG8_BAR;
    }
    PG8_WAIT_V(0);
    PG8_BAR;
#undef PG8_SA
#undef PG8_SB
#undef PG8_STAGE_A
#undef PG8_STAGE_B
#undef PG8_LD1
#undef PG8_LD1H
#undef PG8_LDA
#undef PG8_LDB
#undef PG8_LO
#undef PG8_HI
#undef PG8_MMA
#undef PG8_WAIT_V
#undef PG8_WAIT_L
#undef PG8_BAR
#undef PG8_SCHED
}


struct EpiBf16 {
    bf16_t* O; int ldc; float sc;
    __device__ __forceinline__ void operator()(const f32x4 (&acc)[2][2][4][2], const Unit& u, int wr, int wc, int fr, int fq) const {
        const int row0 = u.pm * BM + wr * 64 + fr, col0 = u.pn * BM + wc * 32 + 8 * fq;
#pragma unroll
        for (int ai = 0; ai < 2; ++ai)
#pragma unroll
            for (int m = 0; m < 4; ++m) { bf16_t* rowp = O + (size_t)(row0 + ai * HALF + m * 16) * ldc + col0;
#pragma unroll
                for (int bj = 0; bj < 2; ++bj) { const f32x4 v0 = acc[ai][bj][m][0] * sc, v1 = acc[ai][bj][m][1] * sc;
                    u32x4 w; w.x = cvt_pk_bf16(v0[0], v0[1]); w.y = cvt_pk_bf16(v0[2], v0[3]); w.z = cvt_pk_bf16(v1[0], v1[1]); w.w = cvt_pk_bf16(v1[2], v1[3]);
                    *(u32x4*)(rowp + bj * HALF) = w; } }
    }
};
struct EpiFp8 {
    unsigned char* O; int ldc;
    __device__ __forceinline__ void operator()(const f32x4 (&acc)[2][2][4][2], const Unit& u, int wr, int wc, int fr, int fq) const {
        const int row0 = u.pm * BM + wr * 64 + fr, col0 = u.pn * BM + wc * 32 + 8 * fq;
#pragma unroll
        for (int ai = 0; ai < 2; ++ai)
#pragma unroll
            for (int m = 0; m < 4; ++m) { unsigned char* rowp = O + (size_t)(row0 + ai * HALF + m * 16) * ldc + col0;
#pragma unroll
                for (int bj = 0; bj < 2; ++bj) { const f32x4 v0 = acc[ai][bj][m][0], v1 = acc[ai][bj][m][1];
                    u32x2 w; w.x = pk4_fp8(__builtin_amdgcn_fmed3f(v0[0], -448.f, 448.f), __builtin_amdgcn_fmed3f(v0[1], -448.f, 448.f), __builtin_amdgcn_fmed3f(v0[2], -448.f, 448.f), __builtin_amdgcn_fmed3f(v0[3], -448.f, 448.f));
                    w.y = pk4_fp8(__builtin_amdgcn_fmed3f(v1[0], -448.f, 448.f), __builtin_amdgcn_fmed3f(v1[1], -448.f, 448.f), __builtin_amdgcn_fmed3f(v1[2], -448.f, 448.f), __builtin_amdgcn_fmed3f(v1[3], -448.f, 448.f));
                    *(u32x2*)(rowp + bj * HALF) = w; } }
    }
};
struct EpiProj1 {
    bf16_t* O; float* SS; LAS float* part; const float* ssx;
    __device__ __forceinline__ void operator()(const f32x4 (&acc)[2][2][4][2], const Unit& u, int wr, int wc, int fr, int fq) const {
        const int row0 = u.pm * BM + wr * 64 + fr, col0 = u.pn * BM + wc * 32 + 8 * fq, wid = wr * 4 + wc;
        float rsv[8];
#pragma unroll
        for (int i = 0; i < 8; ++i) { const f32x4 x4 = *(const f32x4*)(ssx + (size_t)(row0 + (i >> 2) * HALF + (i & 3) * 16) * 4); rsv[i] = __builtin_amdgcn_rsqf(((x4[0] + x4[1]) + (x4[2] + x4[3])) * (1.f / DM) + EPS); }
#pragma unroll
        for (int ai = 0; ai < 2; ++ai)
#pragma unroll
            for (int m = 0; m < 4; ++m) { bf16_t* rowp = O + (size_t)(row0 + ai * HALF + m * 16) * L1_INP + col0;
                const float rstd = rsv[ai * 4 + m];
#pragma unroll
                for (int bj = 0; bj < 2; ++bj) { const f32x4 v0 = acc[ai][bj][m][0] * rstd, v1 = acc[ai][bj][m][1] * rstd;
                    u32x4 w; w.x = cvt_pk_bf16(v0[0], v0[1]); w.y = cvt_pk_bf16(v0[2], v0[3]); w.z = cvt_pk_bf16(v1[0], v1[1]); w.w = cvt_pk_bf16(v1[2], v1[3]);
                    *(u32x4*)(rowp + bj * HALF) = w;
                    float ss = (bf_lo(w.x) * bf_lo(w.x) + bf_hi(w.x) * bf_hi(w.x)) + (bf_lo(w.y) * bf_lo(w.y) + bf_hi(w.y) * bf_hi(w.y)) + (bf_lo(w.z) * bf_lo(w.z) + bf_hi(w.z) * bf_hi(w.z)) + (bf_lo(w.w) * bf_lo(w.w) + bf_hi(w.w) * bf_hi(w.w));
                    ss = fq_sum(ss);
                    if (fq == 0) part[((wid * 2 + bj) * 8 + ai * 4 + m) * 16 + fr] = ss; } }
        asm volatile("s_waitcnt lgkmcnt(0)\n\ts_barrier" ::: "memory");
        { const int t = wid * 64 + fq * 16 + fr, bj = t >> 8, wr2 = (t >> 7) & 1, am = (t >> 4) & 7, fr2 = t & 15;
          const LAS float* pp = part + ((wr2 * 4 * 2 + bj) * 8 + am) * 16 + fr2;
          const float ssum = (pp[0] + pp[2 * 8 * 16]) + (pp[2 * 2 * 8 * 16] + pp[3 * 2 * 8 * 16]);
          const int row = u.pm * BM + (am >> 2) * HALF + wr2 * 64 + (am & 3) * 16 + fr2, sl = u.pn * 2 + bj;
          SS[(size_t)row * 8 + sl + (sl >= 3 ? 1 : 0)] = ssum; }
    }
};
struct EpiBf16Row {
    bf16_t* O; int ldc; const float* rs; int which;
    __device__ __forceinline__ void operator()(const f32x4 (&acc)[2][2][4][2], const Unit& u, int wr, int wc, int fr, int fq) const {
        const int row0 = u.pm * BM + wr * 64 + fr;
        float scv[8];
#pragma unroll
        for (int i = 0; i < 8; ++i) { const f32x4 s4 = *(const f32x4*)(rs + (size_t)(row0 + (i >> 2) * HALF + (i & 3) * 16) * 8); scv[i] = __builtin_amdgcn_rsqf(((s4[0] + s4[1]) + s4[2]) * (1.f / CQ) + EPS); }
#pragma unroll
        for (int ai = 0; ai < 2; ++ai)
#pragma unroll
            for (int m = 0; m < 4; ++m) { const int row = row0 + ai * HALF + m * 16; const float sc = scv[ai * 4 + m]; const int b = row >> 11, t = row & (SEQ - 1);
#pragma unroll
                for (int bj = 0; bj < 2; ++bj) { const f32x4 v0 = acc[ai][bj][m][0] * sc, v1 = acc[ai][bj][m][1] * sc;
                    u32x4 w; w.x = cvt_pk_bf16(v0[0], v0[1]); w.y = cvt_pk_bf16(v0[2], v0[3]); w.z = cvt_pk_bf16(v1[0], v1[1]); w.w = cvt_pk_bf16(v1[2], v1[3]);
                    const int col = u.pn * BM + bj * HALF + wc * 32 + 8 * fq;
                    bf16_t* dst;
                    if (which == 0) { const int hd = col / 96, d = col - hd * 96; dst = O + (((size_t)b * 16 + hd) * SEQ + t) * 96 + d; }
                    else { const int hd = col >> 7, d = col & 127;
                        dst = d < 64 ? O + (size_t)row * 1024 + hd * 64 + d : O + (size_t)NTOK * 1024 + (((size_t)b * 16 + hd) * SEQ + t) * 64 + (d - 64); }
                    *(u32x4*)dst = w; } }
    }
};
template <bool RB, bool OB, bool ST = false>
struct EpiRes {
    const void* res; void* out; bool dry; float* SS; LAS float* part;
    __device__ __forceinline__ void operator()(const f32x4 (&acc)[2][2][4][2], const Unit& u, int wr, int wc, int fr, int fq) const {
        const int row0 = u.pm * BM + wr * 64 + fr, col0 = u.pn * BM + wc * 32 + 8 * fq;
#pragma unroll
        for (int ai = 0; ai < 2; ++ai) {
            u32x4 xb_[4][2]; f32x4 xf_[4][2][2];
#pragma unroll
            for (int m = 0; m < 4; ++m)
#pragma unroll
                for (int bj = 0; bj < 2; ++bj) { const size_t o = (size_t)(row0 + ai * HALF + m * 16) * DM + col0 + bj * HALF;
                    if constexpr (RB) xb_[m][bj] = *(const u32x4*)((const bf16_t*)res + o); else { xf_[m][bj][0] = *(const f32x4*)((const float*)res + o); xf_[m][bj][1] = *(const f32x4*)((const float*)res + o + 4); } }
            __builtin_amdgcn_sched_barrier(0);
#pragma unroll
            for (int m = 0; m < 4; ++m) { const size_t off = (size_t)(row0 + ai * HALF + m * 16) * DM + col0; float ssr = 0.f;
#pragma unroll
                for (int bj = 0; bj < 2; ++bj) { const size_t o = off + bj * HALF;
                    f32x4 r0, r1;
                    if constexpr (RB) { const u32x4 x = xb_[m][bj]; r0 = (f32x4){bf_lo(x.x), bf_hi(x.x), bf_lo(x.y), bf_hi(x.y)}; r1 = (f32x4){bf_lo(x.z), bf_hi(x.z), bf_lo(x.w), bf_hi(x.w)}; }
                    else { r0 = xf_[m][bj][0]; r1 = xf_[m][bj][1]; }
                    r0 += acc[ai][bj][m][0]; r1 += acc[ai][bj][m][1];
                    if (!dry) {
                        if constexpr (OB) { u32x4 w; w.x = cvt_pk_bf16(r0[0], r0[1]); w.y = cvt_pk_bf16(r0[2], r0[3]); w.z = cvt_pk_bf16(r1[0], r1[1]); w.w = cvt_pk_bf16(r1[2], r1[3]); *(u32x4*)((bf16_t*)out + o) = w;
                            if constexpr (ST) ssr += (bf_lo(w.x) * bf_lo(w.x) + bf_hi(w.x) * bf_hi(w.x)) + (bf_lo(w.y) * bf_lo(w.y) + bf_hi(w.y) * bf_hi(w.y)) + (bf_lo(w.z) * bf_lo(w.z) + bf_hi(w.z) * bf_hi(w.z)) + (bf_lo(w.w) * bf_lo(w.w) + bf_hi(w.w) * bf_hi(w.w)); }
                        else { *(f32x4*)((float*)out + o) = r0; *(f32x4*)((float*)out + o + 4) = r1; } } }
                if constexpr (ST) { ssr = fq_sum(ssr); if (fq == 0) part[((wr * 4 + wc) * 8 + ai * 4 + m) * 16 + fr] = ssr; } }
        }
        if constexpr (ST) {
            asm volatile("s_waitcnt lgkmcnt(0)\n\ts_barrier" ::: "memory");
            const int t = (wr * 4 + wc) * 64 + fq * 16 + fr;
            if (t < 256) { const int wr2 = t >> 7, am = (t >> 4) & 7, fr2 = t & 15; const LAS float* pp = part + (wr2 * 4 * 8 + am) * 16 + fr2;
                const float ssum = (pp[0] + pp[8 * 16]) + (pp[2 * 8 * 16] + pp[3 * 8 * 16]);
                SS[(size_t)(u.pm * BM + (am >> 2) * HALF + wr2 * 64 + (am & 3) * 16 + fr2) * 4 + u.pn] = ssum; }
        }
    }
};
struct EpiSwiGLU {
    bf16_t* H; int ldc; int row_sub; const float* ss;
    __device__ __forceinline__ void operator()(const f32x4 (&acc)[2][2][4][2], const Unit& u, int wr, int wc, int fr, int fq) const {
        const int row0 = u.pm * BM - row_sub + wr * 64 + fr, col0 = u.pn * HALF + wc * 32 + 8 * fq;
        float rsv[8];
#pragma unroll
        for (int i = 0; i < 8; ++i) { const f32x4 s4 = *(const f32x4*)(ss + (size_t)(row0 + (i >> 2) * HALF + (i & 3) * 16) * 4); rsv[i] = __builtin_amdgcn_rsqf(((s4[0] + s4[1]) + (s4[2] + s4[3])) * (1.f / DM) + EPS); }
#pragma unroll
        for (int ai = 0; ai < 2; ++ai)
#pragma unroll
            for (int m = 0; m < 4; ++m) { bf16_t* rowp = H + (size_t)(row0 + ai * HALF + m * 16) * ldc + col0;
                const float rstd = rsv[ai * 4 + m];
                float r[8];
#pragma unroll
                for (int n = 0; n < 2; ++n)
#pragma unroll
                    for (int j = 0; j < 4; ++j) { const float gt = acc[ai][0][m][n][j] * rstd, up = acc[ai][1][m][n][j] * rstd;
                        r[n * 4 + j] = gt * __builtin_amdgcn_rcpf(1.0f + __builtin_amdgcn_exp2f(-gt * LOG2E)) * up; }
                u32x4 w; w.x = cvt_pk_bf16(r[0], r[1]); w.y = cvt_pk_bf16(r[2], r[3]); w.z = cvt_pk_bf16(r[4], r[5]); w.w = cvt_pk_bf16(r[6], r[7]);
                *(u32x4*)rowp = w; }
    }
};
struct EpiSwiGLU8 {
    unsigned char* H; int ldc; bool dry;
    __device__ __forceinline__ void operator()(const f32x4 (&acc)[2][2][4][2], const Unit& u, int wr, int wc, int fr, int fq) const {
        const int row0 = u.pm * BM + wr * 64 + fr, col0 = u.pn * HALF + wc * 32 + 8 * fq;
#pragma unroll
        for (int ai = 0; ai < 2; ++ai)
#pragma unroll
            for (int m = 0; m < 4; ++m) { unsigned char* rowp = H + (size_t)(row0 + ai * HALF + m * 16) * ldc + col0;
                float r[8];
#pragma unroll
                for (int n = 0; n < 2; ++n)
#pragma unroll
                    for (int j = 0; j < 4; ++j) { const float ga = acc[ai][0][m][n][j], ua = acc[ai][1][m][n][j];
                        const float e = __builtin_amdgcn_exp2f(-ga); const float q = __builtin_amdgcn_rcpf(__builtin_fmaf(e, LOG2E, LOG2E));
                        r[n * 4 + j] = __builtin_amdgcn_fmed3f((ga * ua) * q, -448.f, 448.f); }
                u32x2 w; w.x = pk4_fp8(r[0], r[1], r[2], r[3]); w.y = pk4_fp8(r[4], r[5], r[6], r[7]);
                if (!dry) *(u32x2*)rowp = w; }
    }
};
struct EpiQKV0 {
    bf16_t* O; const float* cosT; const float* sinT;
    const float* rs0;
    const float* g_aq; const float* g_ak; const float* g_bq; const float* g_bk;
    __device__ __forceinline__ void operator()(const f32x4 (&acc)[2][2][4][2], const Unit& u, int wr, int wc, int fr, int fq) const {
        const int hd = u.pn * 4 + wc;
        const float* g = hd < 8 ? g_aq : hd < 10 ? g_ak : hd < 12 ? nullptr : hd < 20 ? g_bq : hd < 28 ? g_bk : nullptr;
        const float qs = (hd < 8 || (hd >= 12 && hd < 20)) ? 0.125f * LOG2E : 1.0f;
        const int row0 = u.pm * BM + wr * 64 + fr;
        float r0v[8];
#pragma unroll
        for (int i = 0; i < 8; ++i) r0v[i] = rs0[row0 + (i >> 2) * HALF + (i & 3) * 16];
        if (g == nullptr) {
#pragma unroll
            for (int ai = 0; ai < 2; ++ai)
#pragma unroll
                for (int m = 0; m < 4; ++m) { const int row_ = row0 + ai * HALF + m * 16; bf16_t* rowp = O + (((size_t)(row_ >> 11) * 36 + hd) * SEQ + (row_ & (SEQ - 1))) * 64 + 8 * fq; const float r0 = r0v[ai * 4 + m];
#pragma unroll
                    for (int bj = 0; bj < 2; ++bj) { const f32x4 v0 = acc[ai][bj][m][0] * r0, v1 = acc[ai][bj][m][1] * r0;
                        u32x4 w; w.x = cvt_pk_bf16(v0[0], v0[1]); w.y = cvt_pk_bf16(v0[2], v0[3]); w.z = cvt_pk_bf16(v1[0], v1[1]); w.w = cvt_pk_bf16(v1[2], v1[3]);
                        *(u32x4*)(rowp + bj * 32) = w; } }
            return;
        }
        f32x4 gl[2], gh[2];
#pragma unroll
        for (int n = 0; n < 2; ++n) { gl[n] = *(const f32x4*)(g + 8 * fq + 4 * n); gh[n] = *(const f32x4*)(g + 32 + 8 * fq + 4 * n); }
        f32x4 ctb[2][2], stb[2][2];
#pragma unroll
        for (int n = 0; n < 2; ++n) { ctb[0][n] = *(const f32x4*)(cosT + (size_t)row0 * 32 + 8 * fq + 4 * n); stb[0][n] = *(const f32x4*)(sinT + (size_t)row0 * 32 + 8 * fq + 4 * n); }
#pragma unroll
        for (int ai = 0; ai < 2; ++ai)
#pragma unroll
            for (int m = 0; m < 4; ++m) {
                const int row = row0 + ai * HALF + m * 16, cb_ = (ai * 4 + m) & 1;
                if (ai * 4 + m < 7) { const int nr = row0 + ((ai * 4 + m + 1) >> 2) * HALF + ((ai * 4 + m + 1) & 3) * 16;
#pragma unroll
                    for (int n = 0; n < 2; ++n) { ctb[cb_ ^ 1][n] = *(const f32x4*)(cosT + (size_t)nr * 32 + 8 * fq + 4 * n); stb[cb_ ^ 1][n] = *(const f32x4*)(sinT + (size_t)nr * 32 + 8 * fq + 4 * n); } }
                __builtin_amdgcn_sched_barrier(0);
                float ss = 0.f;
#pragma unroll
                for (int bj = 0; bj < 2; ++bj)
#pragma unroll
                    for (int n = 0; n < 2; ++n) { const f32x4 x = acc[ai][bj][m][n]; ss += (x[0] * x[0] + x[1] * x[1]) + (x[2] * x[2] + x[3] * x[3]); }
                ss = fq_sum(ss);
                const float r0 = r0v[ai * 4 + m]; const float rstd = r0 * __builtin_amdgcn_rsqf(ss * (r0 * r0) * (1.0f / 64.0f) + EPS);
                float lo[8], hi[8];
#pragma unroll
                for (int n = 0; n < 2; ++n) { const f32x4 c = ctb[cb_][n], s = stb[cb_][n];
#pragma unroll
                    for (int j = 0; j < 4; ++j) { const float a = acc[ai][0][m][n][j] * rstd * gl[n][j], b = acc[ai][1][m][n][j] * rstd * gh[n][j];
                        lo[n * 4 + j] = (a * c[j] - b * s[j]) * qs; hi[n * 4 + j] = (b * c[j] + a * s[j]) * qs; } }
                bf16_t* rowp = O + (((size_t)(row >> 11) * 36 + hd) * SEQ + (row & (SEQ - 1))) * 64 + 8 * fq;
                u32x4 w; w.x = cvt_pk_bf16(lo[0], lo[1]); w.y = cvt_pk_bf16(lo[2], lo[3]); w.z = cvt_pk_bf16(lo[4], lo[5]); w.w = cvt_pk_bf16(lo[6], lo[7]);
                *(u32x4*)rowp = w;
                w.x = cvt_pk_bf16(hi[0], hi[1]); w.y = cvt_pk_bf16(hi[2], hi[3]); w.z = cvt_pk_bf16(hi[4], hi[5]); w.w = cvt_pk_bf16(hi[6], hi[7]);
                *(u32x4*)(rowp + 32) = w;
            }
    }
};
struct EpiKV1 {
    bf16_t* Ko; bf16_t* Vo; const float* rs; const bf16_t* P1; const float* cc; const float* sc; const float* gk;
    __device__ __forceinline__ void operator()(const f32x4 (&acc)[2][2][4][2], const Unit& u, int wr, int wc, int fr, int fq) const {
        const int hd = 2 * u.pn + (wc & 1);
        const int row0 = u.pm * BM + wr * 64 + fr;
        float sv[8];
#pragma unroll
        for (int i = 0; i < 8; ++i) { const f32x2 s2 = *(const f32x2*)(rs + (size_t)(row0 + (i >> 2) * HALF + (i & 3) * 16) * 8 + 4); sv[i] = __builtin_amdgcn_rsqf((s2[0] + s2[1]) * (1.f / CKV) + EPS); }
        if (wc >= 2) {
#pragma unroll
            for (int ai = 0; ai < 2; ++ai)
#pragma unroll
                for (int m = 0; m < 4; ++m) { const int row = row0 + ai * HALF + m * 16; const float s = sv[ai * 4 + m];
                    bf16_t* dst = Vo + (((size_t)(row >> 11) * 16 + hd) * SEQ + (row & (SEQ - 1))) * 64 + 8 * fq;
#pragma unroll
                    for (int bj = 0; bj < 2; ++bj) { const f32x4 v0 = acc[ai][bj][m][0] * s, v1 = acc[ai][bj][m][1] * s;
                        u32x4 w; w.x = cvt_pk_bf16(v0[0], v0[1]); w.y = cvt_pk_bf16(v0[2], v0[3]); w.z = cvt_pk_bf16(v1[0], v1[1]); w.w = cvt_pk_bf16(v1[2], v1[3]);
                        *(u32x4*)(dst + bj * 32) = w; } }
            return;
        }
        f32x4 gl[2], gh[2];
#pragma unroll
        for (int n = 0; n < 2; ++n) { gl[n] = *(const f32x4*)(gk + 8 * fq + 4 * n); gh[n] = *(const f32x4*)(gk + 32 + 8 * fq + 4 * n); }
        const f32x4 gr0 = *(const f32x4*)(gk + 64 + 4 * fq), gr1 = *(const f32x4*)(gk + 80 + 4 * fq);
#pragma unroll
        for (int ai2 = 0; ai2 < 4; ++ai2) { const int ai = ai2 >> 1, mh = ai2 & 1;
            u32x2 kr0v[2], kr1v[2]; f32x4 csv[2], snv[2];
#pragma unroll
            for (int m2 = 0; m2 < 2; ++m2) { const int row = row0 + ai * HALF + (2 * mh + m2) * 16; const bf16_t* kp = P1 + (size_t)row * L1_INP + CQ + CKV + 4 * fq;
                kr0v[m2] = *(const u32x2*)kp; kr1v[m2] = *(const u32x2*)(kp + 16); csv[m2] = *(const f32x4*)(cc + (size_t)row * 16 + 4 * fq); snv[m2] = *(const f32x4*)(sc + (size_t)row * 16 + 4 * fq); }
            __builtin_amdgcn_sched_barrier(0);
#pragma unroll
            for (int m2 = 0; m2 < 2; ++m2) { const int m = 2 * mh + m2;
                const int row = row0 + ai * HALF + m * 16; const float s = sv[ai * 4 + m];
                const u32x2 kr0 = kr0v[m2], kr1 = kr1v[m2];
                const f32x4 cs = csv[m2], sn = snv[m2];
                const f32x4 ra = (f32x4){bf_lo(kr0.x), bf_hi(kr0.x), bf_lo(kr0.y), bf_hi(kr0.y)}, rb = (f32x4){bf_lo(kr1.x), bf_hi(kr1.x), bf_lo(kr1.y), bf_hi(kr1.y)};
                float ss = (ra[0] * ra[0] + ra[1] * ra[1]) + (ra[2] * ra[2] + ra[3] * ra[3]) + (rb[0] * rb[0] + rb[1] * rb[1]) + (rb[2] * rb[2] + rb[3] * rb[3]);
#pragma unroll
                for (int bj = 0; bj < 2; ++bj)
#pragma unroll
                    for (int n = 0; n < 2; ++n) { const f32x4 x = acc[ai][bj][m][n] * s; ss += (x[0] * x[0] + x[1] * x[1]) + (x[2] * x[2] + x[3] * x[3]); }
                ss = fq_sum(ss);
                const float rstd = __builtin_amdgcn_rsqf(ss * (1.0f / 96.0f) + EPS), rl = rstd * s;
                bf16_t* dst = Ko + (((size_t)(row >> 11) * 16 + hd) * SEQ + (row & (SEQ - 1))) * 96;
                { const f32x4 a0 = acc[ai][0][m][0] * rl * gl[0], a1 = acc[ai][0][m][1] * rl * gl[1], b0 = acc[ai][1][m][0] * rl * gh[0], b1 = acc[ai][1][m][1] * rl * gh[1];
                  u32x4 w; w.x = cvt_pk_bf16(a0[0], a0[1]); w.y = cvt_pk_bf16(a0[2], a0[3]); w.z = cvt_pk_bf16(a1[0], a1[1]); w.w = cvt_pk_bf16(a1[2], a1[3]);
                  *(u32x4*)(dst + 8 * fq) = w;
                  w.x = cvt_pk_bf16(b0[0], b0[1]); w.y = cvt_pk_bf16(b0[2], b0[3]); w.z = cvt_pk_bf16(b1[0], b1[1]); w.w = cvt_pk_bf16(b1[2], b1[3]);
                  *(u32x4*)(dst + 32 + 8 * fq) = w; }
                { const f32x4 a = ra * rstd * gr0, b = rb * rstd * gr1; const f32x4 oa = a * cs - b * sn, ob = b * cs + a * sn;
                  u32x2 p; p.x = cvt_pk_bf16(oa[0], oa[1]); p.y = cvt_pk_bf16(oa[2], oa[3]); *(u32x2*)(dst + 64 + 4 * fq) = p;
                  p.x = cvt_pk_bf16(ob[0], ob[1]); p.y = cvt_pk_bf16(ob[2], ob[3]); *(u32x2*)(dst + 80 + 4 * fq) = p; }
            }
        }
    }
};
}

__device__ __forceinline__ void dma_piece(__amdgpu_buffer_rsrc_t rs, unsigned lds_dst, unsigned voff, unsigned soff) {
    asm volatile("s_mov_b32 m0, %0\n\ts_nop 0\n\tbuffer_load_dwordx4 %1, %2, %3 offen lds" :: "s"(lds_dst), "v"(voff), "s"(rs), "s"(soff) : "m0", "memory");
}
__device__ __forceinline__ int crow(int r, int hi) { return (r & 3) + 8 * (r >> 2) + 4 * hi; }
typedef short v4i16_t __attribute__((ext_vector_type(4)));
__device__ __forceinline__ s16x4 vtr(LAS unsigned char* p) { return __builtin_bit_cast(s16x4, __builtin_amdgcn_ds_read_tr16_b64_v4i16((LAS v4i16_t*)p)); }
constexpr float ATT_THR = 8.0f, ATT_FIX_BOUND = 60.0f;
template <int DQK, bool TWO, bool FIXREF>
__device__ __forceinline__ void attn_step(LAS unsigned char* kp0, LAS unsigned char* kp1, int ke0, int ke1, LAS unsigned char* vp0, LAS unsigned char* vp1, int vd0,
                                          const bf16x8 (&qf)[DQK / 16], f32x16& negm, float& mref, float& l, f32x16& o0, f32x16& o1,
                                          bool mask0, bool mask1, int qidx, int kidx0, int maxd, int hi) {
    f32x16 s0, s1;
    const f32x16 zf = (f32x16){0.f, 0.f, 0.f, 0.f, 0.f, 0.f, 0.f, 0.f, 0.f, 0.f, 0.f, 0.f, 0.f, 0.f, 0.f, 0.f};
    if constexpr (FIXREF) { s1 = zf; } else { s0 = negm; s1 = negm; }
    bf16x8 kfa[DQK / 16];
#pragma unroll
    for (int kk = 0; kk < DQK / 16; ++kk) kfa[kk] = *(const LAS bf16x8*)(kp0 + (kk >> 1) * 1024 + ((kk & 1) ? ke1 : ke0));
#pragma unroll
    for (int kk = 0; kk < DQK / 16; ++kk) s0 = __builtin_amdgcn_mfma_f32_32x32x16_bf16(kfa[kk], qf[kk], (FIXREF && kk == 0) ? zf : s0, 0, 0, 0);
    if constexpr (TWO) {
#pragma unroll
        for (int kk = 0; kk < DQK / 16; ++kk) kfa[kk] = *(const LAS bf16x8*)(kp1 + (kk >> 1) * 1024 + ((kk & 1) ? ke1 : ke0));
#pragma unroll
        for (int kk = 0; kk < DQK / 16; ++kk) s1 = __builtin_amdgcn_mfma_f32_32x32x16_bf16(kfa[kk], qf[kk], (FIXREF && kk == 0) ? zf : s1, 0, 0, 0);
    }
    if (mask0) {
#pragma unroll
        for (int r = 0; r < 16; ++r) { const int d = qidx - (kidx0 + crow(r, hi)); if (d < 0 || d > maxd) s0[r] = -INFINITY; }
    }
    if constexpr (TWO) { if (mask1) {
#pragma unroll
        for (int r = 0; r < 16; ++r) { const int d = qidx - (kidx0 + 32 + crow(r, hi)); if (d < 0 || d > maxd) s1[r] = -INFINITY; }
    } }
    if constexpr (!FIXREF) {
    float rm = fmaxf(fmaxf(s0[0], s0[1]), fmaxf(s0[2], s0[3]));
#pragma unroll
    for (int r = 4; r < 16; r += 4) rm = fmaxf(rm, fmaxf(fmaxf(s0[r], s0[r + 1]), fmaxf(s0[r + 2], s0[r + 3])));
    if constexpr (TWO) {
#pragma unroll
        for (int r = 0; r < 16; r += 4) rm = fmaxf(rm, fmaxf(fmaxf(s1[r], s1[r + 1]), fmaxf(s1[r + 2], s1[r + 3])));
    }
    rm = swap32_max(rm);
    if (__builtin_expect(__any(rm > ATT_THR), 0)) {
        const float dl = fmaxf(rm, 0.f); mref += dl;
#pragma unroll
        for (int r = 0; r < 16; ++r) { s0[r] -= dl; negm[r] -= dl; if constexpr (TWO) s1[r] -= dl; }
        const float f = __builtin_amdgcn_exp2f(-dl); l *= f;
#pragma unroll
        for (int r = 0; r < 16; ++r) { o0[r] *= f; o1[r] *= f; }
    }
    }
    float ps = 0.f;
#pragma unroll
    for (int r = 0; r < 16; ++r) { s0[r] = __builtin_amdgcn_exp2f(s0[r]); ps += s0[r]; }
    if constexpr (TWO) {
#pragma unroll
        for (int r = 0; r < 16; ++r) { s1[r] = __builtin_amdgcn_exp2f(s1[r]); ps += s1[r]; }
    }
    l += ps;
    {
        u32x4 pw0, pw1;
        pw0.x = cvt_pk_bf16(s0[0], s0[1]); pw0.y = cvt_pk_bf16(s0[2], s0[3]); pw0.z = cvt_pk_bf16(s0[4], s0[5]); pw0.w = cvt_pk_bf16(s0[6], s0[7]);
        pw1.x = cvt_pk_bf16(s0[8], s0[9]); pw1.y = cvt_pk_bf16(s0[10], s0[11]); pw1.z = cvt_pk_bf16(s0[12], s0[13]); pw1.w = cvt_pk_bf16(s0[14], s0[15]);
        const bf16x8 pf0 = __builtin_bit_cast(bf16x8, pw0), pf1 = __builtin_bit_cast(bf16x8, pw1);
#pragma unroll
        for (int ks = 0; ks < 2; ++ks) {
            const s16x4 a0 = vtr(vp0 + ks * 1024), a1 = vtr(vp0 + ks * 1024 + 512);
            const s16x4 b0 = vtr(vp0 + vd0 + ks * 1024), b1 = vtr(vp0 + vd0 + ks * 1024 + 512);
            const bf16x8 va = (bf16x8){a0[0], a0[1], a0[2], a0[3], a1[0], a1[1], a1[2], a1[3]};
            const bf16x8 vb = (bf16x8){b0[0], b0[1], b0[2], b0[3], b1[0], b1[1], b1[2], b1[3]};
            o0 = __builtin_amdgcn_mfma_f32_32x32x16_bf16(va, ks ? pf1 : pf0, o0, 0, 0, 0);
            o1 = __builtin_amdgcn_mfma_f32_32x32x16_bf16(vb, ks ? pf1 : pf0, o1, 0, 0, 0);
        }
    }
    if constexpr (TWO) {
        u32x4 pw0, pw1;
        pw0.x = cvt_pk_bf16(s1[0], s1[1]); pw0.y = cvt_pk_bf16(s1[2], s1[3]); pw0.z = cvt_pk_bf16(s1[4], s1[5]); pw0.w = cvt_pk_bf16(s1[6], s1[7]);
        pw1.x = cvt_pk_bf16(s1[8], s1[9]); pw1.y = cvt_pk_bf16(s1[10], s1[11]); pw1.z = cvt_pk_bf16(s1[12], s1[13]); pw1.w = cvt_pk_bf16(s1[14], s1[15]);
        const bf16x8 pf0 = __builtin_bit_cast(bf16x8, pw0), pf1 = __builtin_bit_cast(bf16x8, pw1);
#pragma unroll
        for (int ks = 0; ks < 2; ++ks) {
            const s16x4 a0 = vtr(vp1 + ks * 1024), a1 = vtr(vp1 + ks * 1024 + 512);
            const s16x4 b0 = vtr(vp1 + vd0 + ks * 1024), b1 = vtr(vp1 + vd0 + ks * 1024 + 512);
            const bf16x8 va = (bf16x8){a0[0], a0[1], a0[2], a0[3], a1[0], a1[1], a1[2], a1[3]};
            const bf16x8 vb = (bf16x8){b0[0], b0[1], b0[2], b0[3], b1[0], b1[1], b1[2], b1[3]};
            o0 = __builtin_amdgcn_mfma_f32_32x32x16_bf16(va, ks ? pf1 : pf0, o0, 0, 0, 0);
            o1 = __builtin_amdgcn_mfma_f32_32x32x16_bf16(vb, ks ? pf1 : pf0, o1, 0, 0, 0);
        }
    }
}

template <int DQK>
__device__ __forceinline__ void attn_step2(LAS unsigned char* kp, int ke0, int ke1, LAS unsigned char* vp, int vd0, const bf16x8 (&qa)[DQK / 16], const bf16x8 (&qb)[DQK / 16],
                                           float& la, float& lb, f32x16& oa0, f32x16& oa1, f32x16& ob0, f32x16& ob1, bool maska, bool maskb, int qidx, int kidx0, int hi) {
    f32x16 sa, sb;
    const f32x16 zf = (f32x16){0.f, 0.f, 0.f, 0.f, 0.f, 0.f, 0.f, 0.f, 0.f, 0.f, 0.f, 0.f, 0.f, 0.f, 0.f, 0.f};
    bf16x8 kf[DQK / 16];
#pragma unroll
    for (int kk = 0; kk < DQK / 16; ++kk) kf[kk] = *(const LAS bf16x8*)(kp + (kk >> 1) * 1024 + ((kk & 1) ? ke1 : ke0));
    sa = __builtin_amdgcn_mfma_f32_32x32x16_bf16(kf[0], qa[0], zf, 0, 0, 0); sb = __builtin_amdgcn_mfma_f32_32x32x16_bf16(kf[0], qb[0], zf, 0, 0, 0);
#pragma unroll
    for (int kk = 1; kk < DQK / 16; ++kk) { sa = __builtin_amdgcn_mfma_f32_32x32x16_bf16(kf[kk], qa[kk], sa, 0, 0, 0); sb = __builtin_amdgcn_mfma_f32_32x32x16_bf16(kf[kk], qb[kk], sb, 0, 0, 0); }
    if (maska) {
#pragma unroll
        for (int r = 0; r < 16; ++r) { if (qidx - (kidx0 + crow(r, hi)) < 0) sa[r] = -INFINITY; }
    }
    if (maskb) {
#pragma unroll
        for (int r = 0; r < 16; ++r) { if (qidx + 32 - (kidx0 + crow(r, hi)) < 0) sb[r] = -INFINITY; }
    }
    s16x4 vfr[2][4];
#pragma unroll
    for (int ks = 0; ks < 2; ++ks) { vfr[ks][0] = vtr(vp + ks * 1024); vfr[ks][1] = vtr(vp + ks * 1024 + 512); vfr[ks][2] = vtr(vp + vd0 + ks * 1024); vfr[ks][3] = vtr(vp + vd0 + ks * 1024 + 512); }
    __builtin_amdgcn_sched_barrier(0);
    float pa = 0.f, pb = 0.f;
#pragma unroll
    for (int r = 0; r < 16; ++r) { sa[r] = __builtin_amdgcn_exp2f(sa[r]); pa += sa[r]; sb[r] = __builtin_amdgcn_exp2f(sb[r]); pb += sb[r]; }
    la += pa; lb += pb;
    u32x4 wa0, wa1, wb0, wb1;
    wa0.x = cvt_pk_bf16(sa[0], sa[1]); wa0.y = cvt_pk_bf16(sa[2], sa[3]); wa0.z = cvt_pk_bf16(sa[4], sa[5]); wa0.w = cvt_pk_bf16(sa[6], sa[7]);
    wa1.x = cvt_pk_bf16(sa[8], sa[9]); wa1.y = cvt_pk_bf16(sa[10], sa[11]); wa1.z = cvt_pk_bf16(sa[12], sa[13]); wa1.w = cvt_pk_bf16(sa[14], sa[15]);
    wb0.x = cvt_pk_bf16(sb[0], sb[1]); wb0.y = cvt_pk_bf16(sb[2], sb[3]); wb0.z = cvt_pk_bf16(sb[4], sb[5]); wb0.w = cvt_pk_bf16(sb[6], sb[7]);
    wb1.x = cvt_pk_bf16(sb[8], sb[9]); wb1.y = cvt_pk_bf16(sb[10], sb[11]); wb1.z = cvt_pk_bf16(sb[12], sb[13]); wb1.w = cvt_pk_bf16(sb[14], sb[15]);
#pragma unroll
    for (int ks = 0; ks < 2; ++ks) {
        const s16x4 a0 = vfr[ks][0], a1 = vfr[ks][1], b0 = vfr[ks][2], b1 = vfr[ks][3];
        const bf16x8 va = (bf16x8){a0[0], a0[1], a0[2], a0[3], a1[0], a1[1], a1[2], a1[3]};
        const bf16x8 vb = (bf16x8){b0[0], b0[1], b0[2], b0[3], b1[0], b1[1], b1[2], b1[3]};
        const bf16x8 pfa = __builtin_bit_cast(bf16x8, ks ? wa1 : wa0), pfb = __builtin_bit_cast(bf16x8, ks ? wb1 : wb0);
        oa0 = __builtin_amdgcn_mfma_f32_32x32x16_bf16(va, pfa, oa0, 0, 0, 0);
        ob0 = __builtin_amdgcn_mfma_f32_32x32x16_bf16(va, pfb, ob0, 0, 0, 0);
        oa1 = __builtin_amdgcn_mfma_f32_32x32x16_bf16(vb, pfa, oa1, 0, 0, 0);
        ob1 = __builtin_amdgcn_mfma_f32_32x32x16_bf16(vb, pfb, ob1, 0, 0, 0);
    }
}

constexpr int OST_ROW = 144, OST_WAVE = 32 * OST_ROW;
__device__ __forceinline__ void ostage_write(LAS unsigned char* st, const f32x16& o0, const f32x16& o1, float sc, int r32, int hi) {
#pragma unroll
    for (int g4 = 0; g4 < 4; ++g4) { u32x2 a, b2; a.x = cvt_pk_bf16(o0[4 * g4] * sc, o0[4 * g4 + 1] * sc); a.y = cvt_pk_bf16(o0[4 * g4 + 2] * sc, o0[4 * g4 + 3] * sc);
        b2.x = cvt_pk_bf16(o1[4 * g4] * sc, o1[4 * g4 + 1] * sc); b2.y = cvt_pk_bf16(o1[4 * g4 + 2] * sc, o1[4 * g4 + 3] * sc);
        *(LAS u32x2*)(st + r32 * OST_ROW + (8 * g4 + 4 * hi) * 2) = a; *(LAS u32x2*)(st + r32 * OST_ROW + (32 + 8 * g4 + 4 * hi) * 2) = b2; }
}
struct Args {
    const float* in[28]; float* out; unsigned char* ws; int ph_lo, ph_hi; unsigned probe; int pad;
};
struct Frame {
    LAS unsigned char* lds; int wave, G, bid;
    unsigned char* ws; float* out; const float* const* in;
};
enum { I_X = 0, I_POS, I_L0_ATTN_NORM, I_L0_W_IN, I_L0_A_QN, I_L0_A_KN, I_L0_A_SINKS, I_L0_B_QN, I_L0_B_KN, I_L0_W_OUT, I_L0_FFN_NORM, I_L0_W_GATE, I_L0_W_UP, I_L0_W_DOWN,
       I_L1_ATTN_NORM, I_L1_W_IN, I_L1_QA_NORM, I_L1_W_UQ, I_L1_KVA_NORM, I_L1_W_UKV, I_L1_C_QN, I_L1_C_KN, I_L1_W_OUT, I_L1_FFN_NORM, I_L1_ROUTER, I_L1_WE_GATE, I_L1_WE_UP, I_L1_WE_DOWN };

__device__ __forceinline__ void cvt_item(const float* W, int ldw, int srccol0  , const float* kgain, bf16_t* Bt, int K, int dstrow0, bool perm, int k0, LAS float* scr, int lane) {
#pragma unroll
    for (int i = 0; i < 8; ++i) { const int kk = 8 * i + (lane >> 3), c4 = (lane & 7) * 4; f32x4 v = (f32x4){0.f, 0.f, 0.f, 0.f};
        if (srccol0 >= 0) { v = *(const f32x4*)(W + (size_t)(k0 + kk) * ldw + srccol0 + c4); if (kgain) v = v * kgain[k0 + kk]; }
        scr[kk * 33 + c4] = v[0]; scr[kk * 33 + c4 + 1] = v[1]; scr[kk * 33 + c4 + 2] = v[2]; scr[kk * 33 + c4 + 3] = v[3]; }
    LDS_WAIT(); asm volatile("" ::: "memory");
    const int c = lane & 7;
#pragma unroll
    for (int j = 0; j < 4; ++j) { const int rho = (lane >> 3) + 8 * j; const int sc = perm ? pg8::perm32(rho) : rho; const LAS float* s = scr + (8 * c) * 33 + sc;
        u32x4 o; o.x = cvt_pk_bf16(s[0 * 33], s[1 * 33]); o.y = cvt_pk_bf16(s[2 * 33], s[3 * 33]); o.z = cvt_pk_bf16(s[4 * 33], s[5 * 33]); o.w = cvt_pk_bf16(s[6 * 33], s[7 * 33]);
        *(u32x4*)(Bt + (size_t)(dstrow0 + rho) * K + k0 + 8 * c) = o; }
    LDS_WAIT(); asm volatile("" ::: "memory");
}
__device__ __forceinline__ void cvt_item8(const float* W, int ldw, int srccol0, unsigned char* Bt, int K, int dstrow0, bool perm, int k0, float scale, LAS float* scr, int lane) {
#pragma unroll
    for (int i = 0; i < 8; ++i) { const int kk = 8 * i + (lane >> 3), c4 = (lane & 7) * 4; const f32x4 v = *(const f32x4*)(W + (size_t)(k0 + kk) * ldw + srccol0 + c4) * scale;
        scr[kk * 33 + c4] = v[0]; scr[kk * 33 + c4 + 1] = v[1]; scr[kk * 33 + c4 + 2] = v[2]; scr[kk * 33 + c4 + 3] = v[3]; }
    LDS_WAIT(); asm volatile("" ::: "memory");
    const int rho = lane >> 1, kh = (lane & 1) * 32; const int sc = perm ? pg8::perm32(rho) : rho; const LAS float* s = scr + kh * 33 + sc;
    u32x4 o0, o1;
    o0.x = pk4_fp8(s[0 * 33], s[1 * 33], s[2 * 33], s[3 * 33]); o0.y = pk4_fp8(s[4 * 33], s[5 * 33], s[6 * 33], s[7 * 33]); o0.z = pk4_fp8(s[8 * 33], s[9 * 33], s[10 * 33], s[11 * 33]); o0.w = pk4_fp8(s[12 * 33], s[13 * 33], s[14 * 33], s[15 * 33]);
    o1.x = pk4_fp8(s[16 * 33], s[17 * 33], s[18 * 33], s[19 * 33]); o1.y = pk4_fp8(s[20 * 33], s[21 * 33], s[22 * 33], s[23 * 33]); o1.z = pk4_fp8(s[24 * 33], s[25 * 33], s[26 * 33], s[27 * 33]); o1.w = pk4_fp8(s[28 * 33], s[29 * 33], s[30 * 33], s[31 * 33]);
    unsigned char* dp = Bt + (size_t)(dstrow0 + rho) * K + k0 + kh;
    *(u32x4*)dp = o0; *(u32x4*)(dp + 16) = o1;
    LDS_WAIT(); asm volatile("" ::: "memory");
}
__device__ __forceinline__ void p0_weights(const Frame& F) {
    const int lane_ = lane_id_v(), tid_ = F.wave * 64 + lane_; (void)tid_;
    LAS float* scr = (LAS float*)(F.lds + F.wave * 16384);
    const int gw = F.bid * 8 + F.wave, NGW = F.G * 8;
    constexpr int N0 = (L0_IN / 32) * (DM / 64);
    constexpr int N1 = (DM / 32) * (DM / 64);
    constexpr int N2 = (2 * DFF / 32) * (DM / 64);
    constexpr int N3 = (DM / 32) * (DFF / 64);
    constexpr int N4 = (L1_INP / 32) * (DM / 64);
    constexpr int N5 = (NUQ / 32) * (CQ / 64);
    constexpr int N6 = (NUKV / 32) * (CKV / 64);
    constexpr int N7 = N1;
    constexpr int N8 = NEXP * (2 * DFE / 32) * (DM / 64);
    constexpr int N9 = NEXP * (DM / 32) * (DFE / 64);
    constexpr int NT = N0 + N1 + N2 + N3 + N4 + N5 + N6 + N7 + N8 + N9;
    unsigned char* ws = F.ws;
    for (int it = gw; it < NT; it += NGW) {
        int r = it;
        if (r < N0) { const int g = r % (L0_IN / 32), kb = r / (L0_IN / 32); const int pn = g >> 3, bj = (g >> 2) & 1, wc = g & 3;
            cvt_item(F.in[I_L0_W_IN], L0_IN, pn * 256 + wc * 64 + bj * 32, F.in[I_L0_ATTN_NORM], (bf16_t*)(ws + W0_IN), DM, g * 32, true, kb * 64, scr, lane_); continue; } r -= N0;
        if (r < N1) { const int g = r % (DM / 32), kb = r / (DM / 32);
            cvt_item(F.in[I_L0_W_OUT], DM, g * 32, nullptr, (bf16_t*)(ws + W0_OUT), DM, g * 32, true, kb * 64, scr, lane_); continue; } r -= N1;
        if (r < N2) { const int g = r % (2 * DFF / 32), kb = r / (2 * DFF / 32); const int pn = g >> 3, bj = (g >> 2) & 1, wc = g & 3;
            cvt_item(bj ? F.in[I_L0_W_UP] : F.in[I_L0_W_GATE], DFF, pn * 128 + wc * 32, F.in[I_L0_FFN_NORM], (bf16_t*)(ws + W0_GU), DM, g * 32, true, kb * 64, scr, lane_); continue; } r -= N2;
        if (r < N3) { const int g = r % (DM / 32), kb = r / (DM / 32);
            cvt_item(F.in[I_L0_W_DOWN], DM, g * 32, nullptr, (bf16_t*)(ws + W0_DN), DFF, g * 32, true, kb * 64, scr, lane_); continue; } r -= N3;
        if (r < N4) { const int g = r % (L1_INP / 32), kb = r / (L1_INP / 32);
            cvt_item(F.in[I_L1_W_IN], 672, g < 21 ? g * 32 : -1, F.in[I_L1_ATTN_NORM], (bf16_t*)(ws + W1_IN), DM, g * 32, true, kb * 64, scr, lane_); continue; } r -= N4;
        if (r < N5) { const int g = r % (NUQ / 32), kb = r / (NUQ / 32);
            cvt_item(F.in[I_L1_W_UQ], NUQ, g * 32, F.in[I_L1_QA_NORM], (bf16_t*)(ws + W1_UQ), CQ, g * 32, true, kb * 64, scr, lane_); continue; } r -= N5;
        if (r < N6) { const int g = r % (NUKV / 32), kb = r / (NUKV / 32); const int pn = g >> 3, bj = (g >> 2) & 1, wc = g & 3;
            cvt_item(F.in[I_L1_W_UKV], NUKV, (2 * pn + (wc & 1)) * 128 + (wc >> 1) * 64 + bj * 32, F.in[I_L1_KVA_NORM], (bf16_t*)(ws + W1_UKV), CKV, g * 32, true, kb * 64, scr, lane_); continue; } r -= N6;
        if (r < N7) { const int g = r % (DM / 32), kb = r / (DM / 32);
            cvt_item(F.in[I_L1_W_OUT], DM, g * 32, nullptr, (bf16_t*)(ws + W1_OUT), DM, g * 32, true, kb * 64, scr, lane_); continue; } r -= N7;
        if (r < N8) { constexpr int PE = (2 * DFE / 32) * (DM / 64); const int e = r / PE, q = r % PE; const int g = q % (2 * DFE / 32), kb = q / (2 * DFE / 32); const int pn = g >> 3, bj = (g >> 2) & 1, wc = g & 3;
            cvt_item8((bj ? F.in[I_L1_WE_UP] : F.in[I_L1_WE_GATE]) + (size_t)e * DM * DFE, DFE, pn * 128 + wc * 32, (unsigned char*)(ws + WE_GU) + (size_t)e * 2 * DFE * DM, DM, g * 32, true, kb * 64, bj ? WGU_SCALE : WGU_SCALE * LOG2E, scr, lane_); continue; } r -= N8;
        { constexpr int PE = (DM / 32) * (DFE / 64); const int e = r / PE, q = r % PE; const int g = q % (DM / 32), kb = q / (DM / 32);
            cvt_item8(F.in[I_L1_WE_DOWN] + (size_t)e * DFE * DM, DM, g * 32, (unsigned char*)(ws + WE_DN) + (size_t)e * DM * DFE, DFE, g * 32, true, kb * 64, WDN_SCALE, scr, lane_); }
    }
}
__device__ __forceinline__ void p0_rope(const Frame& F) {
    const int lane_ = lane_id_v(), tid_ = F.wave * 64 + lane_; (void)tid_;
    const int* pos = (const int*)F.in[I_POS];
    float* ch = (float*)(F.ws + WS_ROPEH); float* sh = ch + (size_t)NTOK * 32;
    float* cc = (float*)(F.ws + WS_ROPEC); float* sc = cc + (size_t)NTOK * 16;
    const size_t stride = (size_t)F.G * 512;
    const int f = tid_ & 31;
    const float inv = powf(10000.0f, -(float)(2 * f) / 64.0f), inv2 = powf(10000.0f, -(float)(2 * (f & 15)) / 32.0f);
    for (size_t i = (size_t)F.bid * 512 + tid_; i < (size_t)NTOK * 32; i += stride) {
        const int t = (int)(i >> 5); const float p = (float)pos[t];
        float s, c; sincosf(p * inv, &s, &c); ch[i] = c; sh[i] = s;
        if (f < 16) { sincosf(p * inv2, &s, &c); cc[(size_t)t * 16 + f] = c; sc[(size_t)t * 16 + f] = s; }
    }
}
__device__ __forceinline__ void x_rows(const Frame& F, const float* src, bf16_t* dst, float* rs0) {
    const int lane_ = lane_id_v();
    const int gw = F.bid * 8 + F.wave, NGW = F.G * 8;
    for (int m = gw * 4; m < NTOK; m += NGW * 4) {
        f32x4 v[4][4]; float s[4];
#pragma unroll
        for (int r = 0; r < 4; ++r) { const f32x4* xr = (const f32x4*)(src + (size_t)(m + r) * DM) + lane_;
#pragma unroll
            for (int j = 0; j < 4; ++j) v[r][j] = xr[64 * j]; }
#pragma unroll
        for (int r = 0; r < 4; ++r) { s[r] = 0.f;
#pragma unroll
            for (int j = 0; j < 4; ++j) s[r] += (v[r][j].x * v[r][j].x + v[r][j].y * v[r][j].y) + (v[r][j].z * v[r][j].z + v[r][j].w * v[r][j].w); }
#pragma unroll
        for (int r = 0; r < 4; ++r) {
            const float rstd = __builtin_amdgcn_rsqf(wave_sum(s[r]) * (1.f / DM) + EPS);
            if (lane_ == 0) rs0[m + r] = rstd;
            u32x2* o8 = (u32x2*)(dst + (size_t)(m + r) * DM) + lane_;
#pragma unroll
            for (int j = 0; j < 4; ++j) { u32x2 w; w.x = cvt_pk_bf16(v[r][j].x, v[r][j].y); w.y = cvt_pk_bf16(v[r][j].z, v[r][j].w); o8[64 * j] = w; }
        }
    }
}

constexpr int BK_ROWS = 384, BK_VOFF = BK_ROWS * 128, BK_VD0 = BK_ROWS * 64;
struct BandItem { int b, qcol, kcol, vcol, dil, cls0, cls1, tq0, tq1, maxd, mode  , outcol, pidx, head; float sink; bool has_sink, split_rows; };
template <bool FIXREF>
__device__ __forceinline__ void band_item(const Frame& F, const BandItem it) {
    const int lane_ = lane_id_v();
    const bf16_t* P = (const bf16_t*)(F.ws + WS_PROJ0);
    LAS unsigned char* lds = F.lds;
    const int lane = lane_, w = F.wave, hq = w >> 2, wq = w & 3, hi = lane >> 5, r32 = lane & 31;
    const size_t tokbase = (size_t)it.b * SEQ;
    {
        const __amdgpu_buffer_rsrc_t rsP = __builtin_amdgcn_make_buffer_rsrc((void*)(P + tokbase * L0_IN), (short)0, SEQ * L0_IN * 2, 0x00020000);
        const int k16 = lane >> 2, pc = lane & 3;
        const unsigned vok = (unsigned)(k16 * it.dil * 128 + (pc ^ ((k16 >> 2) & 3)) * 16), vov = (unsigned)(k16 * it.dil * 128 + pc * 16);
#pragma unroll 1
        for (int i = 0; i < 12; ++i) {
            const int p = w + 8 * i; const bool isv = p >= 48; const int j = isv ? p - 48 : p;
            const int kg = isv ? j % 24 : j >> 1, sub = isv ? j / 24 : j & 1;
            const int R0 = kg * 16; const bool second = it.split_rows && R0 >= 256;
            const int kidx = second ? R0 - 256 : it.tq0 - 128 + R0; const int cls = second ? it.cls1 : it.cls0;
            if (kidx >= 0 && kidx < SEQ / it.dil) {
                const unsigned so = (unsigned)((((isv ? it.vcol : it.kcol) >> 6) * SEQ + cls + it.dil * kidx) * 128 + sub * 64);
                dma_piece(rsP, (unsigned)(uintptr_t)lds + (unsigned)(isv ? BK_VOFF + j * 1024 : p * 1024), isv ? vov : vok, so);
            }
        }
    }
    const int tq = hq ? it.tq1 : it.tq0, cls = hq ? it.cls1 : it.cls0;
    const int qidx0 = tq + 32 * wq, qidx = qidx0 + r32;
    const size_t qtok = tokbase + cls + (size_t)it.dil * qidx;
    bf16x8 qf[4];
#pragma unroll
    for (int kk = 0; kk < 4; ++kk) qf[kk] = *(const bf16x8*)(P + (((size_t)it.b * 36 + (it.qcol >> 6)) * SEQ + cls + (size_t)it.dil * qidx) * 64 + 16 * kk + 8 * hi);
    float m = it.has_sink ? it.sink : 0.f, l = (it.has_sink && hi == 0) ? 1.f : 0.f;
    f32x16 o0, o1, negm;
#pragma unroll
    for (int r = 0; r < 16; ++r) { o0[r] = 0.f; o1[r] = 0.f; negm[r] = -m; }
    asm volatile("s_waitcnt vmcnt(0) lgkmcnt(0)\n\ts_barrier" ::: "memory");
    {
        const int vlane = (4 * hi + ((lane & 15) >> 2)) * 64 + ((lane >> 4) & 1) * 32 + (lane & 3) * 8;
        const int ksw = (r32 >> 2) & 3, ke0 = ((hi) ^ ksw) * 16, ke1 = ((2 + hi) ^ ksw) * 16;
#define BK_KP(kb) (lds + (8 * hq + 2 * (kb) + (r32 >> 4)) * 2048 + (r32 & 15) * 64)
#define BK_VP(kb) (lds + BK_VOFF + (128 * hq + 32 * (kb)) * 64 + vlane)
        const int kx0 = tq - 128 + 32 * wq;
        if (kx0 >= 0) {
            attn_step<64, true, FIXREF>(BK_KP(wq), BK_KP(wq + 1), ke0, ke1, BK_VP(wq), BK_VP(wq + 1), BK_VD0, qf, negm, m, l, o0, o1, true, false, qidx, kx0, it.maxd, hi);
            attn_step<64, true, FIXREF>(BK_KP(wq + 2), BK_KP(wq + 3), ke0, ke1, BK_VP(wq + 2), BK_VP(wq + 3), BK_VD0, qf, negm, m, l, o0, o1, false, false, qidx, kx0 + 64, it.maxd, hi);
            attn_step<64, false, FIXREF>(BK_KP(wq + 4), BK_KP(wq + 4), ke0, ke1, BK_VP(wq + 4), BK_VP(wq + 4), BK_VD0, qf, negm, m, l, o0, o1, true, false, qidx, kx0 + 128, it.maxd, hi);
        } else {
#pragma unroll 1
            for (int kb = 4; kb < wq + 4; ++kb) attn_step<64, false, FIXREF>(BK_KP(kb), BK_KP(kb), ke0, ke1, BK_VP(kb), BK_VP(kb), BK_VD0, qf, negm, m, l, o0, o1, false, false, qidx, tq - 128 + 32 * kb, it.maxd, hi);
            attn_step<64, false, FIXREF>(BK_KP(wq + 4), BK_KP(wq + 4), ke0, ke1, BK_VP(wq + 4), BK_VP(wq + 4), BK_VD0, qf, negm, m, l, o0, o1, true, false, qidx, kx0 + 128, it.maxd, hi);
        }
#undef BK_KP
#undef BK_VP
    }
    l = swap32_sum(l);
    const float inv = 1.0f / l;
    const float lse = m + __builtin_amdgcn_logf(l);
    LAS unsigned char* st = lds + 98304 + w * OST_WAVE;
    LAS float* wst = (LAS float*)(lds + 98304 + 8 * OST_WAVE) + w * 128;
    const int srow = lane >> 3, sch = lane & 7;
    if (it.mode != 2) {
        ostage_write(st, o0, o1, inv, r32, hi);
        asm volatile("s_waitcnt lgkmcnt(0)" ::: "memory");
        bf16_t* obase = it.mode == 0 ? (bf16_t*)(F.ws + WS_MIX) + it.outcol : (bf16_t*)(F.ws + WS_PART) + (size_t)it.pidx * NTOK * 512 + it.head * 64;
        const int opitch = it.mode == 0 ? DM : 512;
#pragma unroll
        for (int i = 0; i < 4; ++i) { const int row = 8 * i + srow; const u32x4 v = *(const LAS u32x4*)(st + row * OST_ROW + sch * 16);
            *(u32x4*)(obase + (tokbase + cls + (size_t)it.dil * (qidx0 + row)) * opitch + sch * 8) = v; }
        if (it.mode == 1 && hi == 0) ((float*)(F.ws + WS_LSE))[(size_t)it.pidx * NTOK * 8 + qtok * 8 + it.head] = lse;
    } else {
        const float* lsep = (const float*)(F.ws + WS_LSE);
        const float l1 = lsep[qtok * 8 + it.head], l2 = lsep[(size_t)NTOK * 8 + qtok * 8 + it.head];
        const float M = fmaxf(fmaxf(l1, l2), lse);
        float w0 = __builtin_amdgcn_exp2f(lse - M), w1 = __builtin_amdgcn_exp2f(l1 - M), w2 = __builtin_amdgcn_exp2f(l2 - M);
        const float wn = 1.0f / (w0 + w1 + w2); w0 *= wn; w1 *= wn; w2 *= wn;
        ostage_write(st, o0, o1, inv * w0, r32, hi);
        if (hi == 0) { wst[r32 * 4 + 1] = w1; wst[r32 * 4 + 2] = w2; }
        asm volatile("s_waitcnt lgkmcnt(0)" ::: "memory");
        const bf16_t* p1b = (const bf16_t*)(F.ws + WS_PART) + it.head * 64; const bf16_t* p2b = p1b + (size_t)NTOK * 512;
        bf16_t* obase = (bf16_t*)(F.ws + WS_MIX) + it.outcol;
#pragma unroll
        for (int i = 0; i < 4; ++i) { const int row = 8 * i + srow; const size_t tk = tokbase + cls + (size_t)it.dil * (qidx0 + row);
            const u32x4 a = *(const LAS u32x4*)(st + row * OST_ROW + sch * 16); const u32x4 x1 = *(const u32x4*)(p1b + tk * 512 + sch * 8), x2 = *(const u32x4*)(p2b + tk * 512 + sch * 8);
            const float q1 = wst[row * 4 + 1], q2 = wst[row * 4 + 2];
            u32x4 o;
            o.x = cvt_pk_bf16(bf_lo(a.x) + bf_lo(x1.x) * q1 + bf_lo(x2.x) * q2, bf_hi(a.x) + bf_hi(x1.x) * q1 + bf_hi(x2.x) * q2);
            o.y = cvt_pk_bf16(bf_lo(a.y) + bf_lo(x1.y) * q1 + bf_lo(x2.y) * q2, bf_hi(a.y) + bf_hi(x1.y) * q1 + bf_hi(x2.y) * q2);
            o.z = cvt_pk_bf16(bf_lo(a.z) + bf_lo(x1.z) * q1 + bf_lo(x2.z) * q2, bf_hi(a.z) + bf_hi(x1.z) * q1 + bf_hi(x2.z) * q2);
            o.w = cvt_pk_bf16(bf_lo(a.w) + bf_lo(x1.w) * q1 + bf_lo(x2.w) * q2, bf_hi(a.w) + bf_hi(x1.w) * q1 + bf_hi(x2.w) * q2);
            *(u32x4*)(obase + tk * DM + sch * 8) = o; }
    }
    __syncthreads();
}
__device__ __forceinline__ void band_phase(const Frame& F, int which  ) {
    const float* sinks = F.in[I_L0_A_SINKS];
    float gm[4] = {0.f, 0.f, 0.f, 0.f}, smax = 0.f;
    for (int i = 0; i < 64; ++i) { gm[0] = fmaxf(gm[0], fabsf(F.in[I_L0_A_QN][i])); gm[1] = fmaxf(gm[1], fabsf(F.in[I_L0_A_KN][i])); gm[2] = fmaxf(gm[2], fabsf(F.in[I_L0_B_QN][i])); gm[3] = fmaxf(gm[3], fabsf(F.in[I_L0_B_KN][i])); }
    for (int i = 0; i < 8; ++i) smax = fmaxf(smax, fabsf(sinks[i]));
    const bool fix = fmaxf(fmaxf(gm[0] * gm[1], gm[2] * gm[3]) * 8.0f, smax) * LOG2E < ATT_FIX_BOUND;
    const int nitems = which == 0 ? 6144 : 2048;
    for (int idx = F.bid; idx < nitems; idx += F.G) {
        BandItem it;
        const int ty = which == 0 ? idx / 2048 : 3, r = idx % 2048;
        it.b = r >> 6; const int h = (r >> 3) & 7, jp = r & 7;
        it.head = h; it.split_rows = false; it.has_sink = false; it.sink = 0.f; it.pidx = 0;
        if (ty == 0) { it.qcol = 64 * h; it.kcol = 512 + 64 * (h >> 2); it.vcol = 640 + 64 * (h >> 2); it.dil = 1; it.cls0 = it.cls1 = 0; it.tq0 = 256 * jp; it.tq1 = it.tq0 + 128; it.maxd = 127; it.mode = 0; it.outcol = 64 * h;
            it.has_sink = true; it.sink = sinks[h] * LOG2E; }
        else { it.qcol = 768 + 64 * h; it.kcol = 1280 + 64 * h; it.vcol = 1792 + 64 * h; it.maxd = 128; it.outcol = 512 + 64 * h;
            if (ty == 1) { it.dil = 1; it.cls0 = it.cls1 = 0; it.tq0 = 256 * jp; it.tq1 = it.tq0 + 128; it.mode = 1; it.pidx = 0; }
            else if (ty == 2) { it.dil = 4; it.cls0 = it.cls1 = jp >> 1; it.tq0 = 256 * (jp & 1); it.tq1 = it.tq0 + 128; it.mode = 1; it.pidx = 1; }
            else { it.dil = 16; it.cls0 = 2 * jp; it.cls1 = 2 * jp + 1; it.tq0 = 0; it.tq1 = 0; it.mode = 2; it.split_rows = true; } }
        if (fix) band_item<true>(F, it); else band_item<false>(F, it);
    }
}

constexpr int ML_KB = 12288, ML_VB = 8192, ML_STAGE = ML_KB + ML_VB;
__device__ __forceinline__ void mla_q_prep(bf16x8 (&q)[6], const float* gq, const float* cc, const float* sc, size_t t, int hi) {
    float ss = 0.f;
#pragma unroll
    for (int kk = 0; kk < 6; ++kk) { const u32x4 x = __builtin_bit_cast(u32x4, q[kk]);
        ss += bf_lo(x.x) * bf_lo(x.x) + bf_hi(x.x) * bf_hi(x.x) + bf_lo(x.y) * bf_lo(x.y) + bf_hi(x.y) * bf_hi(x.y) + bf_lo(x.z) * bf_lo(x.z) + bf_hi(x.z) * bf_hi(x.z) + bf_lo(x.w) * bf_lo(x.w) + bf_hi(x.w) * bf_hi(x.w); }
    const float rsd = __builtin_amdgcn_rsqf(swap32_sum(ss) * (1.f / 96.f) + EPS) * (0.10206207261596577f * LOG2E);
    float va[8], vb[8];
#pragma unroll
    for (int kk = 0; kk < 6; ++kk) { const u32x4 x = __builtin_bit_cast(u32x4, q[kk]);
        const f32x4 g0 = *(const f32x4*)(gq + 16 * kk + 8 * hi) * rsd, g1 = *(const f32x4*)(gq + 16 * kk + 8 * hi + 4) * rsd;
        float v[8] = {bf_lo(x.x) * g0[0], bf_hi(x.x) * g0[1], bf_lo(x.y) * g0[2], bf_hi(x.y) * g0[3], bf_lo(x.z) * g1[0], bf_hi(x.z) * g1[1], bf_lo(x.w) * g1[2], bf_hi(x.w) * g1[3]};
        if (kk < 4) { u32x4 o; o.x = cvt_pk_bf16(v[0], v[1]); o.y = cvt_pk_bf16(v[2], v[3]); o.z = cvt_pk_bf16(v[4], v[5]); o.w = cvt_pk_bf16(v[6], v[7]); q[kk] = __builtin_bit_cast(bf16x8, o); }
        else {
#pragma unroll
            for (int j = 0; j < 8; ++j) { if (kk == 4) va[j] = v[j]; else vb[j] = v[j]; } } }
    const f32x4 c0 = *(const f32x4*)(cc + t * 16 + 8 * hi), c1 = *(const f32x4*)(cc + t * 16 + 8 * hi + 4), s0 = *(const f32x4*)(sc + t * 16 + 8 * hi), s1 = *(const f32x4*)(sc + t * 16 + 8 * hi + 4);
    float ra[8], rb[8];
#pragma unroll
    for (int j = 0; j < 8; ++j) { const float c = j < 4 ? c0[j & 3] : c1[j & 3], s = j < 4 ? s0[j & 3] : s1[j & 3]; ra[j] = va[j] * c - vb[j] * s; rb[j] = vb[j] * c + va[j] * s; }
    { u32x4 o; o.x = cvt_pk_bf16(ra[0], ra[1]); o.y = cvt_pk_bf16(ra[2], ra[3]); o.z = cvt_pk_bf16(ra[4], ra[5]); o.w = cvt_pk_bf16(ra[6], ra[7]); q[4] = __builtin_bit_cast(bf16x8, o);
      o.x = cvt_pk_bf16(rb[0], rb[1]); o.y = cvt_pk_bf16(rb[2], rb[3]); o.z = cvt_pk_bf16(rb[4], rb[5]); o.w = cvt_pk_bf16(rb[6], rb[7]); q[5] = __builtin_bit_cast(bf16x8, o); }
}
template <bool FIXREF>
__device__ __forceinline__ void mla_unit(const Frame& F, int b, int h, int qb) {
    const int lane_ = lane_id_v();
    const bf16_t* Q = (const bf16_t*)(F.ws + WS_Q); const bf16_t* Kt = (const bf16_t*)(F.ws + WS_K); const bf16_t* V = (const bf16_t*)(F.ws + WS_KV);
    LAS unsigned char* lds = F.lds;
    const int lane = lane_, w = F.wave, hi = lane >> 5, r32 = lane & 31;
    const size_t tokbase = (size_t)b * SEQ;
    const int q0 = qb * 256, qidx0 = q0 + 32 * w, qidx = qidx0 + r32;
    const int NT = 4 * (qb + 1);
    const size_t hbase = ((size_t)b * 16 + h) * SEQ;
    const __amdgpu_buffer_rsrc_t rsK = __builtin_amdgcn_make_buffer_rsrc((void*)(Kt + hbase * 96), (short)0, SEQ * 96 * 2, 0x00020000);
    const __amdgpu_buffer_rsrc_t rsV = __builtin_amdgcn_make_buffer_rsrc((void*)(V + hbase * 64), (short)0, SEQ * 64 * 2, 0x00020000);
    const int k16 = lane >> 2, pc = lane & 3, swz = pc ^ ((k16 >> 2) & 3);
    unsigned vo0, vo1, vo2;
    { const int kg = w / 3, cg = w % 3; vo0 = (unsigned)((kg * 16 + k16) * 192 + (cg * 4 + swz) * 16); }
    if (w < 4) { const int id = w + 8, kg = id / 3, cg = id % 3; vo1 = (unsigned)((kg * 16 + k16) * 192 + (cg * 4 + swz) * 16);
                 const int j = w + 4, d0 = j >> 2, kgv = j & 3; vo2 = (unsigned)((kgv * 16 + k16) * 128 + (d0 * 4 + pc) * 16); }
    else { const int j = w - 4, d0 = j >> 2, kgv = j & 3; vo1 = (unsigned)((kgv * 16 + k16) * 128 + (d0 * 4 + pc) * 16); vo2 = 0; }
    const unsigned lds0 = (unsigned)(uintptr_t)lds;
#define ML_DMA(t, st) do { const unsigned so_k = (unsigned)((t) * 64 * 192), so_v = (unsigned)((t) * 64 * 128); \
        dma_piece(rsK, lds0 + (st) + w * 1024, vo0, so_k); \
        if (w < 4) { dma_piece(rsK, lds0 + (st) + (w + 8) * 1024, vo1, so_k); dma_piece(rsV, lds0 + (st) + ML_KB + (w + 4) * 1024, vo2, so_v); } \
        else { dma_piece(rsV, lds0 + (st) + ML_KB + (w - 4) * 1024, vo1, so_v); } } while (0)
    ML_DMA(0, 0);
    bf16x8 qf[6];
#pragma unroll
    for (int kk = 0; kk < 6; ++kk) qf[kk] = *(const bf16x8*)(Q + (hbase + qidx) * 96 + 16 * kk + 8 * hi);
    mla_q_prep(qf, F.in[I_L1_C_QN], (const float*)(F.ws + WS_ROPEC), (const float*)(F.ws + WS_ROPEC) + (size_t)NTOK * 16, tokbase + qidx, hi);
    float m = 0.f, l = 0.f; f32x16 o0, o1, negm;
#pragma unroll
    for (int r = 0; r < 16; ++r) { o0[r] = 0.f; o1[r] = 0.f; negm[r] = 0.f; }
    const int vlane = (4 * hi + ((lane & 15) >> 2)) * 64 + ((lane >> 4) & 1) * 32 + (lane & 3) * 8;
    const int klane = (r32 >> 4) * 3072 + (r32 & 15) * 64, ksw = (r32 >> 2) & 3, ke0 = ((hi) ^ ksw) * 16, ke1 = ((2 + hi) ^ ksw) * 16;
    asm volatile("s_waitcnt vmcnt(0) lgkmcnt(0)\n\ts_barrier" ::: "memory");
#define ML_TILE(t, CUR, NXT) do { \
        if ((t) + 1 < NT) ML_DMA((t) + 1, NXT); \
        const int kidx0 = 64 * (t); \
        LAS unsigned char* kp0 = lds + (CUR) + klane; LAS unsigned char* kp1 = kp0 + 6144; \
        LAS unsigned char* vp0 = lds + (CUR) + ML_KB + vlane; LAS unsigned char* vp1 = vp0 + 32 * 64; \
        if (kidx0 <= qidx0 + 31) \
            attn_step<96, true, FIXREF>(kp0, kp1, ke0, ke1, vp0, vp1, 4096, qf, negm, m, l, o0, o1, kidx0 + 31 > qidx0, kidx0 + 63 > qidx0, qidx, kidx0, 1 << 30, hi); \
        asm volatile("s_waitcnt vmcnt(0) lgkmcnt(0)\n\ts_barrier" ::: "memory"); } while (0)
#pragma unroll 1
    for (int t = 0; t < NT; t += 2) {
        ML_TILE(t, 0, ML_STAGE);
        ML_TILE(t + 1, ML_STAGE, 0);
    }
#undef ML_TILE
#undef ML_DMA
    l = swap32_sum(l);
    const float inv = 1.0f / l;
    { LAS unsigned char* st = lds + 2 * ML_STAGE + w * OST_WAVE;
      ostage_write(st, o0, o1, inv, r32, hi);
      asm volatile("s_waitcnt lgkmcnt(0)" ::: "memory");
      bf16_t* obase = (bf16_t*)(F.ws + WS_ATT) + (tokbase + qidx0) * DM + h * 64;
#pragma unroll
      for (int i = 0; i < 4; ++i) { const int row = 8 * i + (lane >> 3); *(u32x4*)(obase + (size_t)row * DM + (lane & 7) * 8) = *(const LAS u32x4*)(st + row * OST_ROW + (lane & 7) * 16); } }
}
__device__ __forceinline__ void mla_unit2(const Frame& F, int b, int h, int qb  ) {
    const int lane_ = lane_id_v();
    const bf16_t* Q = (const bf16_t*)(F.ws + WS_Q); const bf16_t* Kt = (const bf16_t*)(F.ws + WS_K); const bf16_t* V = (const bf16_t*)(F.ws + WS_KV);
    LAS unsigned char* lds = F.lds;
    const int lane = lane_, w = F.wave, hi = lane >> 5, r32 = lane & 31;
    const size_t tokbase = (size_t)b * SEQ;
    const int qidx0 = qb * 512 + 64 * w, qidx = qidx0 + r32;
    const int NT = 8 * (qb + 1);
    const size_t hbase = ((size_t)b * 16 + h) * SEQ;
    const __amdgpu_buffer_rsrc_t rsK = __builtin_amdgcn_make_buffer_rsrc((void*)(Kt + hbase * 96), (short)0, SEQ * 96 * 2, 0x00020000);
    const __amdgpu_buffer_rsrc_t rsV = __builtin_amdgcn_make_buffer_rsrc((void*)(V + hbase * 64), (short)0, SEQ * 64 * 2, 0x00020000);
    const int k16 = lane >> 2, pc = lane & 3, swz = pc ^ ((k16 >> 2) & 3);
    unsigned vo0, vo1, vo2;
    { const int kg = w / 3, cg = w % 3; vo0 = (unsigned)((kg * 16 + k16) * 192 + (cg * 4 + swz) * 16); }
    if (w < 4) { const int id = w + 8, kg = id / 3, cg = id % 3; vo1 = (unsigned)((kg * 16 + k16) * 192 + (cg * 4 + swz) * 16);
                 const int j = w + 4, d0 = j >> 2, kgv = j & 3; vo2 = (unsigned)((kgv * 16 + k16) * 128 + (d0 * 4 + pc) * 16); }
    else { const int j = w - 4, d0 = j >> 2, kgv = j & 3; vo1 = (unsigned)((kgv * 16 + k16) * 128 + (d0 * 4 + pc) * 16); vo2 = 0; }
    const unsigned lds0 = (unsigned)(uintptr_t)lds;
#define ML_DMA(t, st) do { const unsigned so_k = (unsigned)((t) * 64 * 192), so_v = (unsigned)((t) * 64 * 128); \
        dma_piece(rsK, lds0 + (st) + w * 1024, vo0, so_k); \
        if (w < 4) { dma_piece(rsK, lds0 + (st) + (w + 8) * 1024, vo1, so_k); dma_piece(rsV, lds0 + (st) + ML_KB + (w + 4) * 1024, vo2, so_v); } \
        else { dma_piece(rsV, lds0 + (st) + ML_KB + (w - 4) * 1024, vo1, so_v); } } while (0)
    ML_DMA(0, 0);
    bf16x8 qa[6], qb2[6];
    { const __amdgpu_buffer_rsrc_t rsQ = __builtin_amdgcn_make_buffer_rsrc((void*)(Q + hbase * 96), (short)0, SEQ * 96 * 2, 0x00020000);
      const unsigned qo = (unsigned)(qidx * 192 + hi * 16);
#pragma unroll
      for (int kk = 0; kk < 6; ++kk) { qa[kk] = __builtin_bit_cast(bf16x8, __builtin_amdgcn_raw_buffer_load_b128(rsQ, qo + kk * 32, 0, 0)); qb2[kk] = __builtin_bit_cast(bf16x8, __builtin_amdgcn_raw_buffer_load_b128(rsQ, qo + 32 * 192 + kk * 32, 0, 0)); } }
    { const float* cc_ = (const float*)(F.ws + WS_ROPEC); mla_q_prep(qa, F.in[I_L1_C_QN], cc_, cc_ + (size_t)NTOK * 16, tokbase + qidx, hi); mla_q_prep(qb2, F.in[I_L1_C_QN], cc_, cc_ + (size_t)NTOK * 16, tokbase + qidx + 32, hi); }
    float la = 0.f, lb = 0.f; f32x16 oa0, oa1, ob0, ob1;
#pragma unroll
    for (int r = 0; r < 16; ++r) { oa0[r] = 0.f; oa1[r] = 0.f; ob0[r] = 0.f; ob1[r] = 0.f; }
    const int vlane = (4 * hi + ((lane & 15) >> 2)) * 64 + ((lane >> 4) & 1) * 32 + (lane & 3) * 8;
    const int klane = (r32 >> 4) * 3072 + (r32 & 15) * 64, ksw = (r32 >> 2) & 3, ke0 = ((hi) ^ ksw) * 16, ke1 = ((2 + hi) ^ ksw) * 16;
    asm volatile("s_waitcnt vmcnt(0) lgkmcnt(0)\n\ts_barrier" ::: "memory");
#define ML_TILE(t, CUR, NXT) do { \
        if ((t) + 1 < NT) ML_DMA((t) + 1, NXT); \
        const int kidx0 = 64 * (t); \
        if (kidx0 <= qidx0 + 63) { \
            attn_step2<96>(lds + (CUR) + klane, ke0, ke1, lds + (CUR) + ML_KB + vlane, 4096, qa, qb2, la, lb, oa0, oa1, ob0, ob1, kidx0 + 31 > qidx0, kidx0 + 31 > qidx0 + 32, qidx, kidx0, hi); \
            attn_step2<96>(lds + (CUR) + klane + 6144, ke0, ke1, lds + (CUR) + ML_KB + vlane + 32 * 64, 4096, qa, qb2, la, lb, oa0, oa1, ob0, ob1, kidx0 + 63 > qidx0, kidx0 + 63 > qidx0 + 32, qidx, kidx0 + 32, hi); } \
        asm volatile("s_waitcnt vmcnt(0) lgkmcnt(0)\n\ts_barrier" ::: "memory"); } while (0)
#pragma unroll 1
    for (int t = 0; t < NT; t += 2) {
        ML_TILE(t, 0, ML_STAGE);
        ML_TILE(t + 1, ML_STAGE, 0);
    }
#undef ML_TILE
#undef ML_DMA
    la = swap32_sum(la); lb = swap32_sum(lb);
    const float ia = 1.0f / la, ib = 1.0f / lb;
    { LAS unsigned char* st = lds + 2 * ML_STAGE + w * 2 * OST_WAVE;
      ostage_write(st, oa0, oa1, ia, r32, hi); ostage_write(st + OST_WAVE, ob0, ob1, ib, r32, hi);
      asm volatile("s_waitcnt lgkmcnt(0)" ::: "memory");
      bf16_t* obase = (bf16_t*)(F.ws + WS_ATT) + (tokbase + qidx0) * DM + h * 64;
#pragma unroll
      for (int i = 0; i < 8; ++i) { const int row = 8 * i + (lane >> 3); *(u32x4*)(obase + (size_t)row * DM + (lane & 7) * 8) = *(const LAS u32x4*)(st + row * OST_ROW + (lane & 7) * 16); } }
}
__device__ __forceinline__ void mla_phase(const Frame& F) {
    float gq = 0.f, gk = 0.f;
    for (int i = 0; i < 96; ++i) { gq = fmaxf(gq, fabsf(F.in[I_L1_C_QN][i])); gk = fmaxf(gk, fabsf(F.in[I_L1_C_KN][i])); }
    const bool fix = gq * gk * 9.797959f * LOG2E < ATT_FIX_BOUND;
    if (fix) {
        for (int idx = F.bid; idx < 1024; idx += F.G) {
            const int bh = idx >> 1, s = idx & 1;
#pragma nounroll
            for (int u = 0; u < 2; ++u) mla_unit2(F, bh >> 4, bh & 15, u ? s : 3 - s);
        }
    } else {
        for (int idx = F.bid; idx < 2048; idx += F.G) {
            const int bh = idx >> 2, s = idx & 3;
#pragma nounroll
            for (int u = 0; u < 2; ++u) mla_unit<false>(F, bh >> 4, bh & 15, u ? s : 7 - s);
        }
    }
}

__device__ __forceinline__ void mla_rowstats(const Frame& F) {
    const int lane_ = lane_id_v();
    const bf16_t* P1 = (const bf16_t*)(F.ws + WS_PROJ1); float* rs = (float*)(F.ws + RT_ROWST);
    for (int t = F.bid * 8 + F.wave; t < NTOK; t += F.G * 8) {
        const bf16_t* pr = P1 + (size_t)t * L1_INP;
        const u32x2 a = *(const u32x2*)(pr + lane_ * 4); const unsigned a2 = *(const unsigned*)(pr + 256 + lane_ * 2); const u32x2 c = *(const u32x2*)(pr + CQ + lane_ * 4);
        const float s1 = bf_lo(a.x) * bf_lo(a.x) + bf_hi(a.x) * bf_hi(a.x) + bf_lo(a.y) * bf_lo(a.y) + bf_hi(a.y) * bf_hi(a.y) + bf_lo(a2) * bf_lo(a2) + bf_hi(a2) * bf_hi(a2);
        const float s2 = bf_lo(c.x) * bf_lo(c.x) + bf_hi(c.x) * bf_hi(c.x) + bf_lo(c.y) * bf_lo(c.y) + bf_hi(c.y) * bf_hi(c.y);
        const float rq = __builtin_amdgcn_rsqf(wave_sum(s1) * (1.f / CQ) + EPS), rkv = __builtin_amdgcn_rsqf(wave_sum(s2) * (1.f / CKV) + EPS);
        if (lane_ == 0) *(f32x2*)(rs + 2 * t) = (f32x2){rq, rkv};
    }
}
__device__ __forceinline__ void moe_route1(const Frame& F) {
    const int lane_ = lane_id_v(), tid_ = F.wave * 64 + lane_; (void)tid_;
    const bf16_t* x = (const bf16_t*)(F.ws + WS_X3); const float* gain = F.in[I_L1_FFN_NORM]; const float* router = F.in[I_L1_ROUTER];
    unsigned char* dst = (unsigned char*)(F.ws + WS_H3F8);
    int* tok_e = (int*)(F.ws + RT_TOKE); float* tok_g = (float*)(F.ws + RT_TOKG); int* wgcnt = (int*)(F.ws + RT_WGCNT);
    LAS int* cnt = (LAS int*)(F.lds + 32768);
    if (tid_ < 8) cnt[tid_] = 0;
    __syncthreads();
    f32x4 rr[4][4][2];
#pragma unroll
    for (int j = 0; j < 4; ++j)
#pragma unroll
        for (int c = 0; c < 4; ++c) { const int d = (lane_ + 64 * j) * 4 + c; rr[j][c][0] = *(const f32x4*)(router + d * 8); rr[j][c][1] = *(const f32x4*)(router + d * 8 + 4); }
    f32x4 gv[4];
#pragma unroll
    for (int j = 0; j < 4; ++j) gv[j] = ((const f32x4*)gain)[lane_ + 64 * j];
    u32x2 nx[4];
    { const int m0 = F.bid * 8 + F.wave; const u32x2* xr = (const u32x2*)(x + (size_t)m0 * DM) + lane_;
#pragma unroll
      for (int j = 0; j < 4; ++j) nx[j] = xr[64 * j]; }
    for (int m = F.bid * 8 + F.wave; m < NTOK; m += F.G * 8) {
        u32x2 cx[4];
#pragma unroll
        for (int j = 0; j < 4; ++j) cx[j] = nx[j];
        if (m + F.G * 8 < NTOK) { const u32x2* xr = (const u32x2*)(x + (size_t)(m + F.G * 8) * DM) + lane_;
#pragma unroll
            for (int j = 0; j < 4; ++j) nx[j] = xr[64 * j]; }
        f32x4 v[4]; float s = 0.f;
#pragma unroll
        for (int j = 0; j < 4; ++j) { const u32x2 xx = cx[j]; v[j] = (f32x4){bf_lo(xx.x), bf_hi(xx.x), bf_lo(xx.y), bf_hi(xx.y)}; s += (v[j].x * v[j].x + v[j].y * v[j].y) + (v[j].z * v[j].z + v[j].w * v[j].w); }
        const float rstd = __builtin_amdgcn_rsqf(wave_sum(s) * (1.f / DM) + EPS);
        float lg[8];
#pragma unroll
        for (int e = 0; e < 8; ++e) lg[e] = 0.f;
        unsigned* o8 = (unsigned*)(dst + (size_t)m * DM) + lane_;
#pragma unroll
        for (int j = 0; j < 4; ++j) {
            f32x4 hv = v[j] * rstd * gv[j];
            o8[64 * j] = pk4_fp8(hv.x, hv.y, hv.z, hv.w);
#pragma unroll
            for (int c = 0; c < 4; ++c) { const f32x4 r0 = rr[j][c][0], r1 = rr[j][c][1];
                lg[0] += hv[c] * r0.x; lg[1] += hv[c] * r0.y; lg[2] += hv[c] * r0.z; lg[3] += hv[c] * r0.w; lg[4] += hv[c] * r1.x; lg[5] += hv[c] * r1.y; lg[6] += hv[c] * r1.z; lg[7] += hv[c] * r1.w; }
        }
        { const bool b0 = lane_ & 1, b1 = (lane_ >> 1) & 1, b2 = (lane_ >> 2) & 1;
          float k4[4], k2[2], k1;
#pragma unroll
          for (int i = 0; i < 4; ++i) { const float keep = b0 ? lg[4 + i] : lg[i], send = b0 ? lg[i] : lg[4 + i]; k4[i] = keep + __shfl_xor(send, 1); }
#pragma unroll
          for (int i = 0; i < 2; ++i) { const float keep = b1 ? k4[2 + i] : k4[i], send = b1 ? k4[i] : k4[2 + i]; k2[i] = keep + __shfl_xor(send, 2); }
          { const float keep = b2 ? k2[1] : k2[0], send = b2 ? k2[0] : k2[1]; k1 = keep + __shfl_xor(send, 4); }
          k1 += __shfl_xor(k1, 8); k1 += __shfl_xor(k1, 16); k1 += __shfl_xor(k1, 32);
#pragma unroll
          for (int e = 0; e < 8; ++e) lg[e] = __uint_as_float(__builtin_amdgcn_readlane(__float_as_uint(k1), (e >> 2) | (((e >> 1) & 1) << 1) | ((e & 1) << 2))); }
        int e0 = 0; float v0 = lg[0];
#pragma unroll
        for (int e = 1; e < 8; ++e) if (lg[e] > v0) { v0 = lg[e]; e0 = e; }
        int e1 = -1; float v1 = -INFINITY;
#pragma unroll
        for (int e = 0; e < 8; ++e) if (e != e0 && lg[e] > v1) { v1 = lg[e]; e1 = e; }
        const float p1 = __expf(v1 - v0), g0 = 1.0f / (1.0f + p1), g1 = p1 * g0;
        if (lane_ == 0) { tok_e[2 * m] = e0; tok_e[2 * m + 1] = e1; tok_g[2 * m] = g0; tok_g[2 * m + 1] = g1;
            __hip_atomic_fetch_add(cnt + e0, 1, __ATOMIC_RELAXED, __HIP_MEMORY_SCOPE_WORKGROUP); __hip_atomic_fetch_add(cnt + e1, 1, __ATOMIC_RELAXED, __HIP_MEMORY_SCOPE_WORKGROUP); }
    }
    __syncthreads();
    if (tid_ < 8) wgcnt[F.bid * 8 + tid_] = cnt[tid_];
}
__device__ __forceinline__ void moe_route2(const Frame& F) {
    const int lane_ = lane_id_v(), tid_ = F.wave * 64 + lane_; (void)tid_;
    const int* tok_e = (const int*)(F.ws + RT_TOKE); int* tok_s = (int*)(F.ws + RT_TOKS); int* row_tok = (int*)(F.ws + RT_ROWTOK);
    const int* wgcnt = (const int*)(F.ws + RT_WGCNT); int* tile_e = (int*)(F.ws + RT_TILEE);
    LAS int* tot = (LAS int*)F.lds;
    if (tid_ < 32) tot[tid_] = 0;
    __syncthreads();
    { const int e = tid_ & 7; int a = 0, b = 0;
      for (int wg = tid_ >> 3; wg < F.G; wg += 64) { const int c = wgcnt[wg * 8 + e]; a += c; if (wg < F.bid) b += c; }
      __hip_atomic_fetch_add(tot + e, a, __ATOMIC_RELAXED, __HIP_MEMORY_SCOPE_WORKGROUP); __hip_atomic_fetch_add(tot + 8 + e, b, __ATOMIC_RELAXED, __HIP_MEMORY_SCOPE_WORKGROUP); }
    __syncthreads();
    if (tid_ == 0) { int ps = 0; for (int e = 0; e < 8; ++e) { tot[16 + e] = ps; ps += (tot[e] + 255) / 256 * 256; } tot[32] = ps; }
    __syncthreads();
    if (F.bid == 0) {
        const int used = tot[32] / 256;
        for (int t = tid_; t < MOE_TILES_MAX; t += 512) { int e = -1; if (t < used) { e = 7; for (int q = 7; q >= 1; --q) if (t * 256 < tot[16 + q]) e = q - 1; } tile_e[t] = e < 0 ? 0 : e; }
        if (tid_ == 0) tile_e[MOE_TILES_MAX] = used;
    }
    if (F.bid < 8) {
        const int e = F.bid, lo = tot[16 + e] + tot[e], hi = tot[16 + e] + (tot[e] + 255) / 256 * 256;
        for (int p = lo + tid_; p < hi; p += 512) row_tok[p] = -1;
    }
    { const int gw = F.bid * 8 + F.wave, NGW = F.G * 8;
      for (int j0 = 0; gw + j0 * NGW < NTOK; j0 += 32) {
          const int m = gw + (j0 + (lane_ >> 1)) * NGW, k = lane_ & 1;
          if (m < NTOK) { const int e = tok_e[2 * m + k];
              const int slot = tot[16 + e] + tot[8 + e] + __hip_atomic_fetch_add(tot + 24 + e, 1, __ATOMIC_RELAXED, __HIP_MEMORY_SCOPE_WORKGROUP);
              row_tok[slot] = m; tok_s[2 * m + k] = slot; } } }
    __syncthreads();
}
__device__ __forceinline__ void moe_combine(const Frame& F, bool dry) {
    const int lane_ = lane_id_v();
    const f32x2* tok_g = (const f32x2*)(F.ws + RT_TOKG); const u32x2* tok_s = (const u32x2*)(F.ws + RT_TOKS); const unsigned char* Y = (const unsigned char*)(F.ws + WS_Y);
    for (int m = (F.bid * 8 + F.wave) * 2; m < NTOK; m += F.G * 16) {
        const f32x2 ga = tok_g[m], gb = tok_g[m + 1]; const u32x2 sa = tok_s[m], sb = tok_s[m + 1];
        f32x4* xa = (f32x4*)(F.out + (size_t)m * DM) + lane_; f32x4* xb = xa + DM / 4;
        const u32x2* x3a = (const u32x2*)((const bf16_t*)(F.ws + WS_X3) + (size_t)m * DM) + lane_; const u32x2* x3b = x3a + DM / 4;
        const unsigned* ya0 = (const unsigned*)(Y + (size_t)sa.x * DM) + lane_; const unsigned* ya1 = (const unsigned*)(Y + (size_t)sa.y * DM) + lane_;
        const unsigned* yb0 = (const unsigned*)(Y + (size_t)sb.x * DM) + lane_; const unsigned* yb1 = (const unsigned*)(Y + (size_t)sb.y * DM) + lane_;
        f32x4 va[4], vb[4]; unsigned a0[4], a1[4], b0[4], b1[4];
#pragma unroll
        for (int j = 0; j < 4; ++j) { { const u32x2 p = x3a[64 * j], q = x3b[64 * j]; va[j] = (f32x4){bf_lo(p.x), bf_hi(p.x), bf_lo(p.y), bf_hi(p.y)}; vb[j] = (f32x4){bf_lo(q.x), bf_hi(q.x), bf_lo(q.y), bf_hi(q.y)}; } a0[j] = ya0[64 * j]; a1[j] = ya1[64 * j]; b0[j] = yb0[64 * j]; b1[j] = yb1[64 * j]; }
#pragma unroll
        for (int j = 0; j < 4; ++j) {
            const float gax = ga.x * 0.0625f, gay = ga.y * 0.0625f, gbx = gb.x * 0.0625f, gby = gb.y * 0.0625f;
            f32x4 v = va[j];
            v.x += gax * __builtin_amdgcn_cvt_f32_fp8((int)a0[j], 0) + gay * __builtin_amdgcn_cvt_f32_fp8((int)a1[j], 0); v.y += gax * __builtin_amdgcn_cvt_f32_fp8((int)a0[j], 1) + gay * __builtin_amdgcn_cvt_f32_fp8((int)a1[j], 1);
            v.z += gax * __builtin_amdgcn_cvt_f32_fp8((int)a0[j], 2) + gay * __builtin_amdgcn_cvt_f32_fp8((int)a1[j], 2); v.w += gax * __builtin_amdgcn_cvt_f32_fp8((int)a0[j], 3) + gay * __builtin_amdgcn_cvt_f32_fp8((int)a1[j], 3);
            if (!dry) xa[64 * j] = v;
            v = vb[j];
            v.x += gbx * __builtin_amdgcn_cvt_f32_fp8((int)b0[j], 0) + gby * __builtin_amdgcn_cvt_f32_fp8((int)b1[j], 0); v.y += gbx * __builtin_amdgcn_cvt_f32_fp8((int)b0[j], 1) + gby * __builtin_amdgcn_cvt_f32_fp8((int)b1[j], 1);
            v.z += gbx * __builtin_amdgcn_cvt_f32_fp8((int)b0[j], 2) + gby * __builtin_amdgcn_cvt_f32_fp8((int)b1[j], 2); v.w += gbx * __builtin_amdgcn_cvt_f32_fp8((int)b0[j], 3) + gby * __builtin_amdgcn_cvt_f32_fp8((int)b1[j], 3);
            if (!dry) xb[64 * j] = v; }
    }
}

constexpr int NPHASE = 21;
__global__ void __launch_bounds__(512, 2) mk_fwd(Args args) {
    extern __shared__ __attribute__((aligned(16))) unsigned char lds_raw[];
    Frame F;
    F.lds = (LAS unsigned char*)lds_raw;
    F.wave = __builtin_amdgcn_readfirstlane((int)threadIdx.x >> 6);
    F.G = gridDim.x; F.bid = blockIdx.x; F.ws = args.ws; F.out = args.out; F.in = args.in;
    volatile LAS unsigned* MISC = (volatile LAS unsigned*)(F.lds + LDS_MISC);
    { const int l0 = lane_id_v(); if (F.wave == 0) MISC[l0] = 0u; }
    __syncthreads();
    unsigned* ctl = (unsigned*)(args.ws + WS_CTL);
    XcdBarrier bar; bar.bar = ctl + CW_BAR; bar.x = 0; bar.st = nullptr; bar.wave = F.wave;
    if (!MK_PER_PHASE) bar = xcd_barrier_post(ctl + CW_BAR, MISC, F.wave);
    const int lo = args.ph_lo, hi = args.ph_hi; const unsigned probe = args.probe; (void)probe;
    unsigned char* ws = args.ws;
#define IN(k) (lo <= (k) && (k) < hi)
#if PROBE_MASK != 0
#define DRY(k) (rep_ < (int)((probe >> (k)) & 1u))
#define REPS(k) _Pragma("nounroll") for (int rep_ = 0; rep_ <= (int)((probe >> (k)) & 1u); ++rep_)
#else
#define DRY(k) false
#define REPS(k)
#endif
#define SEAM(k) do { if (IN(k) && IN((k) + 1)) { if (!MK_PER_PHASE) xcd_barrier(bar); } } while (0)
    int ph = 0;
    if (IN(0)) REPS(0) { p0_weights(F); p0_rope(F); x_rows(F, F.in[I_X], (bf16_t*)(ws + WS_H), (float*)(ws + RT_ROWST)); } SEAM(0);
    if (IN(1)) REPS(1) { pg8::Gemm g{(const bf16_t*)(ws + WS_H), (const bf16_t*)(ws + W0_IN), DM, DM, 0, nullptr}; pg8::StaticOrder S; S.init(NTOK / 256, L0_IN / 256, F.G, F.bid);
        pg8::EpiQKV0 E{(bf16_t*)(ws + WS_PROJ0), (const float*)(ws + WS_ROPEH), (const float*)(ws + WS_ROPEH) + (size_t)NTOK * 32, (const float*)(ws + RT_ROWST), F.in[I_L0_A_QN], F.in[I_L0_A_KN], F.in[I_L0_B_QN], F.in[I_L0_B_KN]};
        pg8::gemm_phase<pg8::EpiQKV0, false, 2, L0_IN / 256>(F.lds, g, S, E, 0, F.wave); } SEAM(1);
    if (IN(2)) REPS(2) { band_phase(F, 0); } SEAM(2);
    if (IN(3)) REPS(3) { band_phase(F, 1); } SEAM(3);
    if (IN(4)) REPS(4) { pg8::Gemm g{(const bf16_t*)(ws + WS_MIX), (const bf16_t*)(ws + W0_OUT), DM, DM, 0, nullptr}; pg8::StaticOrder S; S.init(NTOK / 256, DM / 256, F.G, F.bid);
        pg8::EpiRes<true, true, true> E{ws + WS_H, ws + WS_X12, false, (float*)(ws + WS_SSX), (LAS float*)(F.lds + RING_BYTES + 2048)}; pg8::gemm_phase<pg8::EpiRes<true, true, true>, false, 2, DM / 256>(F.lds, g, S, E, 0, F.wave); } SEAM(4);
    if (IN(6)) REPS(6) { pg8::Gemm g{(const bf16_t*)(ws + WS_X12), (const bf16_t*)(ws + W0_GU), DM, DM, 0, nullptr}; pg8::StaticOrder S; S.init(NTOK / 256, 2 * DFF / 256, F.G, F.bid);
        pg8::EpiSwiGLU E{(bf16_t*)(ws + WS_HID0), DFF, 0, (const float*)(ws + WS_SSX)}; pg8::gemm_phase<pg8::EpiSwiGLU, false, 2, 2 * DFF / 256>(F.lds, g, S, E, 0, F.wave); } SEAM(6);
    if (IN(7)) REPS(7) { pg8::Gemm g{(const bf16_t*)(ws + WS_HID0), (const bf16_t*)(ws + W0_DN), DFF, DFF, 0, nullptr}; pg8::StaticOrder S; S.init(NTOK / 256, DM / 256, F.G, F.bid);
        pg8::EpiRes<true, true, true> E{ws + WS_X12, ws + WS_X12, DRY(7), (float*)(ws + WS_SSX), (LAS float*)(F.lds + RING_BYTES + 2048)}; pg8::gemm_phase<pg8::EpiRes<true, true, true>, false, 2, DM / 256>(F.lds, g, S, E, 0, F.wave); } SEAM(7);
    if (IN(9)) REPS(9) { pg8::Gemm g{(const bf16_t*)(ws + WS_X12), (const bf16_t*)(ws + W1_IN), DM, DM, 0, nullptr}; pg8::StaticOrder S; S.init(NTOK / 256, L1_INP / 256, F.G, F.bid);
        pg8::EpiProj1 E{(bf16_t*)(ws + WS_PROJ1), (float*)(ws + WS_ROPEH), (LAS float*)(F.lds + RING_BYTES + 2048), (const float*)(ws + WS_SSX)}; pg8::gemm_phase<pg8::EpiProj1, false, 2, L1_INP / 256>(F.lds, g, S, E, 0, F.wave); } SEAM(9);
    if (IN(11)) REPS(11) {
        { pg8::Gemm g{(const bf16_t*)(ws + WS_PROJ1), (const bf16_t*)(ws + W1_UQ), L1_INP, CQ, 0, nullptr}; pg8::StaticOrder S; S.init(NTOK / 256, NUQ / 256, F.G, F.bid);
          pg8::EpiBf16Row E{(bf16_t*)(ws + WS_Q), NUQ, (const float*)(ws + WS_ROPEH), 0}; pg8::gemm_phase<pg8::EpiBf16Row, false, 2, NUQ / 256>(F.lds, g, S, E, 0, F.wave); } }
    if (IN(12)) REPS(12) {
        { pg8::Gemm g{(const bf16_t*)(ws + WS_PROJ1) + CQ, (const bf16_t*)(ws + W1_UKV), L1_INP, CKV, 0, nullptr}; pg8::StaticOrder S; S.init(NTOK / 256, NUKV / 256, F.G, F.bid);
          const float* cc_ = (const float*)(ws + WS_ROPEC);
          pg8::EpiKV1 E{(bf16_t*)(ws + WS_K), (bf16_t*)(ws + WS_KV), (const float*)(ws + WS_ROPEH), (const bf16_t*)(ws + WS_PROJ1), cc_, cc_ + (size_t)NTOK * 16, F.in[I_L1_C_KN]};
          pg8::gemm_phase<pg8::EpiKV1, false, 2, NUKV / 256>(F.lds, g, S, E, 0, F.wave); } } SEAM(12);
    if (IN(14)) REPS(14) { mla_phase(F); } SEAM(14);
    if (IN(15)) REPS(15) { pg8::Gemm g{(const bf16_t*)(ws + WS_ATT), (const bf16_t*)(ws + W1_OUT), DM, DM, 0, nullptr}; pg8::StaticOrder S; S.init(NTOK / 256, DM / 256, F.G, F.bid);
        pg8::EpiRes<true, true> E{ws + WS_X12, ws + WS_X3, false, nullptr, nullptr}; pg8::gemm_phase<pg8::EpiRes<true, true>, false, 2, DM / 256>(F.lds, g, S, E, 0, F.wave); } SEAM(15);
    if (IN(16)) REPS(16) { moe_route1(F); } SEAM(16);
    if (IN(17)) REPS(17) { moe_route2(F); } SEAM(17);
    if (IN(18)) REPS(18) {
        const int* tile_e = (const int*)(ws + RT_TILEE); const int used = tile_e[MOE_TILES_MAX];
        pg8::Gemm g{(const bf16_t*)(ws + WS_H3F8), (const bf16_t*)(ws + WE_GU), DM, DM, (size_t)2 * DFE * DM, (const int*)(ws + RT_ROWTOK)}; pg8::StaticOrder S; S.init(used, 2 * DFE / 256, F.G, F.bid, 0, tile_e);
        static_assert(WGU_SCALE == 32.0f && WDN_SCALE == 64.0f, "MFMA block scales below");
        pg8::EpiSwiGLU8 E{(unsigned char*)(ws + WS_HIDE), DFE, DRY(18)}; pg8::gemm_phase<pg8::EpiSwiGLU8, true, 1, 0, 0x7a7a7a7a>(F.lds, g, S, E, 0, F.wave); } SEAM(18);
    if (IN(19)) REPS(19) {
        const int* tile_e = (const int*)(ws + RT_TILEE); const int used = tile_e[MOE_TILES_MAX];
        pg8::Gemm g{(const bf16_t*)(ws + WS_HIDE), (const bf16_t*)(ws + WE_DN), DFE, DFE, (size_t)DM * DFE, nullptr}; pg8::StaticOrder S; S.init(used, DM / 256, F.G, F.bid, 0, tile_e);
        pg8::EpiFp8 E{(unsigned char*)(ws + WS_Y), DM}; pg8::gemm_phase<pg8::EpiFp8, false, 1, 0, 0x7d7d7d7d>(F.lds, g, S, E, 0, F.wave); } SEAM(19);
    if (IN(20)) REPS(20) { moe_combine(F, DRY(20)); }
    (void)ph;
#undef IN
#undef SEAM
}

extern "C" void kernel_launch(void* const* d_in, const int* in_sizes, int n_in, void* d_out, int out_size, void* d_ws, size_t ws_size, hipStream_t stream) {
    static int grid = 0;
    if (grid == 0) {
        if (n_in != 28 || in_sizes[0] != NTOK * DM || out_size != NTOK * DM || ws_size < WS_END) {
            fprintf(stderr, "kernel_launch: unexpected shapes (n_in %d, in0 %d, out %d, ws %zu < %zu); nothing launched\n", n_in, n_in > 0 ? in_sizes[0] : -1, out_size, ws_size, (size_t)WS_END); grid = -1; return; }
        int dev = 0, cus = 0, per_cu = 0;
        if (hipGetDevice(&dev) != hipSuccess || hipDeviceGetAttribute(&cus, hipDeviceAttributeMultiprocessorCount, dev) != hipSuccess) { grid = -1; return; }
        if (hipFuncSetAttribute((const void*)mk_fwd, hipFuncAttributeMaxDynamicSharedMemorySize, LDS_BYTES) != hipSuccess) { fprintf(stderr, "kernel_launch: hipFuncSetAttribute failed\n"); grid = -1; return; }
        if (hipOccupancyMaxActiveBlocksPerMultiprocessor(&per_cu, (const void*)mk_fwd, 512, LDS_BYTES) != hipSuccess || per_cu < 1) fprintf(stderr, "kernel_launch: occupancy query reports %d\n", per_cu);
        (void)hipGetLastError();
        grid = cus;
    }
    if (grid < 0) return;
    if (hipMemsetAsync((char*)d_ws + WS_CTL, 0, CTL_ZERO_BYTES, stream) != hipSuccess) return;
    Args a{};
    for (int i = 0; i < 28; ++i) a.in[i] = (const float*)d_in[i];
    a.out = (float*)d_out; a.ws = (unsigned char*)d_ws; a.probe = PROBE_MASK; a.pad = 0;
    if (MK_PER_PHASE) {
        for (int p = 0; p < NPHASE; ++p) { a.ph_lo = p; a.ph_hi = p + 1; hipLaunchKernelGGL(mk_fwd, dim3(grid), dim3(512), LDS_BYTES, stream, a); }
    } else {
        a.ph_lo = 0; a.ph_hi = NPHASE; hipLaunchKernelGGL(mk_fwd, dim3(grid), dim3(512), LDS_BYTES, stream, a);
    }
}
```

```cpp
#include <hip/hip_runtime.h>
#include <cstdio>
#include <cstdint>

#ifndef PROBE_MASK
#define PROBE_MASK 0u
#endif
#ifndef MK_PER_PHASE
#define MK_PER_PHASE 0
#endif

#define LAS __attribute__((address_space(3)))
#define GAS __attribute__((address_space(1)))
typedef unsigned short bf16_t;
typedef short bf16x8 __attribute__((ext_vector_type(8)));
typedef short s16x4 __attribute__((ext_vector_type(4)));
typedef float f32x2 __attribute__((ext_vector_type(2)));
typedef float f32x4 __attribute__((ext_vector_type(4)));
typedef float f32x16 __attribute__((ext_vector_type(16)));
typedef unsigned u32x2 __attribute__((ext_vector_type(2)));
typedef unsigned u32x4 __attribute__((ext_vector_type(4)));
typedef int v8i_t __attribute__((ext_vector_type(8)));
typedef int v4i_t __attribute__((ext_vector_type(4)));
typedef short bf16x16_t __attribute__((ext_vector_type(16)));

constexpr int NTOK = 65536, DM = 1024, SEQ = 2048, NBATCH = 32;
constexpr int L0_IN = 2304, DFF = 2816, L1_INP = 768  , CQ = 384, CKV = 256, NUQ = 1536, NUKV = 2048;
constexpr int NEXP = 8, DFE = 3584, MOE_ROWS_MAX = 133120  , MOE_TILES_MAX = 520, MOE_CHUNK_TILES = 130;
constexpr float EPS = 1e-6f;
constexpr float LOG2E = 1.4426950408889634f;
constexpr float WGU_SCALE = 32.0f, WDN_SCALE = 64.0f;

constexpr size_t MiB = 1u << 20;
constexpr size_t WS_CTL = 0, CTL_ZERO_BYTES = 64 * 1024;
constexpr size_t WS_ROUTE = 1 * MiB;
constexpr size_t RT_TOKE = WS_ROUTE;
constexpr size_t RT_TOKG = RT_TOKE + (size_t)NTOK * 8;
constexpr size_t RT_TOKS = RT_TOKG + (size_t)NTOK * 8;
constexpr size_t RT_ROWTOK = RT_TOKS + (size_t)NTOK * 8;
constexpr size_t RT_WGCNT = RT_ROWTOK + (size_t)MOE_ROWS_MAX * 4;
constexpr size_t RT_TILEE = RT_WGCNT + 1024 * 8 * 4;
constexpr size_t RT_ROWST = RT_TILEE + 4096;
constexpr size_t RT_END = RT_ROWST + (size_t)NTOK * 8;
static_assert(RT_END <= 4 * MiB, "route tables");
constexpr size_t WS_W = 4 * MiB;
constexpr size_t W0_IN = WS_W;
constexpr size_t W0_OUT = W0_IN + (size_t)L0_IN * DM * 2;
constexpr size_t W0_GU = W0_OUT + (size_t)DM * DM * 2;
constexpr size_t W0_DN = W0_GU + (size_t)2 * DFF * DM * 2;
constexpr size_t W1_IN = W0_DN + (size_t)DM * DFF * 2;
constexpr size_t W1_UQ = W1_IN + (size_t)L1_INP * DM * 2;
constexpr size_t W1_UKV = W1_UQ + (size_t)NUQ * CQ * 2;
constexpr size_t W1_OUT = W1_UKV + (size_t)NUKV * CKV * 2;
constexpr size_t WE_GU = W1_OUT + (size_t)DM * DM * 2;
constexpr size_t WE_DN = WE_GU + (size_t)NEXP * 2 * DFE * DM;
constexpr size_t WS_W_END = WE_DN + (size_t)NEXP * DM * DFE;
static_assert(WS_W_END <= 202 * MiB, "weights");
constexpr size_t WS_H = 202 * MiB;
constexpr size_t WS_PROJ0 = 330 * MiB;
constexpr size_t WS_MIX = 618 * MiB;
constexpr size_t WS_PART = 746 * MiB;
constexpr size_t WS_LSE = 874 * MiB;
constexpr size_t WS_X12 = 746 * MiB;
constexpr size_t WS_SSX = 1004 * MiB;
constexpr size_t WS_ROPEH = 1000 * MiB;
constexpr size_t WS_ROPEC = 1016 * MiB;
constexpr size_t WS_HID0 = 330 * MiB;
constexpr size_t WS_PROJ1 = 878 * MiB;
constexpr size_t WS_Q = 426 * MiB;
constexpr size_t WS_KV = 618 * MiB;
constexpr size_t WS_K = 202 * MiB;
constexpr size_t WS_ATT = 874 * MiB;
constexpr size_t WS_X3 = 117 * MiB;
constexpr size_t WS_H3F8 = 245 * MiB;
constexpr size_t WS_HIDE = 309 * MiB;
constexpr size_t WS_Y = 764 * MiB;
static_assert(WE_DN + (size_t)NEXP * DM * DFE <= WS_X3 && WS_X3 + (size_t)NTOK * DM * 2 <= WS_H3F8, "x3 map");
constexpr size_t WS_END = 1024 * MiB;
static_assert(WS_H3F8 + (size_t)NTOK * DM <= WS_HIDE && WS_HIDE + (size_t)MOE_ROWS_MAX * DFE <= WS_Y && WS_Y + (size_t)MOE_ROWS_MAX * DM * 2 <= WS_END, "moe map");
static_assert(WS_ATT + (size_t)NTOK * DM * 2 <= WS_ROPEC, "att map");

constexpr int CW_BAR = 1024;

constexpr int RING_BYTES = 131072;
constexpr int LDS_ROWTAB = RING_BYTES;
constexpr int LDS_BYTES = 147456;
constexpr int LDS_MISC = LDS_BYTES - 256;

#define RLX_AGENT __ATOMIC_RELAXED, __HIP_MEMORY_SCOPE_AGENT
#define LDS_WAIT() asm volatile("s_waitcnt lgkmcnt(0)" ::: "memory")
#define VM_WAIT() asm volatile("s_waitcnt vmcnt(0)" ::: "memory")
__device__ __forceinline__ unsigned cvt_pk_bf16(float lo, float hi) { unsigned r; asm volatile("v_cvt_pk_bf16_f32 %0, %1, %2" : "=v"(r) : "v"(lo), "v"(hi)); return r; }
__device__ __forceinline__ unsigned pk4_fp8(float a, float b, float c, float d) { int w = 0; w = __builtin_amdgcn_cvt_pk_fp8_f32(a, b, w, false); w = __builtin_amdgcn_cvt_pk_fp8_f32(c, d, w, true); return (unsigned)w; }
__device__ __forceinline__ float bf_lo(unsigned u) { return __uint_as_float(u << 16); }
__device__ __forceinline__ float bf_hi(unsigned u) { return __uint_as_float(u & 0xffff0000u); }
__device__ __forceinline__ int lane_id() { return (int)__builtin_amdgcn_mbcnt_hi(~0u, __builtin_amdgcn_mbcnt_lo(~0u, 0u)); }
__device__ __forceinline__ int lane_id_v() { int l; asm volatile("v_mbcnt_lo_u32_b32 %0, -1, 0\n\tv_mbcnt_hi_u32_b32 %0, -1, %0" : "=v"(l)); return l; }
__device__ __forceinline__ float wave_sum(float v) {
#pragma unroll
    for (int o = 1; o < 64; o <<= 1) v += __shfl_xor(v, o);
    return v;
}
__device__ __forceinline__ float fq_sum(float v) {
    auto a = __builtin_amdgcn_permlane16_swap(__float_as_uint(v), __float_as_uint(v), false, false); v = __uint_as_float(a[0]) + __uint_as_float(a[1]);
    auto b = __builtin_amdgcn_permlane32_swap(__float_as_uint(v), __float_as_uint(v), false, false); return __uint_as_float(b[0]) + __uint_as_float(b[1]); }
__device__ __forceinline__ float swap32_max(float v) { auto rr = __builtin_amdgcn_permlane32_swap(__float_as_uint(v), __float_as_uint(v), false, false); return fmaxf(__uint_as_float(rr[0]), __uint_as_float(rr[1])); }
__device__ __forceinline__ float swap32_sum(float v) { auto rr = __builtin_amdgcn_permlane32_swap(__float_as_uint(v), __float_as_uint(v), false, false); return __uint_as_float(rr[0]) + __uint_as_float(rr[1]); }

#define XB_TMO      128
#define XB_XCNT(j)  (256  + 64 * (j))
#define XB_XSUB(j)  (1280 + 64 * (j))
#define XB_XGEN(j)  (2304 + 64 * (j))
#define XB_TOP      3328
#define XB_TOPGEN   3392
#define XCD_BAR_WORDS 3456
#define XB_SPIN_CAP (1u << 18)
__device__ __forceinline__ unsigned xb_ld(unsigned* p)              { return __hip_atomic_load(p, __ATOMIC_RELAXED, __HIP_MEMORY_SCOPE_AGENT); }
__device__ __forceinline__ unsigned xb_add(unsigned* p, unsigned v) { return __hip_atomic_fetch_add(p, v, __ATOMIC_RELAXED, __HIP_MEMORY_SCOPE_AGENT); }
__device__ __forceinline__ unsigned xb_xcc_id() { return (unsigned)__builtin_amdgcn_s_getreg((3 << 11) | 20) & 0xFu; }
#define XB_SPIN(cond, bar) do { unsigned _sp = 0; while (cond) { __builtin_amdgcn_s_sleep(1); \
    if ((++_sp & 255u) == 0u) { if (xb_ld(&(bar)[XB_TMO])) break; if (_sp > XB_SPIN_CAP) { atomicAdd(&(bar)[XB_TMO], 1u); break; } } } } while (0)
struct XcdBarrier { unsigned* bar; unsigned x; volatile LAS unsigned* st; int wave; };
__device__ __forceinline__ XcdBarrier xcd_barrier_post(unsigned* bar, volatile LAS unsigned* st, int wave) {
    XcdBarrier b; b.bar = bar; b.x = xb_xcc_id(); b.st = st; b.wave = wave;
    if (wave == 0 && lane_id() == 0) (void)xb_add(&bar[XB_XCNT(b.x)], 1u);
    return b;
}
__device__ __forceinline__ void xcd_barrier_complete(unsigned* bar, unsigned x, unsigned& nloc, unsigned& nx) {
    const unsigned G = gridDim.x * gridDim.y * gridDim.z;
    unsigned sum, cnt, mine, sp = 0u;
    for (;;) {
        sum = 0u; cnt = 0u; mine = 0u;
#pragma unroll
        for (unsigned j = 0; j < 16; ++j) { const unsigned c = xb_ld(&bar[XB_XCNT(j)]); sum += c; cnt += (c > 0u) ? 1u : 0u; mine = (j == x) ? c : mine; }
        if (sum == G) break;
        __builtin_amdgcn_s_sleep(1);
        if ((++sp & 255u) == 0u) { if (xb_ld(&bar[XB_TMO])) break; if (sp > XB_SPIN_CAP) { atomicAdd(&bar[XB_TMO], 1u); break; } }
    }
    nloc = mine > 0u ? mine : 1u; nx = cnt > 0u ? cnt : 1u;
}
__device__ __forceinline__ void xcd_barrier(const XcdBarrier& b) {
    asm volatile("s_waitcnt vmcnt(0)" ::: "memory");
    __syncthreads();
    if (b.wave == 0 && lane_id() == 0) {
        unsigned* bar = b.bar;
        __builtin_amdgcn_s_waitcnt(0);
        unsigned nloc = b.st[0], nx = b.st[1];
        if (nloc == 0u) { xcd_barrier_complete(bar, b.x, nloc, nx); b.st[0] = nloc; b.st[1] = nx; }
        const unsigned old = xb_add(&bar[XB_XSUB(b.x)], 1u);
        const unsigned gen = old / nloc;
        if (old + 1u == (gen + 1u) * nloc) {
            __builtin_amdgcn_fence(__ATOMIC_RELEASE, "agent");
            asm volatile("s_waitcnt vmcnt(0)" ::: "memory");
            const unsigned og = xb_add(&bar[XB_TOP], 1u);
            const unsigned tg = og / nx;
            if (og + 1u == (tg + 1u) * nx) xb_add(&bar[XB_TOPGEN], 1u);
            else XB_SPIN(xb_ld(&bar[XB_TOPGEN]) == tg, bar);
            __builtin_amdgcn_fence(__ATOMIC_ACQUIRE, "agent");
            xb_add(&bar[XB_XGEN(b.x)], 1u);
            asm volatile("s_waitcnt vmcnt(0)" ::: "memory");
        } else {
            XB_SPIN(xb_ld(&bar[XB_XGEN(b.x)]) == gen, bar);
            __builtin_amdgcn_fence(__ATOMIC_ACQUIRE, "agent");
            asm volatile("s_waitcnt vmcnt(0)" ::: "memory");
        }
    }
    __syncthreads();
}

namespace pg8 {
constexpr int BM = 256, BK = 64, HALF = 128, HTB = HALF * BK * 2, STAGE_BYTES = 8 * HTB, NXCD = 8, WGM = 8;
__host__ __device__ __forceinline__ int lds_byte(int r, int c) { const int st = (r >> 4) * 2 + (c >> 5), rr = r & 15, cc = c & 31, ob = rr * 64 + cc * 2; return st * 1024 + (ob ^ (((ob >> 9) & 1) << 5)); }
__host__ __device__ __forceinline__ void stage_rc(int b, int& R, int& C) { const int st = b / 1024, sb = b % 1024, swz = sb ^ (((sb >> 9) & 1) << 5); R = (st >> 1) * 16 + swz / 64; C = (st & 1) * 32 + (swz % 64) / 2; }
__host__ __device__ __forceinline__ int perm32(int rho) { const int n = rho >> 4, i = rho & 15; return 8 * (i >> 2) + 4 * n + (i & 3); }

struct Unit { int pm, pn, e; };
struct Gemm { const bf16_t* A; const bf16_t* Bt; int lda, K; size_t bstride; const int* rowtab; };

struct StaticOrder {
    int nM, nN, nwg, G, c, pm0; const int* tile_e;
    __device__ void init(int nM_, int nN_, int G_, int c_, int pm0_ = 0, const int* te = nullptr) { nM = nM_; nN = nN_; nwg = nM * nN; G = G_; c = c_; pm0 = pm0_; tile_e = te; }
    template <int NN> __device__ bool next_dense(int i, Unit& u) const {
        const int L = i * G + c; if (L >= nwg) return false;
        const int wgid = (L % NXCD) * ((NTOK / 256) * NN / NXCD) + L / NXCD;
        const int gid = wgid / (WGM * NN), w = wgid % (WGM * NN);
        u.pm = gid * WGM + (w % WGM); u.pn = w / WGM; u.e = 0; return true;
    }
    __device__ bool next(int i, Unit& u) const {
        const int L = i * G + c; if (L >= nwg) return false;
        int wgid = L; { const int q = nwg / NXCD, r = nwg % NXCD, xcd = wgid % NXCD, off = wgid / NXCD; wgid = (xcd < r ? xcd * (q + 1) : r * (q + 1) + (xcd - r) * q) + off; }
        const int nig = WGM * nN, gid = wgid / nig, fm = gid * WGM, gsz = (nM - fm) < WGM ? (nM - fm) : WGM;
        u.pm = pm0 + fm + ((wgid % nig) % gsz); u.pn = (wgid % nig) / gsz;
        u.e = tile_e ? __builtin_amdgcn_readfirstlane(tile_e[u.pm]) : 0;
        return true;
    }
};

template <class Epi, bool GATHER, int ESZ = 2, int NNC = 0, int WSC = 0x7f7f7f7f  >
__device__ __forceinline__ void gemm_phase(LAS unsigned char* lds, const Gemm g, const StaticOrder& S, const Epi& E, int a_row0  , int wave_id) {
    const int wid = wave_id, wr = wid >> 2, wc = wid & 3;
    const int K = g.K, nt = K * ESZ / 128, lda = g.lda;
    const unsigned hstepA = (unsigned)(HALF * lda * ESZ), hstepB = (unsigned)(HALF * K * ESZ);
    const unsigned ldsw0 = (unsigned)wid * 1024u;
    const __amdgpu_buffer_rsrc_t rsA = __builtin_amdgcn_make_buffer_rsrc((void*)g.A, (short)0, 0x7ffffff0, 0x00020000);
    const __amdgpu_buffer_rsrc_t rsB = __builtin_amdgcn_make_buffer_rsrc((void*)g.Bt, (short)0, 0x7ffffff0, 0x00020000);
#define PG8_SA(b, h) (((b) * 2 + (h)) * HTB)
#define PG8_SB(b, h) ((4 + (b) * 2 + (h)) * HTB)
#define PG8_STAGE_B(bufoff, soff) do { _Pragma("unroll") for (int _i = 0; _i < 2; ++_i) \
        __builtin_amdgcn_raw_ptr_buffer_load_lds(rsB, (LAS unsigned*)(lds + (bufoff) + ldsw + _i * 8192), 16, voffB[_i], (soff), 0, 0); } while (0)
#define PG8_STAGE_A(bufoff, abase, h, kofs, VO) do { _Pragma("unroll") for (int _i = 0; _i < 2; ++_i) { if constexpr (GATHER) \
        __builtin_amdgcn_raw_ptr_buffer_load_lds(rsA, (LAS unsigned*)(lds + (bufoff) + ldsw + _i * 8192), 16, VO[h][_i], (kofs), 0, 0); else \
        __builtin_amdgcn_raw_ptr_buffer_load_lds(rsA, (LAS unsigned*)(lds + (bufoff) + ldsw + _i * 8192), 16, voffA[_i], (abase) + (h) * hstepA + (kofs), 0, 0); } } while (0)
#define PG8_LD1(base, i) __builtin_shufflevector(*(const LAS v4i_t*)(lds + (base) + (i) * 2048), *(const LAS v4i_t*)(lds + (base) + (i) * 2048 + 1024), 0, 1, 2, 3, 4, 5, 6, 7)
#define PG8_LD1H(off, i) __builtin_shufflevector(*(const LAS v4i_t*)(ldsB + (off) + (i) * 2048), *(const LAS v4i_t*)(ldsB + (off) + (i) * 2048 + 1024), 0, 1, 2, 3, 4, 5, 6, 7)
#define PG8_LDA(dst, b, h) do { _Pragma("unroll") for (int m = 0; m < 4; ++m) dst[m] = PG8_LD1(PG8_SA(b, h) + aoff, m); } while (0)
#define PG8_LDB(dst, b, h) do { _Pragma("unroll") for (int n = 0; n < 2; ++n) dst[n] = PG8_LD1H(PG8_SB(b, h) - 65536, n); } while (0)
#define PG8_LO(x) __builtin_bit_cast(bf16x8, __builtin_shufflevector(x, x, 0, 1, 2, 3))
#define PG8_HI(x) __builtin_bit_cast(bf16x8, __builtin_shufflevector(x, x, 4, 5, 6, 7))
#define PG8_MMA(ai, bj, At, Bt) do { __builtin_amdgcn_s_setprio(1); if constexpr (ESZ == 2) { _Pragma("unroll") for (int m = 0; m < 4; ++m) _Pragma("unroll") for (int n = 0; n < 2; ++n) { \
        acc[ai][bj][m][n] = __builtin_amdgcn_mfma_f32_16x16x32_bf16(PG8_LO(Bt[n]), PG8_LO(At[m]), acc[ai][bj][m][n], 0, 0, 0); \
        acc[ai][bj][m][n] = __builtin_amdgcn_mfma_f32_16x16x32_bf16(PG8_HI(Bt[n]), PG8_HI(At[m]), acc[ai][bj][m][n], 0, 0, 0); } } \
        else { _Pragma("unroll") for (int m = 0; m < 4; ++m) _Pragma("unroll") for (int n = 0; n < 2; ++n) \
        acc[ai][bj][m][n] = __builtin_amdgcn_mfma_scale_f32_16x16x128_f8f6f4(Bt[n], At[m], acc[ai][bj][m][n], 0, 0, 0, WSC, 0, 0x7f7f7f7f); } \
        __builtin_amdgcn_s_setprio(0); } while (0)
#define PG8_WAIT_V(n) asm volatile("s_waitcnt vmcnt(" #n ")" ::: "memory")
#define PG8_WAIT_L(n) asm volatile("s_waitcnt lgkmcnt(" #n ")" ::: "memory")
#define PG8_BAR __builtin_amdgcn_s_barrier()
#define PG8_SCHED __builtin_amdgcn_sched_barrier(0)
    Unit cur, nxt; int ui = 0;
    if (!(NNC > 0 ? S.template next_dense<NNC ? NNC : 1>(0, cur) : S.next(0, cur))) return;
    f32x4 acc[2][2][4][2];
    v8i_t At[4], B0[2], B1[2];
    unsigned voC[2][2];
    LAS int* rtab = (LAS int*)(lds + RING_BYTES);
#pragma unroll
    for (int h = 0; h < 2; ++h)
#pragma unroll
        for (int i = 0; i < 2; ++i) voC[h][i] = 0;
    unsigned cA = (unsigned)((cur.pm * BM - a_row0) * lda * ESZ), cB = (unsigned)((cur.e * (int)g.bstride + cur.pn * BM * K) * ESZ);
    for (;;) {
        float zr; asm volatile("v_mov_b32 %0, 0" : "=v"(zr));
#pragma unroll
        for (int a = 0; a < 2; ++a)
#pragma unroll
            for (int b = 0; b < 2; ++b)
#pragma unroll
                for (int m = 0; m < 4; ++m)
#pragma unroll
                    for (int n = 0; n < 2; ++n) { acc[a][b][m][n] = (f32x4){zr, zr, zr, zr}; }
        const int lane = lane_id_v(), tid = wid * 64 + lane, fr = lane & 15, fq = lane >> 4;
        unsigned voffA[2], voffB[2];
#pragma unroll
        for (int i = 0; i < 2; ++i) { int R_, C_; stage_rc(tid * 16 + i * 8192, R_, C_); voffA[i] = (unsigned)(R_ * lda * ESZ + C_ * 2); voffB[i] = (unsigned)(R_ * K * ESZ + C_ * 2); }
        const int aoff = lds_byte(wr * 64 + fr, fq * 8), boff = lds_byte(wc * 32 + fr, fq * 8);
        LAS unsigned char* ldsB = lds + 65536 + boff;
        if (ui == 0) {
            const unsigned ldsw = ldsw0;
            if constexpr (GATHER) {
#pragma unroll
                for (int h = 0; h < 2; ++h)
#pragma unroll
                    for (int i = 0; i < 2; ++i) { int R_, C_; stage_rc(tid * 16 + i * 8192, R_, C_); int t = g.rowtab[cur.pm * BM + h * HALF + R_]; t = t < 0 ? 0 : t; voC[h][i] = (unsigned)t * (unsigned)(lda * ESZ) + (unsigned)C_ * 2u; }
                VM_WAIT();
            }
            PG8_STAGE_B(PG8_SB(0, 0), cB); PG8_STAGE_B(PG8_SB(0, 1), cB + hstepB); PG8_STAGE_A(PG8_SA(0, 0), cA, 0, 0u, voC); PG8_STAGE_A(PG8_SA(0, 1), cA, 1, 0u, voC);
            if (wr == 1) PG8_BAR;
            PG8_WAIT_V(2); PG8_BAR;
            PG8_STAGE_B(PG8_SB(1, 0), cB + 128u); PG8_STAGE_A(PG8_SA(1, 0), cA, 0, 128u, voC); PG8_STAGE_B(PG8_SB(1, 1), cB + hstepB + 128u);
            PG8_WAIT_V(6); PG8_BAR;
        }
        const bool has_next = NNC > 0 ? S.template next_dense<NNC ? NNC : 1>(ui + 1, nxt) : S.next(ui + 1, nxt);
        const unsigned nA = has_next ? (unsigned)((nxt.pm * BM - a_row0) * lda * ESZ) : cA, nB = has_next ? (unsigned)((nxt.e * (int)g.bstride + nxt.pn * BM * K) * ESZ) : cB;
        if constexpr (GATHER) {
            if (has_next && wid == 0) __builtin_amdgcn_global_load_lds((const unsigned*)(g.rowtab + nxt.pm * BM + lane * 4), (LAS unsigned*)(lds + RING_BYTES + ((ui + 1) & 1) * 1024), 16, 0, 0);
        }
#pragma unroll 1
        for (int t = 0; t < nt; t += 2) {
            unsigned ldsw = ldsw0; asm volatile("" : "+s"(ldsw));
            int last_i = __builtin_amdgcn_readfirstlane((t == nt - 2) ? 1 : 0); asm volatile("" : "+s"(last_i));
            const bool last = last_i != 0;
            const unsigned k1 = (unsigned)(t + 1) * 128u;
            const unsigned a2 = last ? nA : cA, k2 = last ? 0u : (unsigned)(t + 2) * 128u;
            const unsigned b2 = last ? nB : cB + (unsigned)(t + 2) * 128u;
            const unsigned b3 = b2 + 128u, k3 = k2 + 128u;
            PG8_LDB(B0, 0, 0); PG8_LDB(B1, 0, 1); PG8_SCHED; PG8_LDA(At, 0, 0); PG8_STAGE_A(PG8_SA(1, 1), cA, 1, k1, voC);
            PG8_WAIT_V(8); PG8_WAIT_L(0); PG8_BAR; PG8_MMA(0, 0, At, B0); PG8_MMA(0, 1, At, B1); PG8_BAR; PG8_SCHED;
            if constexpr (GATHER) {
                if (last && has_next) {
#pragma unroll
                    for (int h = 0; h < 2; ++h)
#pragma unroll
                        for (int i = 0; i < 2; ++i) { int R_, C_; stage_rc(tid * 16 + i * 8192, R_, C_); int tk = rtab[((ui + 1) & 1) * 256 + h * HALF + R_]; tk = tk < 0 ? 0 : tk; voC[h][i] = (unsigned)tk * (unsigned)(lda * ESZ) + (unsigned)C_ * 2u; }
                }
            }
            PG8_LDA(At, 0, 1); PG8_STAGE_B(PG8_SB(0, 0), b2); PG8_STAGE_B(PG8_SB(0, 1), b2 + hstepB);
            PG8_STAGE_A(PG8_SA(0, 0), a2, 0, k2, voC);
            PG8_WAIT_V(8); PG8_WAIT_L(0); PG8_BAR; PG8_MMA(1, 0, At, B0); PG8_MMA(1, 1, At, B1); PG8_BAR; PG8_SCHED;
            PG8_LDB(B0, 1, 0); PG8_LDB(B1, 1, 1); PG8_SCHED; PG8_LDA(At, 1, 0);
            PG8_STAGE_A(PG8_SA(0, 1), a2, 1, k2, voC);
            PG8_WAIT_V(8); PG8_WAIT_L(0); PG8_BAR; PG8_MMA(0, 0, At, B0); PG8_MMA(0, 1, At, B1); PG8_BAR; PG8_SCHED;
            PG8_LDA(At, 1, 1); PG8_STAGE_B(PG8_SB(1, 0), b3); PG8_STAGE_B(PG8_SB(1, 1), b3 + hstepB);
            PG8_STAGE_A(PG8_SA(1, 0), a2, 0, k3, voC);
            PG8_WAIT_V(8); PG8_WAIT_L(0); PG8_BAR; PG8_MMA(1, 0, At, B0); PG8_MMA(1, 1, At, B1); PG8_BAR; PG8_SCHED;
        }
        if (wr == 0) PG8_BAR;
        { const int l2 = lane_id_v(); E(acc, cur, wr, wc, l2 & 15, l2 >> 4); }
        if (!has_next) break;
        cur = nxt; cA = nA; cB = nB; ++ui;
        if (wr == 1) PG8_BAR;
    }
    PG8_WAIT_V(0);
    PG8_BAR;
#undef PG8_SA
#undef PG8_SB
#undef PG8_STAGE_A
#undef PG8_STAGE_B
#undef PG8_LD1
#undef PG8_LD1H
#undef PG8_LDA
#undef PG8_LDB
#undef PG8_LO
#undef PG8_HI
#undef PG8_MMA
#undef PG8_WAIT_V
#undef PG8_WAIT_L
#undef PG8_BAR
#undef PG8_SCHED
}


struct EpiBf16 {
    bf16_t* O; int ldc; float sc;
    __device__ __forceinline__ void operator()(const f32x4 (&acc)[2][2][4][2], const Unit& u, int wr, int wc, int fr, int fq) const {
        const int row0 = u.pm * BM + wr * 64 + fr, col0 = u.pn * BM + wc * 32 + 8 * fq;
#pragma unroll
        for (int ai = 0; ai < 2; ++ai)
#pragma unroll
            for (int m = 0; m < 4; ++m) { bf16_t* rowp = O + (size_t)(row0 + ai * HALF + m * 16) * ldc + col0;
#pragma unroll
                for (int bj = 0; bj < 2; ++bj) { const f32x4 v0 = acc[ai][bj][m][0] * sc, v1 = acc[ai][bj][m][1] * sc;
                    u32x4 w; w.x = cvt_pk_bf16(v0[0], v0[1]); w.y = cvt_pk_bf16(v0[2], v0[3]); w.z = cvt_pk_bf16(v1[0], v1[1]); w.w = cvt_pk_bf16(v1[2], v1[3]);
                    *(u32x4*)(rowp + bj * HALF) = w; } }
    }
};
struct EpiFp8 {
    unsigned char* O; int ldc;
    __device__ __forceinline__ void operator()(const f32x4 (&acc)[2][2][4][2], const Unit& u, int wr, int wc, int fr, int fq) const {
        const int row0 = u.pm * BM + wr * 64 + fr, col0 = u.pn * BM + wc * 32 + 8 * fq;
#pragma unroll
        for (int ai = 0; ai < 2; ++ai)
#pragma unroll
            for (int m = 0; m < 4; ++m) { unsigned char* rowp = O + (size_t)(row0 + ai * HALF + m * 16) * ldc + col0;
#pragma unroll
                for (int bj = 0; bj < 2; ++bj) { const f32x4 v0 = acc[ai][bj][m][0], v1 = acc[ai][bj][m][1];
                    u32x2 w; w.x = pk4_fp8(__builtin_amdgcn_fmed3f(v0[0], -448.f, 448.f), __builtin_amdgcn_fmed3f(v0[1], -448.f, 448.f), __builtin_amdgcn_fmed3f(v0[2], -448.f, 448.f), __builtin_amdgcn_fmed3f(v0[3], -448.f, 448.f));
                    w.y = pk4_fp8(__builtin_amdgcn_fmed3f(v1[0], -448.f, 448.f), __builtin_amdgcn_fmed3f(v1[1], -448.f, 448.f), __builtin_amdgcn_fmed3f(v1[2], -448.f, 448.f), __builtin_amdgcn_fmed3f(v1[3], -448.f, 448.f));
                    *(u32x2*)(rowp + bj * HALF) = w; } }
    }
};
struct EpiProj1 {
    bf16_t* O; float* SS; LAS float* part; const float* ssx;
    __device__ __forceinline__ void operator()(const f32x4 (&acc)[2][2][4][2], const Unit& u, int wr, int wc, int fr, int fq) const {
        const int row0 = u.pm * BM + wr * 64 + fr, col0 = u.pn * BM + wc * 32 + 8 * fq, wid = wr * 4 + wc;
        float rsv[8];
#pragma unroll
        for (int i = 0; i < 8; ++i) { const f32x4 x4 = *(const f32x4*)(ssx + (size_t)(row0 + (i >> 2) * HALF + (i & 3) * 16) * 4); rsv[i] = __builtin_amdgcn_rsqf(((x4[0] + x4[1]) + (x4[2] + x4[3])) * (1.f / DM) + EPS); }
#pragma unroll
        for (int ai = 0; ai < 2; ++ai)
#pragma unroll
            for (int m = 0; m < 4; ++m) { bf16_t* rowp = O + (size_t)(row0 + ai * HALF + m * 16) * L1_INP + col0;
                const float rstd = rsv[ai * 4 + m];
#pragma unroll
                for (int bj = 0; bj < 2; ++bj) { const f32x4 v0 = acc[ai][bj][m][0] * rstd, v1 = acc[ai][bj][m][1] * rstd;
                    u32x4 w; w.x = cvt_pk_bf16(v0[0], v0[1]); w.y = cvt_pk_bf16(v0[2], v0[3]); w.z = cvt_pk_bf16(v1[0], v1[1]); w.w = cvt_pk_bf16(v1[2], v1[3]);
                    *(u32x4*)(rowp + bj * HALF) = w;
                    float ss = (bf_lo(w.x) * bf_lo(w.x) + bf_hi(w.x) * bf_hi(w.x)) + (bf_lo(w.y) * bf_lo(w.y) + bf_hi(w.y) * bf_hi(w.y)) + (bf_lo(w.z) * bf_lo(w.z) + bf_hi(w.z) * bf_hi(w.z)) + (bf_lo(w.w) * bf_lo(w.w) + bf_hi(w.w) * bf_hi(w.w));
                    ss = fq_sum(ss);
                    if (fq == 0) part[((wid * 2 + bj) * 8 + ai * 4 + m) * 16 + fr] = ss; } }
        asm volatile("s_waitcnt lgkmcnt(0)\n\ts_barrier" ::: "memory");
        { const int t = wid * 64 + fq * 16 + fr, bj = t >> 8, wr2 = (t >> 7) & 1, am = (t >> 4) & 7, fr2 = t & 15;
          const LAS float* pp = part + ((wr2 * 4 * 2 + bj) * 8 + am) * 16 + fr2;
          const float ssum = (pp[0] + pp[2 * 8 * 16]) + (pp[2 * 2 * 8 * 16] + pp[3 * 2 * 8 * 16]);
          const int row = u.pm * BM + (am >> 2) * HALF + wr2 * 64 + (am & 3) * 16 + fr2, sl = u.pn * 2 + bj;
          SS[(size_t)row * 8 + sl + (sl >= 3 ? 1 : 0)] = ssum; }
    }
};
struct EpiBf16Row {
    bf16_t* O; int ldc; const float* rs; int which;
    __device__ __forceinline__ void operator()(const f32x4 (&acc)[2][2][4][2], const Unit& u, int wr, int wc, int fr, int fq) const {
        const int row0 = u.pm * BM + wr * 64 + fr;
        float scv[8];
#pragma unroll
        for (int i = 0; i < 8; ++i) { const f32x4 s4 = *(const f32x4*)(rs + (size_t)(row0 + (i >> 2) * HALF + (i & 3) * 16) * 8); scv[i] = __builtin_amdgcn_rsqf(((s4[0] + s4[1]) + s4[2]) * (1.f / CQ) + EPS); }
#pragma unroll
        for (int ai = 0; ai < 2; ++ai)
#pragma unroll
            for (int m = 0; m < 4; ++m) { const int row = row0 + ai * HALF + m * 16; const float sc = scv[ai * 4 + m]; const int b = row >> 11, t = row & (SEQ - 1);
#pragma unroll
                for (int bj = 0; bj < 2; ++bj) { const f32x4 v0 = acc[ai][bj][m][0] * sc, v1 = acc[ai][bj][m][1] * sc;
                    u32x4 w; w.x = cvt_pk_bf16(v0[0], v0[1]); w.y = cvt_pk_bf16(v0[2], v0[3]); w.z = cvt_pk_bf16(v1[0], v1[1]); w.w = cvt_pk_bf16(v1[2], v1[3]);
                    const int col = u.pn * BM + bj * HALF + wc * 32 + 8 * fq;
                    bf16_t* dst;
                    if (which == 0) { const int hd = col / 96, d = col - hd * 96; dst = O + (((size_t)b * 16 + hd) * SEQ + t) * 96 + d; }
                    else { const int hd = col >> 7, d = col & 127;
                        dst = d < 64 ? O + (size_t)row * 1024 + hd * 64 + d : O + (size_t)NTOK * 1024 + (((size_t)b * 16 + hd) * SEQ + t) * 64 + (d - 64); }
                    *(u32x4*)dst = w; } }
    }
};
template <bool RB, bool OB, bool ST = false>
struct EpiRes {
    const void* res; void* out; bool dry; float* SS; LAS float* part;
    __device__ __forceinline__ void operator()(const f32x4 (&acc)[2][2][4][2], const Unit& u, int wr, int wc, int fr, int fq) const {
        const int row0 = u.pm * BM + wr * 64 + fr, col0 = u.pn * BM + wc * 32 + 8 * fq;
        u32x4 xball_[2][4][2];
        if constexpr (RB) {
#pragma unroll
            for (int ai = 0; ai < 2; ++ai)
#pragma unroll
                for (int m = 0; m < 4; ++m)
#pragma unroll
                    for (int bj = 0; bj < 2; ++bj) xball_[ai][m][bj] = *(const u32x4*)((const bf16_t*)res + (size_t)(row0 + ai * HALF + m * 16) * DM + col0 + bj * HALF);
            __builtin_amdgcn_sched_barrier(0);
        }
#pragma unroll
        for (int ai = 0; ai < 2; ++ai) {
            u32x4 xb_[4][2]; f32x4 xf_[4][2][2];
#pragma unroll
            for (int m = 0; m < 4; ++m)
#pragma unroll
                for (int bj = 0; bj < 2; ++bj) { const size_t o = (size_t)(row0 + ai * HALF + m * 16) * DM + col0 + bj * HALF;
                    if constexpr (RB) xb_[m][bj] = xball_[ai][m][bj]; else { xf_[m][bj][0] = *(const f32x4*)((const float*)res + o); xf_[m][bj][1] = *(const f32x4*)((const float*)res + o + 4); } }
            __builtin_amdgcn_sched_barrier(0);
#pragma unroll
            for (int m = 0; m < 4; ++m) { const size_t off = (size_t)(row0 + ai * HALF + m * 16) * DM + col0; float ssr = 0.f;
#pragma unroll
                for (int bj = 0; bj < 2; ++bj) { const size_t o = off + bj * HALF;
                    f32x4 r0, r1;
                    if constexpr (RB) { const u32x4 x = xb_[m][bj]; r0 = (f32x4){bf_lo(x.x), bf_hi(x.x), bf_lo(x.y), bf_hi(x.y)}; r1 = (f32x4){bf_lo(x.z), bf_hi(x.z), bf_lo(x.w), bf_hi(x.w)}; }
                    else { r0 = xf_[m][bj][0]; r1 = xf_[m][bj][1]; }
                    r0 += acc[ai][bj][m][0]; r1 += acc[ai][bj][m][1];
                    if (!dry) {
                        if constexpr (OB) { u32x4 w; w.x = cvt_pk_bf16(r0[0], r0[1]); w.y = cvt_pk_bf16(r0[2], r0[3]); w.z = cvt_pk_bf16(r1[0], r1[1]); w.w = cvt_pk_bf16(r1[2], r1[3]); *(u32x4*)((bf16_t*)out + o) = w;
                            if constexpr (ST) ssr += (bf_lo(w.x) * bf_lo(w.x) + bf_hi(w.x) * bf_hi(w.x)) + (bf_lo(w.y) * bf_lo(w.y) + bf_hi(w.y) * bf_hi(w.y)) + (bf_lo(w.z) * bf_lo(w.z) + bf_hi(w.z) * bf_hi(w.z)) + (bf_lo(w.w) * bf_lo(w.w) + bf_hi(w.w) * bf_hi(w.w)); }
                        else { *(f32x4*)((float*)out + o) = r0; *(f32x4*)((float*)out + o + 4) = r1; } } }
                if constexpr (ST) { ssr = fq_sum(ssr); if (fq == 0) part[((wr * 4 + wc) * 8 + ai * 4 + m) * 16 + fr] = ssr; } }
        }
        if constexpr (ST) {
            asm volatile("s_waitcnt lgkmcnt(0)\n\ts_barrier" ::: "memory");
            const int t = (wr * 4 + wc) * 64 + fq * 16 + fr;
            if (t < 256) { const int wr2 = t >> 7, am = (t >> 4) & 7, fr2 = t & 15; const LAS float* pp = part + (wr2 * 4 * 8 + am) * 16 + fr2;
                const float ssum = (pp[0] + pp[8 * 16]) + (pp[2 * 8 * 16] + pp[3 * 8 * 16]);
                SS[(size_t)(u.pm * BM + (am >> 2) * HALF + wr2 * 64 + (am & 3) * 16 + fr2) * 4 + u.pn] = ssum; }
        }
    }
};
struct EpiSwiGLU {
    bf16_t* H; int ldc; int row_sub; const float* ss;
    __device__ __forceinline__ void operator()(const f32x4 (&acc)[2][2][4][2], const Unit& u, int wr, int wc, int fr, int fq) const {
        const int row0 = u.pm * BM - row_sub + wr * 64 + fr, col0 = u.pn * HALF + wc * 32 + 8 * fq;
        float rsv[8];
#pragma unroll
        for (int i = 0; i < 8; ++i) { const f32x4 s4 = *(const f32x4*)(ss + (size_t)(row0 + (i >> 2) * HALF + (i & 3) * 16) * 4); rsv[i] = __builtin_amdgcn_rsqf(((s4[0] + s4[1]) + (s4[2] + s4[3])) * (1.f / DM) + EPS); }
#pragma unroll
        for (int ai = 0; ai < 2; ++ai)
#pragma unroll
            for (int m = 0; m < 4; ++m) { bf16_t* rowp = H + (size_t)(row0 + ai * HALF + m * 16) * ldc + col0;
                const float rstd = rsv[ai * 4 + m];
                float r[8];
#pragma unroll
                for (int n = 0; n < 2; ++n)
#pragma unroll
                    for (int j = 0; j < 4; ++j) { const float gt = acc[ai][0][m][n][j] * rstd, up = acc[ai][1][m][n][j] * rstd;
                        r[n * 4 + j] = gt * __builtin_amdgcn_rcpf(1.0f + __builtin_amdgcn_exp2f(-gt * LOG2E)) * up; }
                u32x4 w; w.x = cvt_pk_bf16(r[0], r[1]); w.y = cvt_pk_bf16(r[2], r[3]); w.z = cvt_pk_bf16(r[4], r[5]); w.w = cvt_pk_bf16(r[6], r[7]);
                *(u32x4*)rowp = w; }
    }
};
struct EpiSwiGLU8 {
    unsigned char* H; int ldc; bool dry;
    __device__ __forceinline__ void operator()(const f32x4 (&acc)[2][2][4][2], const Unit& u, int wr, int wc, int fr, int fq) const {
        const int row0 = u.pm * BM + wr * 64 + fr, col0 = u.pn * HALF + wc * 32 + 8 * fq;
#pragma unroll
        for (int ai = 0; ai < 2; ++ai)
#pragma unroll
            for (int m = 0; m < 4; ++m) { unsigned char* rowp = H + (size_t)(row0 + ai * HALF + m * 16) * ldc + col0;
                float r[8];
#pragma unroll
                for (int n = 0; n < 2; ++n)
#pragma unroll
                    for (int j = 0; j < 4; ++j) { const float ga = acc[ai][0][m][n][j], ua = acc[ai][1][m][n][j];
                        const float e = __builtin_amdgcn_exp2f(-ga); const float q = __builtin_amdgcn_rcpf(__builtin_fmaf(e, LOG2E, LOG2E));
                        r[n * 4 + j] = __builtin_amdgcn_fmed3f((ga * ua) * q, -448.f, 448.f); }
                u32x2 w; w.x = pk4_fp8(r[0], r[1], r[2], r[3]); w.y = pk4_fp8(r[4], r[5], r[6], r[7]);
                if (!dry) *(u32x2*)rowp = w; }
    }
};
struct EpiQKV0 {
    bf16_t* O; const float* cosT; const float* sinT;
    const float* rs0;
    const float* g_aq; const float* g_ak; const float* g_bq; const float* g_bk;
    __device__ __forceinline__ void operator()(const f32x4 (&acc)[2][2][4][2], const Unit& u, int wr, int wc, int fr, int fq) const {
        const int hd = u.pn * 4 + wc;
        const float* g = hd < 8 ? g_aq : hd < 10 ? g_ak : hd < 12 ? nullptr : hd < 20 ? g_bq : hd < 28 ? g_bk : nullptr;
        const float qs = (hd < 8 || (hd >= 12 && hd < 20)) ? 0.125f * LOG2E : 1.0f;
        const int row0 = u.pm * BM + wr * 64 + fr;
        float r0v[8];
#pragma unroll
        for (int i = 0; i < 8; ++i) r0v[i] = rs0[row0 + (i >> 2) * HALF + (i & 3) * 16];
        if (g == nullptr) {
#pragma unroll
            for (int ai = 0; ai < 2; ++ai)
#pragma unroll
                for (int m = 0; m < 4; ++m) { const int row_ = row0 + ai * HALF + m * 16; bf16_t* rowp = O + (((size_t)(row_ >> 11) * 36 + hd) * SEQ + (row_ & (SEQ - 1))) * 64 + 8 * fq; const float r0 = r0v[ai * 4 + m];
#pragma unroll
                    for (int bj = 0; bj < 2; ++bj) { const f32x4 v0 = acc[ai][bj][m][0] * r0, v1 = acc[ai][bj][m][1] * r0;
                        u32x4 w; w.x = cvt_pk_bf16(v0[0], v0[1]); w.y = cvt_pk_bf16(v0[2], v0[3]); w.z = cvt_pk_bf16(v1[0], v1[1]); w.w = cvt_pk_bf16(v1[2], v1[3]);
                        *(u32x4*)(rowp + bj * 32) = w; } }
            return;
        }
        f32x4 gl[2], gh[2];
#pragma unroll
        for (int n = 0; n < 2; ++n) { gl[n] = *(const f32x4*)(g + 8 * fq + 4 * n); gh[n] = *(const f32x4*)(g + 32 + 8 * fq + 4 * n); }
        f32x4 ctb[2][2], stb[2][2];
#pragma unroll
        for (int n = 0; n < 2; ++n) { ctb[0][n] = *(const f32x4*)(cosT + (size_t)row0 * 32 + 8 * fq + 4 * n); stb[0][n] = *(const f32x4*)(sinT + (size_t)row0 * 32 + 8 * fq + 4 * n); }
#pragma unroll
        for (int ai = 0; ai < 2; ++ai)
#pragma unroll
            for (int m = 0; m < 4; ++m) {
                const int row = row0 + ai * HALF + m * 16, cb_ = (ai * 4 + m) & 1;
                if (ai * 4 + m < 7) { const int nr = row0 + ((ai * 4 + m + 1) >> 2) * HALF + ((ai * 4 + m + 1) & 3) * 16;
#pragma unroll
                    for (int n = 0; n < 2; ++n) { ctb[cb_ ^ 1][n] = *(const f32x4*)(cosT + (size_t)nr * 32 + 8 * fq + 4 * n); stb[cb_ ^ 1][n] = *(const f32x4*)(sinT + (size_t)nr * 32 + 8 * fq + 4 * n); } }
                __builtin_amdgcn_sched_barrier(0);
                float ss = 0.f;
#pragma unroll
                for (int bj = 0; bj < 2; ++bj)
#pragma unroll
                    for (int n = 0; n < 2; ++n) { const f32x4 x = acc[ai][bj][m][n]; ss += (x[0] * x[0] + x[1] * x[1]) + (x[2] * x[2] + x[3] * x[3]); }
                ss = fq_sum(ss);
                const float r0 = r0v[ai * 4 + m]; const float rstd = r0 * __builtin_amdgcn_rsqf(ss * (r0 * r0) * (1.0f / 64.0f) + EPS);
                float lo[8], hi[8];
#pragma unroll
                for (int n = 0; n < 2; ++n) { const f32x4 c = ctb[cb_][n], s = stb[cb_][n];
#pragma unroll
                    for (int j = 0; j < 4; ++j) { const float a = acc[ai][0][m][n][j] * rstd * gl[n][j], b = acc[ai][1][m][n][j] * rstd * gh[n][j];
                        lo[n * 4 + j] = (a * c[j] - b * s[j]) * qs; hi[n * 4 + j] = (b * c[j] + a * s[j]) * qs; } }
                bf16_t* rowp = O + (((size_t)(row >> 11) * 36 + hd) * SEQ + (row & (SEQ - 1))) * 64 + 8 * fq;
                u32x4 w; w.x = cvt_pk_bf16(lo[0], lo[1]); w.y = cvt_pk_bf16(lo[2], lo[3]); w.z = cvt_pk_bf16(lo[4], lo[5]); w.w = cvt_pk_bf16(lo[6], lo[7]);
                *(u32x4*)rowp = w;
                w.x = cvt_pk_bf16(hi[0], hi[1]); w.y = cvt_pk_bf16(hi[2], hi[3]); w.z = cvt_pk_bf16(hi[4], hi[5]); w.w = cvt_pk_bf16(hi[6], hi[7]);
                *(u32x4*)(rowp + 32) = w;
            }
    }
};
struct EpiKV1 {
    bf16_t* Ko; bf16_t* Vo; const float* rs; const bf16_t* P1; const float* cc; const float* sc; const float* gk;
    __device__ __forceinline__ void operator()(const f32x4 (&acc)[2][2][4][2], const Unit& u, int wr, int wc, int fr, int fq) const {
        const int hd = 2 * u.pn + (wc & 1);
        const int row0 = u.pm * BM + wr * 64 + fr;
        float sv[8];
#pragma unroll
        for (int i = 0; i < 8; ++i) { const f32x2 s2 = *(const f32x2*)(rs + (size_t)(row0 + (i >> 2) * HALF + (i & 3) * 16) * 8 + 4); sv[i] = __builtin_amdgcn_rsqf((s2[0] + s2[1]) * (1.f / CKV) + EPS); }
        if (wc >= 2) {
#pragma unroll
            for (int ai = 0; ai < 2; ++ai)
#pragma unroll
                for (int m = 0; m < 4; ++m) { const int row = row0 + ai * HALF + m * 16; const float s = sv[ai * 4 + m];
                    bf16_t* dst = Vo + (((size_t)(row >> 11) * 16 + hd) * SEQ + (row & (SEQ - 1))) * 64 + 8 * fq;
#pragma unroll
                    for (int bj = 0; bj < 2; ++bj) { const f32x4 v0 = acc[ai][bj][m][0] * s, v1 = acc[ai][bj][m][1] * s;
                        u32x4 w; w.x = cvt_pk_bf16(v0[0], v0[1]); w.y = cvt_pk_bf16(v0[2], v0[3]); w.z = cvt_pk_bf16(v1[0], v1[1]); w.w = cvt_pk_bf16(v1[2], v1[3]);
                        *(u32x4*)(dst + bj * 32) = w; } }
            return;
        }
        f32x4 gl[2], gh[2];
#pragma unroll
        for (int n = 0; n < 2; ++n) { gl[n] = *(const f32x4*)(gk + 8 * fq + 4 * n); gh[n] = *(const f32x4*)(gk + 32 + 8 * fq + 4 * n); }
        const f32x4 gr0 = *(const f32x4*)(gk + 64 + 4 * fq), gr1 = *(const f32x4*)(gk + 80 + 4 * fq);
#pragma unroll
        for (int ai2 = 0; ai2 < 4; ++ai2) { const int ai = ai2 >> 1, mh = ai2 & 1;
            u32x2 kr0v[2], kr1v[2]; f32x4 csv[2], snv[2];
#pragma unroll
            for (int m2 = 0; m2 < 2; ++m2) { const int row = row0 + ai * HALF + (2 * mh + m2) * 16; const bf16_t* kp = P1 + (size_t)row * L1_INP + CQ + CKV + 4 * fq;
                kr0v[m2] = *(const u32x2*)kp; kr1v[m2] = *(const u32x2*)(kp + 16); csv[m2] = *(const f32x4*)(cc + (size_t)row * 16 + 4 * fq); snv[m2] = *(const f32x4*)(sc + (size_t)row * 16 + 4 * fq); }
            __builtin_amdgcn_sched_barrier(0);
#pragma unroll
            for (int m2 = 0; m2 < 2; ++m2) { const int m = 2 * mh + m2;
                const int row = row0 + ai * HALF + m * 16; const float s = sv[ai * 4 + m];
                const u32x2 kr0 = kr0v[m2], kr1 = kr1v[m2];
                const f32x4 cs = csv[m2], sn = snv[m2];
                const f32x4 ra = (f32x4){bf_lo(kr0.x), bf_hi(kr0.x), bf_lo(kr0.y), bf_hi(kr0.y)}, rb = (f32x4){bf_lo(kr1.x), bf_hi(kr1.x), bf_lo(kr1.y), bf_hi(kr1.y)};
                float ss = (ra[0] * ra[0] + ra[1] * ra[1]) + (ra[2] * ra[2] + ra[3] * ra[3]) + (rb[0] * rb[0] + rb[1] * rb[1]) + (rb[2] * rb[2] + rb[3] * rb[3]);
#pragma unroll
                for (int bj = 0; bj < 2; ++bj)
#pragma unroll
                    for (int n = 0; n < 2; ++n) { const f32x4 x = acc[ai][bj][m][n] * s; ss += (x[0] * x[0] + x[1] * x[1]) + (x[2] * x[2] + x[3] * x[3]); }
                ss = fq_sum(ss);
                const float rstd = __builtin_amdgcn_rsqf(ss * (1.0f / 96.0f) + EPS), rl = rstd * s;
                bf16_t* dst = Ko + (((size_t)(row >> 11) * 16 + hd) * SEQ + (row & (SEQ - 1))) * 96;
                { const f32x4 a0 = acc[ai][0][m][0] * rl * gl[0], a1 = acc[ai][0][m][1] * rl * gl[1], b0 = acc[ai][1][m][0] * rl * gh[0], b1 = acc[ai][1][m][1] * rl * gh[1];
                  u32x4 w; w.x = cvt_pk_bf16(a0[0], a0[1]); w.y = cvt_pk_bf16(a0[2], a0[3]); w.z = cvt_pk_bf16(a1[0], a1[1]); w.w = cvt_pk_bf16(a1[2], a1[3]);
                  *(u32x4*)(dst + 8 * fq) = w;
                  w.x = cvt_pk_bf16(b0[0], b0[1]); w.y = cvt_pk_bf16(b0[2], b0[3]); w.z = cvt_pk_bf16(b1[0], b1[1]); w.w = cvt_pk_bf16(b1[2], b1[3]);
                  *(u32x4*)(dst + 32 + 8 * fq) = w; }
                { const f32x4 a = ra * rstd * gr0, b = rb * rstd * gr1; const f32x4 oa = a * cs - b * sn, ob = b * cs + a * sn;
                  u32x2 p; p.x = cvt_pk_bf16(oa[0], oa[1]); p.y = cvt_pk_bf16(oa[2], oa[3]); *(u32x2*)(dst + 64 + 4 * fq) = p;
                  p.x = cvt_pk_bf16(ob[0], ob[1]); p.y = cvt_pk_bf16(ob[2], ob[3]); *(u32x2*)(dst + 80 + 4 * fq) = p; }
            }
        }
    }
};
}

__device__ __forceinline__ void dma_piece(__amdgpu_buffer_rsrc_t rs, unsigned lds_dst, unsigned voff, unsigned soff) {
    asm volatile("s_mov_b32 m0, %0\n\ts_nop 0\n\tbuffer_load_dwordx4 %1, %2, %3 offen lds" :: "s"(lds_dst), "v"(voff), "s"(rs), "s"(soff) : "m0", "memory");
}
__device__ __forceinline__ int crow(int r, int hi) { return (r & 3) + 8 * (r >> 2) + 4 * hi; }
typedef short v4i16_t __attribute__((ext_vector_type(4)));
__device__ __forceinline__ s16x4 vtr(LAS unsigned char* p) { return __builtin_bit_cast(s16x4, __builtin_amdgcn_ds_read_tr16_b64_v4i16((LAS v4i16_t*)p)); }
constexpr float ATT_THR = 8.0f, ATT_FIX_BOUND = 60.0f;
template <int DQK, bool TWO, bool FIXREF>
__device__ __forceinline__ void attn_step(LAS unsigned char* kp0, LAS unsigned char* kp1, int ke0, int ke1, LAS unsigned char* vp0, LAS unsigned char* vp1, int vd0,
                                          const bf16x8 (&qf)[DQK / 16], f32x16& negm, float& mref, float& l, f32x16& o0, f32x16& o1,
                                          bool mask0, bool mask1, int qidx, int kidx0, int maxd, int hi) {
    f32x16 s0, s1;
    const f32x16 zf = (f32x16){0.f, 0.f, 0.f, 0.f, 0.f, 0.f, 0.f, 0.f, 0.f, 0.f, 0.f, 0.f, 0.f, 0.f, 0.f, 0.f};
    if constexpr (FIXREF) { s1 = zf; } else { s0 = negm; s1 = negm; }
    bf16x8 kfa[DQK / 16];
#pragma unroll
    for (int kk = 0; kk < DQK / 16; ++kk) kfa[kk] = *(const LAS bf16x8*)(kp0 + (kk >> 1) * 1024 + ((kk & 1) ? ke1 : ke0));
#pragma unroll
    for (int kk = 0; kk < DQK / 16; ++kk) s0 = __builtin_amdgcn_mfma_f32_32x32x16_bf16(kfa[kk], qf[kk], (FIXREF && kk == 0) ? zf : s0, 0, 0, 0);
    if constexpr (TWO) {
#pragma unroll
        for (int kk = 0; kk < DQK / 16; ++kk) kfa[kk] = *(const LAS bf16x8*)(kp1 + (kk >> 1) * 1024 + ((kk & 1) ? ke1 : ke0));
#pragma unroll
        for (int kk = 0; kk < DQK / 16; ++kk) s1 = __builtin_amdgcn_mfma_f32_32x32x16_bf16(kfa[kk], qf[kk], (FIXREF && kk == 0) ? zf : s1, 0, 0, 0);
    }
    if (mask0) {
#pragma unroll
        for (int r = 0; r < 16; ++r) { const int d = qidx - (kidx0 + crow(r, hi)); if (d < 0 || d > maxd) s0[r] = -INFINITY; }
    }
    if constexpr (TWO) { if (mask1) {
#pragma unroll
        for (int r = 0; r < 16; ++r) { const int d = qidx - (kidx0 + 32 + crow(r, hi)); if (d < 0 || d > maxd) s1[r] = -INFINITY; }
    } }
    if constexpr (!FIXREF) {
    float rm = fmaxf(fmaxf(s0[0], s0[1]), fmaxf(s0[2], s0[3]));
#pragma unroll
    for (int r = 4; r < 16; r += 4) rm = fmaxf(rm, fmaxf(fmaxf(s0[r], s0[r + 1]), fmaxf(s0[r + 2], s0[r + 3])));
    if constexpr (TWO) {
#pragma unroll
        for (int r = 0; r < 16; r += 4) rm = fmaxf(rm, fmaxf(fmaxf(s1[r], s1[r + 1]), fmaxf(s1[r + 2], s1[r + 3])));
    }
    rm = swap32_max(rm);
    if (__builtin_expect(__any(rm > ATT_THR), 0)) {
        const float dl = fmaxf(rm, 0.f); mref += dl;
#pragma unroll
        for (int r = 0; r < 16; ++r) { s0[r] -= dl; negm[r] -= dl; if constexpr (TWO) s1[r] -= dl; }
        const float f = __builtin_amdgcn_exp2f(-dl); l *= f;
#pragma unroll
        for (int r = 0; r < 16; ++r) { o0[r] *= f; o1[r] *= f; }
    }
    }
    float ps = 0.f;
#pragma unroll
    for (int r = 0; r < 16; ++r) { s0[r] = __builtin_amdgcn_exp2f(s0[r]); ps += s0[r]; }
    if constexpr (TWO) {
#pragma unroll
        for (int r = 0; r < 16; ++r) { s1[r] = __builtin_amdgcn_exp2f(s1[r]); ps += s1[r]; }
    }
    l += ps;
    {
        u32x4 pw0, pw1;
        pw0.x = cvt_pk_bf16(s0[0], s0[1]); pw0.y = cvt_pk_bf16(s0[2], s0[3]); pw0.z = cvt_pk_bf16(s0[4], s0[5]); pw0.w = cvt_pk_bf16(s0[6], s0[7]);
        pw1.x = cvt_pk_bf16(s0[8], s0[9]); pw1.y = cvt_pk_bf16(s0[10], s0[11]); pw1.z = cvt_pk_bf16(s0[12], s0[13]); pw1.w = cvt_pk_bf16(s0[14], s0[15]);
        const bf16x8 pf0 = __builtin_bit_cast(bf16x8, pw0), pf1 = __builtin_bit_cast(bf16x8, pw1);
#pragma unroll
        for (int ks = 0; ks < 2; ++ks) {
            const s16x4 a0 = vtr(vp0 + ks * 1024), a1 = vtr(vp0 + ks * 1024 + 512);
            const s16x4 b0 = vtr(vp0 + vd0 + ks * 1024), b1 = vtr(vp0 + vd0 + ks * 1024 + 512);
            const bf16x8 va = (bf16x8){a0[0], a0[1], a0[2], a0[3], a1[0], a1[1], a1[2], a1[3]};
            const bf16x8 vb = (bf16x8){b0[0], b0[1], b0[2], b0[3], b1[0], b1[1], b1[2], b1[3]};
            o0 = __builtin_amdgcn_mfma_f32_32x32x16_bf16(va, ks ? pf1 : pf0, o0, 0, 0, 0);
            o1 = __builtin_amdgcn_mfma_f32_32x32x16_bf16(vb, ks ? pf1 : pf0, o1, 0, 0, 0);
        }
    }
    if constexpr (TWO) {
        u32x4 pw0, pw1;
        pw0.x = cvt_pk_bf16(s1[0], s1[1]); pw0.y = cvt_pk_bf16(s1[2], s1[3]); pw0.z = cvt_pk_bf16(s1[4], s1[5]); pw0.w = cvt_pk_bf16(s1[6], s1[7]);
        pw1.x = cvt_pk_bf16(s1[8], s1[9]); pw1.y = cvt_pk_bf16(s1[10], s1[11]); pw1.z = cvt_pk_bf16(s1[12], s1[13]); pw1.w = cvt_pk_bf16(s1[14], s1[15]);
        const bf16x8 pf0 = __builtin_bit_cast(bf16x8, pw0), pf1 = __builtin_bit_cast(bf16x8, pw1);
#pragma unroll
        for (int ks = 0; ks < 2; ++ks) {
            const s16x4 a0 = vtr(vp1 + ks * 1024), a1 = vtr(vp1 + ks * 1024 + 512);
            const s16x4 b0 = vtr(vp1 + vd0 + ks * 1024), b1 = vtr(vp1 + vd0 + ks * 1024 + 512);
            const bf16x8 va = (bf16x8){a0[0], a0[1], a0[2], a0[3], a1[0], a1[1], a1[2], a1[3]};
            const bf16x8 vb = (bf16x8){b0[0], b0[1], b0[2], b0[3], b1[0], b1[1], b1[2], b1[3]};
            o0 = __builtin_amdgcn_mfma_f32_32x32x16_bf16(va, ks ? pf1 : pf0, o0, 0, 0, 0);
            o1 = __builtin_amdgcn_mfma_f32_32x32x16_bf16(vb, ks ? pf1 : pf0, o1, 0, 0, 0);
        }
    }
}

template <int DQK>
__device__ __forceinline__ void attn_step2(LAS unsigned char* kp, int ke0, int ke1, LAS unsigned char* vp, int vd0, const bf16x8 (&qa)[DQK / 16], const bf16x8 (&qb)[DQK / 16],
                                           float& la, float& lb, f32x16& oa0, f32x16& oa1, f32x16& ob0, f32x16& ob1, bool maska, bool maskb, int qidx, int kidx0, int hi) {
    f32x16 sa, sb;
    const f32x16 zf = (f32x16){0.f, 0.f, 0.f, 0.f, 0.f, 0.f, 0.f, 0.f, 0.f, 0.f, 0.f, 0.f, 0.f, 0.f, 0.f, 0.f};
    bf16x8 kf[DQK / 16];
#pragma unroll
    for (int kk = 0; kk < DQK / 16; ++kk) kf[kk] = *(const LAS bf16x8*)(kp + (kk >> 1) * 1024 + ((kk & 1) ? ke1 : ke0));
    sa = __builtin_amdgcn_mfma_f32_32x32x16_bf16(kf[0], qa[0], zf, 0, 0, 0); sb = __builtin_amdgcn_mfma_f32_32x32x16_bf16(kf[0], qb[0], zf, 0, 0, 0);
#pragma unroll
    for (int kk = 1; kk < DQK / 16; ++kk) { sa = __builtin_amdgcn_mfma_f32_32x32x16_bf16(kf[kk], qa[kk], sa, 0, 0, 0); sb = __builtin_amdgcn_mfma_f32_32x32x16_bf16(kf[kk], qb[kk], sb, 0, 0, 0); }
    if (maska) {
#pragma unroll
        for (int r = 0; r < 16; ++r) { if (qidx - (kidx0 + crow(r, hi)) < 0) sa[r] = -INFINITY; }
    }
    if (maskb) {
#pragma unroll
        for (int r = 0; r < 16; ++r) { if (qidx + 32 - (kidx0 + crow(r, hi)) < 0) sb[r] = -INFINITY; }
    }
    s16x4 vfr[2][4];
#pragma unroll
    for (int ks = 0; ks < 2; ++ks) { vfr[ks][0] = vtr(vp + ks * 1024); vfr[ks][1] = vtr(vp + ks * 1024 + 512); vfr[ks][2] = vtr(vp + vd0 + ks * 1024); vfr[ks][3] = vtr(vp + vd0 + ks * 1024 + 512); }
    __builtin_amdgcn_sched_barrier(0);
    float pa = 0.f, pb = 0.f;
#pragma unroll
    for (int r = 0; r < 16; ++r) { sa[r] = __builtin_amdgcn_exp2f(sa[r]); pa += sa[r]; sb[r] = __builtin_amdgcn_exp2f(sb[r]); pb += sb[r]; }
    la += pa; lb += pb;
    u32x4 wa0, wa1, wb0, wb1;
    wa0.x = cvt_pk_bf16(sa[0], sa[1]); wa0.y = cvt_pk_bf16(sa[2], sa[3]); wa0.z = cvt_pk_bf16(sa[4], sa[5]); wa0.w = cvt_pk_bf16(sa[6], sa[7]);
    wa1.x = cvt_pk_bf16(sa[8], sa[9]); wa1.y = cvt_pk_bf16(sa[10], sa[11]); wa1.z = cvt_pk_bf16(sa[12], sa[13]); wa1.w = cvt_pk_bf16(sa[14], sa[15]);
    wb0.x = cvt_pk_bf16(sb[0], sb[1]); wb0.y = cvt_pk_bf16(sb[2], sb[3]); wb0.z = cvt_pk_bf16(sb[4], sb[5]); wb0.w = cvt_pk_bf16(sb[6], sb[7]);
    wb1.x = cvt_pk_bf16(sb[8], sb[9]); wb1.y = cvt_pk_bf16(sb[10], sb[11]); wb1.z = cvt_pk_bf16(sb[12], sb[13]); wb1.w = cvt_pk_bf16(sb[14], sb[15]);
#pragma unroll
    for (int ks = 0; ks < 2; ++ks) {
        const s16x4 a0 = vfr[ks][0], a1 = vfr[ks][1], b0 = vfr[ks][2], b1 = vfr[ks][3];
        const bf16x8 va = (bf16x8){a0[0], a0[1], a0[2], a0[3], a1[0], a1[1], a1[2], a1[3]};
        const bf16x8 vb = (bf16x8){b0[0], b0[1], b0[2], b0[3], b1[0], b1[1], b1[2], b1[3]};
        const bf16x8 pfa = __builtin_bit_cast(bf16x8, ks ? wa1 : wa0), pfb = __builtin_bit_cast(bf16x8, ks ? wb1 : wb0);
        oa0 = __builtin_amdgcn_mfma_f32_32x32x16_bf16(va, pfa, oa0, 0, 0, 0);
        ob0 = __builtin_amdgcn_mfma_f32_32x32x16_bf16(va, pfb, ob0, 0, 0, 0);
        oa1 = __builtin_amdgcn_mfma_f32_32x32x16_bf16(vb, pfa, oa1, 0, 0, 0);
        ob1 = __builtin_amdgcn_mfma_f32_32x32x16_bf16(vb, pfb, ob1, 0, 0, 0);
    }
}

constexpr int OST_ROW = 144, OST_WAVE = 32 * OST_ROW;
__device__ __forceinline__ void ostage_write(LAS unsigned char* st, const f32x16& o0, const f32x16& o1, float sc, int r32, int hi) {
#pragma unroll
    for (int g4 = 0; g4 < 4; ++g4) { u32x2 a, b2; a.x = cvt_pk_bf16(o0[4 * g4] * sc, o0[4 * g4 + 1] * sc); a.y = cvt_pk_bf16(o0[4 * g4 + 2] * sc, o0[4 * g4 + 3] * sc);
        b2.x = cvt_pk_bf16(o1[4 * g4] * sc, o1[4 * g4 + 1] * sc); b2.y = cvt_pk_bf16(o1[4 * g4 + 2] * sc, o1[4 * g4 + 3] * sc);
        *(LAS u32x2*)(st + r32 * OST_ROW + (8 * g4 + 4 * hi) * 2) = a; *(LAS u32x2*)(st + r32 * OST_ROW + (32 + 8 * g4 + 4 * hi) * 2) = b2; }
}
struct Args {
    const float* in[28]; float* out; unsigned char* ws; int ph_lo, ph_hi; unsigned probe; int pad;
};
struct Frame {
    LAS unsigned char* lds; int wave, G, bid;
    unsigned char* ws; float* out; const float* const* in;
};
enum { I_X = 0, I_POS, I_L0_ATTN_NORM, I_L0_W_IN, I_L0_A_QN, I_L0_A_KN, I_L0_A_SINKS, I_L0_B_QN, I_L0_B_KN, I_L0_W_OUT, I_L0_FFN_NORM, I_L0_W_GATE, I_L0_W_UP, I_L0_W_DOWN,
       I_L1_ATTN_NORM, I_L1_W_IN, I_L1_QA_NORM, I_L1_W_UQ, I_L1_KVA_NORM, I_L1_W_UKV, I_L1_C_QN, I_L1_C_KN, I_L1_W_OUT, I_L1_FFN_NORM, I_L1_ROUTER, I_L1_WE_GATE, I_L1_WE_UP, I_L1_WE_DOWN };

__device__ __forceinline__ void cvt_item(const float* W, int ldw, int srccol0  , const float* kgain, bf16_t* Bt, int K, int dstrow0, bool perm, int k0, LAS float* scr, int lane) {
#pragma unroll
    for (int i = 0; i < 8; ++i) { const int kk = 8 * i + (lane >> 3), c4 = (lane & 7) * 4; f32x4 v = (f32x4){0.f, 0.f, 0.f, 0.f};
        if (srccol0 >= 0) { v = *(const f32x4*)(W + (size_t)(k0 + kk) * ldw + srccol0 + c4); if (kgain) v = v * kgain[k0 + kk]; }
        scr[kk * 33 + c4] = v[0]; scr[kk * 33 + c4 + 1] = v[1]; scr[kk * 33 + c4 + 2] = v[2]; scr[kk * 33 + c4 + 3] = v[3]; }
    LDS_WAIT(); asm volatile("" ::: "memory");
    const int c = lane & 7;
#pragma unroll
    for (int j = 0; j < 4; ++j) { const int rho = (lane >> 3) + 8 * j; const int sc = perm ? pg8::perm32(rho) : rho; const LAS float* s = scr + (8 * c) * 33 + sc;
        u32x4 o; o.x = cvt_pk_bf16(s[0 * 33], s[1 * 33]); o.y = cvt_pk_bf16(s[2 * 33], s[3 * 33]); o.z = cvt_pk_bf16(s[4 * 33], s[5 * 33]); o.w = cvt_pk_bf16(s[6 * 33], s[7 * 33]);
        *(u32x4*)(Bt + (size_t)(dstrow0 + rho) * K + k0 + 8 * c) = o; }
    LDS_WAIT(); asm volatile("" ::: "memory");
}
__device__ __forceinline__ void cvt_item8(const float* W, int ldw, int srccol0, unsigned char* Bt, int K, int dstrow0, bool perm, int k0, float scale, LAS float* scr, int lane) {
#pragma unroll
    for (int i = 0; i < 8; ++i) { const int kk = 8 * i + (lane >> 3), c4 = (lane & 7) * 4; const f32x4 v = *(const f32x4*)(W + (size_t)(k0 + kk) * ldw + srccol0 + c4) * scale;
        scr[kk * 33 + c4] = v[0]; scr[kk * 33 + c4 + 1] = v[1]; scr[kk * 33 + c4 + 2] = v[2]; scr[kk * 33 + c4 + 3] = v[3]; }
    LDS_WAIT(); asm volatile("" ::: "memory");
    const int rho = lane >> 1, kh = (lane & 1) * 32; const int sc = perm ? pg8::perm32(rho) : rho; const LAS float* s = scr + kh * 33 + sc;
    u32x4 o0, o1;
    o0.x = pk4_fp8(s[0 * 33], s[1 * 33], s[2 * 33], s[3 * 33]); o0.y = pk4_fp8(s[4 * 33], s[5 * 33], s[6 * 33], s[7 * 33]); o0.z = pk4_fp8(s[8 * 33], s[9 * 33], s[10 * 33], s[11 * 33]); o0.w = pk4_fp8(s[12 * 33], s[13 * 33], s[14 * 33], s[15 * 33]);
    o1.x = pk4_fp8(s[16 * 33], s[17 * 33], s[18 * 33], s[19 * 33]); o1.y = pk4_fp8(s[20 * 33], s[21 * 33], s[22 * 33], s[23 * 33]); o1.z = pk4_fp8(s[24 * 33], s[25 * 33], s[26 * 33], s[27 * 33]); o1.w = pk4_fp8(s[28 * 33], s[29 * 33], s[30 * 33], s[31 * 33]);
    unsigned char* dp = Bt + (size_t)(dstrow0 + rho) * K + k0 + kh;
    *(u32x4*)dp = o0; *(u32x4*)(dp + 16) = o1;
    LDS_WAIT(); asm volatile("" ::: "memory");
}
__device__ __forceinline__ void p0_weights(const Frame& F) {
    const int lane_ = lane_id_v(), tid_ = F.wave * 64 + lane_; (void)tid_;
    LAS float* scr = (LAS float*)(F.lds + F.wave * 16384);
    const int gw = F.bid * 8 + F.wave, NGW = F.G * 8;
    constexpr int N0 = (L0_IN / 32) * (DM / 64);
    constexpr int N1 = (DM / 32) * (DM / 64);
    constexpr int N2 = (2 * DFF / 32) * (DM / 64);
    constexpr int N3 = (DM / 32) * (DFF / 64);
    constexpr int N4 = (L1_INP / 32) * (DM / 64);
    constexpr int N5 = (NUQ / 32) * (CQ / 64);
    constexpr int N6 = (NUKV / 32) * (CKV / 64);
    constexpr int N7 = N1;
    constexpr int N8 = NEXP * (2 * DFE / 32) * (DM / 64);
    constexpr int N9 = NEXP * (DM / 32) * (DFE / 64);
    constexpr int NT = N0 + N1 + N2 + N3 + N4 + N5 + N6 + N7 + N8 + N9;
    unsigned char* ws = F.ws;
    for (int it = gw; it < NT; it += NGW) {
        int r = it;
        if (r < N0) { const int g = r % (L0_IN / 32), kb = r / (L0_IN / 32); const int pn = g >> 3, bj = (g >> 2) & 1, wc = g & 3;
            cvt_item(F.in[I_L0_W_IN], L0_IN, pn * 256 + wc * 64 + bj * 32, F.in[I_L0_ATTN_NORM], (bf16_t*)(ws + W0_IN), DM, g * 32, true, kb * 64, scr, lane_); continue; } r -= N0;
        if (r < N1) { const int g = r % (DM / 32), kb = r / (DM / 32);
            cvt_item(F.in[I_L0_W_OUT], DM, g * 32, nullptr, (bf16_t*)(ws + W0_OUT), DM, g * 32, true, kb * 64, scr, lane_); continue; } r -= N1;
        if (r < N2) { const int g = r % (2 * DFF / 32), kb = r / (2 * DFF / 32); const int pn = g >> 3, bj = (g >> 2) & 1, wc = g & 3;
            cvt_item(bj ? F.in[I_L0_W_UP] : F.in[I_L0_W_GATE], DFF, pn * 128 + wc * 32, F.in[I_L0_FFN_NORM], (bf16_t*)(ws + W0_GU), DM, g * 32, true, kb * 64, scr, lane_); continue; } r -= N2;
        if (r < N3) { const int g = r % (DM / 32), kb = r / (DM / 32);
            cvt_item(F.in[I_L0_W_DOWN], DM, g * 32, nullptr, (bf16_t*)(ws + W0_DN), DFF, g * 32, true, kb * 64, scr, lane_); continue; } r -= N3;
        if (r < N4) { const int g = r % (L1_INP / 32), kb = r / (L1_INP / 32);
            cvt_item(F.in[I_L1_W_IN], 672, g < 21 ? g * 32 : -1, F.in[I_L1_ATTN_NORM], (bf16_t*)(ws + W1_IN), DM, g * 32, true, kb * 64, scr, lane_); continue; } r -= N4;
        if (r < N5) { const int g = r % (NUQ / 32), kb = r / (NUQ / 32);
            cvt_item(F.in[I_L1_W_UQ], NUQ, g * 32, F.in[I_L1_QA_NORM], (bf16_t*)(ws + W1_UQ), CQ, g * 32, true, kb * 64, scr, lane_); continue; } r -= N5;
        if (r < N6) { const int g = r % (NUKV / 32), kb = r / (NUKV / 32); const int pn = g >> 3, bj = (g >> 2) & 1, wc = g & 3;
            cvt_item(F.in[I_L1_W_UKV], NUKV, (2 * pn + (wc & 1)) * 128 + (wc >> 1) * 64 + bj * 32, F.in[I_L1_KVA_NORM], (bf16_t*)(ws + W1_UKV), CKV, g * 32, true, kb * 64, scr, lane_); continue; } r -= N6;
        if (r < N7) { const int g = r % (DM / 32), kb = r / (DM / 32);
            cvt_item(F.in[I_L1_W_OUT], DM, g * 32, nullptr, (bf16_t*)(ws + W1_OUT), DM, g * 32, true, kb * 64, scr, lane_); continue; } r -= N7;
        if (r < N8) { constexpr int PE = (2 * DFE / 32) * (DM / 64); const int e = r / PE, q = r % PE; const int g = q % (2 * DFE / 32), kb = q / (2 * DFE / 32); const int pn = g >> 3, bj = (g >> 2) & 1, wc = g & 3;
            cvt_item8((bj ? F.in[I_L1_WE_UP] : F.in[I_L1_WE_GATE]) + (size_t)e * DM * DFE, DFE, pn * 128 + wc * 32, (unsigned char*)(ws + WE_GU) + (size_t)e * 2 * DFE * DM, DM, g * 32, true, kb * 64, bj ? WGU_SCALE : WGU_SCALE * LOG2E, scr, lane_); continue; } r -= N8;
        { constexpr int PE = (DM / 32) * (DFE / 64); const int e = r / PE, q = r % PE; const int g = q % (DM / 32), kb = q / (DM / 32);
            cvt_item8(F.in[I_L1_WE_DOWN] + (size_t)e * DFE * DM, DM, g * 32, (unsigned char*)(ws + WE_DN) + (size_t)e * DM * DFE, DFE, g * 32, true, kb * 64, WDN_SCALE, scr, lane_); }
    }
}
__device__ __forceinline__ void p0_rope(const Frame& F) {
    const int lane_ = lane_id_v(), tid_ = F.wave * 64 + lane_; (void)tid_;
    const int* pos = (const int*)F.in[I_POS];
    float* ch = (float*)(F.ws + WS_ROPEH); float* sh = ch + (size_t)NTOK * 32;
    float* cc = (float*)(F.ws + WS_ROPEC); float* sc = cc + (size_t)NTOK * 16;
    const size_t stride = (size_t)F.G * 512;
    const int f = tid_ & 31;
    const float inv = powf(10000.0f, -(float)(2 * f) / 64.0f), inv2 = powf(10000.0f, -(float)(2 * (f & 15)) / 32.0f);
    for (size_t i = (size_t)F.bid * 512 + tid_; i < (size_t)NTOK * 32; i += stride) {
        const int t = (int)(i >> 5); const float p = (float)pos[t];
        float s, c; sincosf(p * inv, &s, &c); ch[i] = c; sh[i] = s;
        if (f < 16) { sincosf(p * inv2, &s, &c); cc[(size_t)t * 16 + f] = c; sc[(size_t)t * 16 + f] = s; }
    }
}
__device__ __forceinline__ void x_rows(const Frame& F, const float* src, bf16_t* dst, float* rs0) {
    const int lane_ = lane_id_v();
    const int gw = F.bid * 8 + F.wave, NGW = F.G * 8;
    for (int m = gw * 4; m < NTOK; m += NGW * 4) {
        f32x4 v[4][4]; float s[4];
#pragma unroll
        for (int r = 0; r < 4; ++r) { const f32x4* xr = (const f32x4*)(src + (size_t)(m + r) * DM) + lane_;
#pragma unroll
            for (int j = 0; j < 4; ++j) v[r][j] = xr[64 * j]; }
#pragma unroll
        for (int r = 0; r < 4; ++r) { s[r] = 0.f;
#pragma unroll
            for (int j = 0; j < 4; ++j) s[r] += (v[r][j].x * v[r][j].x + v[r][j].y * v[r][j].y) + (v[r][j].z * v[r][j].z + v[r][j].w * v[r][j].w); }
#pragma unroll
        for (int r = 0; r < 4; ++r) {
            const float rstd = __builtin_amdgcn_rsqf(wave_sum(s[r]) * (1.f / DM) + EPS);
            if (lane_ == 0) rs0[m + r] = rstd;
            u32x2* o8 = (u32x2*)(dst + (size_t)(m + r) * DM) + lane_;
#pragma unroll
            for (int j = 0; j < 4; ++j) { u32x2 w; w.x = cvt_pk_bf16(v[r][j].x, v[r][j].y); w.y = cvt_pk_bf16(v[r][j].z, v[r][j].w); o8[64 * j] = w; }
        }
    }
}

constexpr int BK_ROWS = 384, BK_VOFF = BK_ROWS * 128, BK_VD0 = BK_ROWS * 64;
struct BandItem { int b, qcol, kcol, vcol, dil, cls0, cls1, tq0, tq1, maxd, mode  , outcol, pidx, head; float sink; bool has_sink, split_rows; };
template <bool FIXREF>
__device__ __forceinline__ void band_item(const Frame& F, const BandItem it) {
    const int lane_ = lane_id_v();
    const bf16_t* P = (const bf16_t*)(F.ws + WS_PROJ0);
    LAS unsigned char* lds = F.lds;
    const int lane = lane_, w = F.wave, hq = w >> 2, wq = w & 3, hi = lane >> 5, r32 = lane & 31;
    const size_t tokbase = (size_t)it.b * SEQ;
    {
        const __amdgpu_buffer_rsrc_t rsP = __builtin_amdgcn_make_buffer_rsrc((void*)(P + tokbase * L0_IN), (short)0, SEQ * L0_IN * 2, 0x00020000);
        const int k16 = lane >> 2, pc = lane & 3;
        const unsigned vok = (unsigned)(k16 * it.dil * 128 + (pc ^ ((k16 >> 2) & 3)) * 16), vov = (unsigned)(k16 * it.dil * 128 + pc * 16);
#pragma unroll 1
        for (int i = 0; i < 12; ++i) {
            const int p = w + 8 * i; const bool isv = p >= 48; const int j = isv ? p - 48 : p;
            const int kg = isv ? j % 24 : j >> 1, sub = isv ? j / 24 : j & 1;
            const int R0 = kg * 16; const bool second = it.split_rows && R0 >= 256;
            const int kidx = second ? R0 - 256 : it.tq0 - 128 + R0; const int cls = second ? it.cls1 : it.cls0;
            if (kidx >= 0 && kidx < SEQ / it.dil) {
                const unsigned so = (unsigned)((((isv ? it.vcol : it.kcol) >> 6) * SEQ + cls + it.dil * kidx) * 128 + sub * 64);
                dma_piece(rsP, (unsigned)(uintptr_t)lds + (unsigned)(isv ? BK_VOFF + j * 1024 : p * 1024), isv ? vov : vok, so);
            }
        }
    }
    const int tq = hq ? it.tq1 : it.tq0, cls = hq ? it.cls1 : it.cls0;
    const int qidx0 = tq + 32 * wq, qidx = qidx0 + r32;
    const size_t qtok = tokbase + cls + (size_t)it.dil * qidx;
    bf16x8 qf[4];
#pragma unroll
    for (int kk = 0; kk < 4; ++kk) qf[kk] = *(const bf16x8*)(P + (((size_t)it.b * 36 + (it.qcol >> 6)) * SEQ + cls + (size_t)it.dil * qidx) * 64 + 16 * kk + 8 * hi);
    float m = it.has_sink ? it.sink : 0.f, l = (it.has_sink && hi == 0) ? 1.f : 0.f;
    f32x16 o0, o1, negm;
#pragma unroll
    for (int r = 0; r < 16; ++r) { o0[r] = 0.f; o1[r] = 0.f; negm[r] = -m; }
    asm volatile("s_waitcnt vmcnt(0) lgkmcnt(0)\n\ts_barrier" ::: "memory");
    {
        const int vlane = (4 * hi + ((lane & 15) >> 2)) * 64 + ((lane >> 4) & 1) * 32 + (lane & 3) * 8;
        const int ksw = (r32 >> 2) & 3, ke0 = ((hi) ^ ksw) * 16, ke1 = ((2 + hi) ^ ksw) * 16;
#define BK_KP(kb) (lds + (8 * hq + 2 * (kb) + (r32 >> 4)) * 2048 + (r32 & 15) * 64)
#define BK_VP(kb) (lds + BK_VOFF + (128 * hq + 32 * (kb)) * 64 + vlane)
        const int kx0 = tq - 128 + 32 * wq;
        if (kx0 >= 0) {
            attn_step<64, true, FIXREF>(BK_KP(wq), BK_KP(wq + 1), ke0, ke1, BK_VP(wq), BK_VP(wq + 1), BK_VD0, qf, negm, m, l, o0, o1, true, false, qidx, kx0, it.maxd, hi);
            attn_step<64, true, FIXREF>(BK_KP(wq + 2), BK_KP(wq + 3), ke0, ke1, BK_VP(wq + 2), BK_VP(wq + 3), BK_VD0, qf, negm, m, l, o0, o1, false, false, qidx, kx0 + 64, it.maxd, hi);
            attn_step<64, false, FIXREF>(BK_KP(wq + 4), BK_KP(wq + 4), ke0, ke1, BK_VP(wq + 4), BK_VP(wq + 4), BK_VD0, qf, negm, m, l, o0, o1, true, false, qidx, kx0 + 128, it.maxd, hi);
        } else {
#pragma unroll 1
            for (int kb = 4; kb < wq + 4; ++kb) attn_step<64, false, FIXREF>(BK_KP(kb), BK_KP(kb), ke0, ke1, BK_VP(kb), BK_VP(kb), BK_VD0, qf, negm, m, l, o0, o1, false, false, qidx, tq - 128 + 32 * kb, it.maxd, hi);
            attn_step<64, false, FIXREF>(BK_KP(wq + 4), BK_KP(wq + 4), ke0, ke1, BK_VP(wq + 4), BK_VP(wq + 4), BK_VD0, qf, negm, m, l, o0, o1, true, false, qidx, kx0 + 128, it.maxd, hi);
        }
#undef BK_KP
#undef BK_VP
    }
    l = swap32_sum(l);
    const float inv = 1.0f / l;
    const float lse = m + __builtin_amdgcn_logf(l);
    LAS unsigned char* st = lds + 98304 + w * OST_WAVE;
    LAS float* wst = (LAS float*)(lds + 98304 + 8 * OST_WAVE) + w * 128;
    const int srow = lane >> 3, sch = lane & 7;
    if (it.mode != 2) {
        ostage_write(st, o0, o1, inv, r32, hi);
        asm volatile("s_waitcnt lgkmcnt(0)" ::: "memory");
        bf16_t* obase = it.mode == 0 ? (bf16_t*)(F.ws + WS_MIX) + it.outcol : (bf16_t*)(F.ws + WS_PART) + (size_t)it.pidx * NTOK * 512 + it.head * 64;
        const int opitch = it.mode == 0 ? DM : 512;
#pragma unroll
        for (int i = 0; i < 4; ++i) { const int row = 8 * i + srow; const u32x4 v = *(const LAS u32x4*)(st + row * OST_ROW + sch * 16);
            *(u32x4*)(obase + (tokbase + cls + (size_t)it.dil * (qidx0 + row)) * opitch + sch * 8) = v; }
        if (it.mode == 1 && hi == 0) ((float*)(F.ws + WS_LSE))[(size_t)it.pidx * NTOK * 8 + qtok * 8 + it.head] = lse;
    } else {
        const float* lsep = (const float*)(F.ws + WS_LSE);
        const float l1 = lsep[qtok * 8 + it.head], l2 = lsep[(size_t)NTOK * 8 + qtok * 8 + it.head];
        const float M = fmaxf(fmaxf(l1, l2), lse);
        float w0 = __builtin_amdgcn_exp2f(lse - M), w1 = __builtin_amdgcn_exp2f(l1 - M), w2 = __builtin_amdgcn_exp2f(l2 - M);
        const float wn = 1.0f / (w0 + w1 + w2); w0 *= wn; w1 *= wn; w2 *= wn;
        ostage_write(st, o0, o1, inv * w0, r32, hi);
        if (hi == 0) { wst[r32 * 4 + 1] = w1; wst[r32 * 4 + 2] = w2; }
        asm volatile("s_waitcnt lgkmcnt(0)" ::: "memory");
        const bf16_t* p1b = (const bf16_t*)(F.ws + WS_PART) + it.head * 64; const bf16_t* p2b = p1b + (size_t)NTOK * 512;
        bf16_t* obase = (bf16_t*)(F.ws + WS_MIX) + it.outcol;
#pragma unroll
        for (int i = 0; i < 4; ++i) { const int row = 8 * i + srow; const size_t tk = tokbase + cls + (size_t)it.dil * (qidx0 + row);
            const u32x4 a = *(const LAS u32x4*)(st + row * OST_ROW + sch * 16); const u32x4 x1 = *(const u32x4*)(p1b + tk * 512 + sch * 8), x2 = *(const u32x4*)(p2b + tk * 512 + sch * 8);
            const float q1 = wst[row * 4 + 1], q2 = wst[row * 4 + 2];
            u32x4 o;
            o.x = cvt_pk_bf16(bf_lo(a.x) + bf_lo(x1.x) * q1 + bf_lo(x2.x) * q2, bf_hi(a.x) + bf_hi(x1.x) * q1 + bf_hi(x2.x) * q2);
            o.y = cvt_pk_bf16(bf_lo(a.y) + bf_lo(x1.y) * q1 + bf_lo(x2.y) * q2, bf_hi(a.y) + bf_hi(x1.y) * q1 + bf_hi(x2.y) * q2);
            o.z = cvt_pk_bf16(bf_lo(a.z) + bf_lo(x1.z) * q1 + bf_lo(x2.z) * q2, bf_hi(a.z) + bf_hi(x1.z) * q1 + bf_hi(x2.z) * q2);
            o.w = cvt_pk_bf16(bf_lo(a.w) + bf_lo(x1.w) * q1 + bf_lo(x2.w) * q2, bf_hi(a.w) + bf_hi(x1.w) * q1 + bf_hi(x2.w) * q2);
            *(u32x4*)(obase + tk * DM + sch * 8) = o; }
    }
    __syncthreads();
}
__device__ __forceinline__ void band_phase(const Frame& F, int which  ) {
    const float* sinks = F.in[I_L0_A_SINKS];
    float gm[4] = {0.f, 0.f, 0.f, 0.f}, smax = 0.f;
    for (int i = 0; i < 64; ++i) { gm[0] = fmaxf(gm[0], fabsf(F.in[I_L0_A_QN][i])); gm[1] = fmaxf(gm[1], fabsf(F.in[I_L0_A_KN][i])); gm[2] = fmaxf(gm[2], fabsf(F.in[I_L0_B_QN][i])); gm[3] = fmaxf(gm[3], fabsf(F.in[I_L0_B_KN][i])); }
    for (int i = 0; i < 8; ++i) smax = fmaxf(smax, fabsf(sinks[i]));
    const bool fix = fmaxf(fmaxf(gm[0] * gm[1], gm[2] * gm[3]) * 8.0f, smax) * LOG2E < ATT_FIX_BOUND;
    const int nitems = which == 0 ? 6144 : 2048;
    for (int idx = F.bid; idx < nitems; idx += F.G) {
        BandItem it;
        const int ty = which == 0 ? idx / 2048 : 3, r = idx % 2048;
        it.b = r >> 6; const int h = (r >> 3) & 7, jp = r & 7;
        it.head = h; it.split_rows = false; it.has_sink = false; it.sink = 0.f; it.pidx = 0;
        if (ty == 0) { it.qcol = 64 * h; it.kcol = 512 + 64 * (h >> 2); it.vcol = 640 + 64 * (h >> 2); it.dil = 1; it.cls0 = it.cls1 = 0; it.tq0 = 256 * jp; it.tq1 = it.tq0 + 128; it.maxd = 127; it.mode = 0; it.outcol = 64 * h;
            it.has_sink = true; it.sink = sinks[h] * LOG2E; }
        else { it.qcol = 768 + 64 * h; it.kcol = 1280 + 64 * h; it.vcol = 1792 + 64 * h; it.maxd = 128; it.outcol = 512 + 64 * h;
            if (ty == 1) { it.dil = 1; it.cls0 = it.cls1 = 0; it.tq0 = 256 * jp; it.tq1 = it.tq0 + 128; it.mode = 1; it.pidx = 0; }
            else if (ty == 2) { it.dil = 4; it.cls0 = it.cls1 = jp >> 1; it.tq0 = 256 * (jp & 1); it.tq1 = it.tq0 + 128; it.mode = 1; it.pidx = 1; }
            else { it.dil = 16; it.cls0 = 2 * jp; it.cls1 = 2 * jp + 1; it.tq0 = 0; it.tq1 = 0; it.mode = 2; it.split_rows = true; } }
        if (fix) band_item<true>(F, it); else band_item<false>(F, it);
    }
}

constexpr int ML_KB = 12288, ML_VB = 8192, ML_STAGE = ML_KB + ML_VB;
__device__ __forceinline__ void mla_q_prep(bf16x8 (&q)[6], const float* gq, const float* cc, const float* sc, size_t t, int hi) {
    float ss = 0.f;
#pragma unroll
    for (int kk = 0; kk < 6; ++kk) { const u32x4 x = __builtin_bit_cast(u32x4, q[kk]);
        ss += bf_lo(x.x) * bf_lo(x.x) + bf_hi(x.x) * bf_hi(x.x) + bf_lo(x.y) * bf_lo(x.y) + bf_hi(x.y) * bf_hi(x.y) + bf_lo(x.z) * bf_lo(x.z) + bf_hi(x.z) * bf_hi(x.z) + bf_lo(x.w) * bf_lo(x.w) + bf_hi(x.w) * bf_hi(x.w); }
    const float rsd = __builtin_amdgcn_rsqf(swap32_sum(ss) * (1.f / 96.f) + EPS) * (0.10206207261596577f * LOG2E);
    float va[8], vb[8];
#pragma unroll
    for (int kk = 0; kk < 6; ++kk) { const u32x4 x = __builtin_bit_cast(u32x4, q[kk]);
        const f32x4 g0 = *(const f32x4*)(gq + 16 * kk + 8 * hi) * rsd, g1 = *(const f32x4*)(gq + 16 * kk + 8 * hi + 4) * rsd;
        float v[8] = {bf_lo(x.x) * g0[0], bf_hi(x.x) * g0[1], bf_lo(x.y) * g0[2], bf_hi(x.y) * g0[3], bf_lo(x.z) * g1[0], bf_hi(x.z) * g1[1], bf_lo(x.w) * g1[2], bf_hi(x.w) * g1[3]};
        if (kk < 4) { u32x4 o; o.x = cvt_pk_bf16(v[0], v[1]); o.y = cvt_pk_bf16(v[2], v[3]); o.z = cvt_pk_bf16(v[4], v[5]); o.w = cvt_pk_bf16(v[6], v[7]); q[kk] = __builtin_bit_cast(bf16x8, o); }
        else {
#pragma unroll
            for (int j = 0; j < 8; ++j) { if (kk == 4) va[j] = v[j]; else vb[j] = v[j]; } } }
    const f32x4 c0 = *(const f32x4*)(cc + t * 16 + 8 * hi), c1 = *(const f32x4*)(cc + t * 16 + 8 * hi + 4), s0 = *(const f32x4*)(sc + t * 16 + 8 * hi), s1 = *(const f32x4*)(sc + t * 16 + 8 * hi + 4);
    float ra[8], rb[8];
#pragma unroll
    for (int j = 0; j < 8; ++j) { const float c = j < 4 ? c0[j & 3] : c1[j & 3], s = j < 4 ? s0[j & 3] : s1[j & 3]; ra[j] = va[j] * c - vb[j] * s; rb[j] = vb[j] * c + va[j] * s; }
    { u32x4 o; o.x = cvt_pk_bf16(ra[0], ra[1]); o.y = cvt_pk_bf16(ra[2], ra[3]); o.z = cvt_pk_bf16(ra[4], ra[5]); o.w = cvt_pk_bf16(ra[6], ra[7]); q[4] = __builtin_bit_cast(bf16x8, o);
      o.x = cvt_pk_bf16(rb[0], rb[1]); o.y = cvt_pk_bf16(rb[2], rb[3]); o.z = cvt_pk_bf16(rb[4], rb[5]); o.w = cvt_pk_bf16(rb[6], rb[7]); q[5] = __builtin_bit_cast(bf16x8, o); }
}
template <bool FIXREF>
__device__ __forceinline__ void mla_unit(const Frame& F, int b, int h, int qb) {
    const int lane_ = lane_id_v();
    const bf16_t* Q = (const bf16_t*)(F.ws + WS_Q); const bf16_t* Kt = (const bf16_t*)(F.ws + WS_K); const bf16_t* V = (const bf16_t*)(F.ws + WS_KV);
    LAS unsigned char* lds = F.lds;
    const int lane = lane_, w = F.wave, hi = lane >> 5, r32 = lane & 31;
    const size_t tokbase = (size_t)b * SEQ;
    const int q0 = qb * 256, qidx0 = q0 + 32 * w, qidx = qidx0 + r32;
    const int NT = 4 * (qb + 1);
    const size_t hbase = ((size_t)b * 16 + h) * SEQ;
    const __amdgpu_buffer_rsrc_t rsK = __builtin_amdgcn_make_buffer_rsrc((void*)(Kt + hbase * 96), (short)0, SEQ * 96 * 2, 0x00020000);
    const __amdgpu_buffer_rsrc_t rsV = __builtin_amdgcn_make_buffer_rsrc((void*)(V + hbase * 64), (short)0, SEQ * 64 * 2, 0x00020000);
    const int k16 = lane >> 2, pc = lane & 3, swz = pc ^ ((k16 >> 2) & 3);
    unsigned vo0, vo1, vo2;
    { const int kg = w / 3, cg = w % 3; vo0 = (unsigned)((kg * 16 + k16) * 192 + (cg * 4 + swz) * 16); }
    if (w < 4) { const int id = w + 8, kg = id / 3, cg = id % 3; vo1 = (unsigned)((kg * 16 + k16) * 192 + (cg * 4 + swz) * 16);
                 const int j = w + 4, d0 = j >> 2, kgv = j & 3; vo2 = (unsigned)((kgv * 16 + k16) * 128 + (d0 * 4 + pc) * 16); }
    else { const int j = w - 4, d0 = j >> 2, kgv = j & 3; vo1 = (unsigned)((kgv * 16 + k16) * 128 + (d0 * 4 + pc) * 16); vo2 = 0; }
    const unsigned lds0 = (unsigned)(uintptr_t)lds;
#define ML_DMA(t, st) do { const unsigned so_k = (unsigned)((t) * 64 * 192), so_v = (unsigned)((t) * 64 * 128); \
        dma_piece(rsK, lds0 + (st) + w * 1024, vo0, so_k); \
        if (w < 4) { dma_piece(rsK, lds0 + (st) + (w + 8) * 1024, vo1, so_k); dma_piece(rsV, lds0 + (st) + ML_KB + (w + 4) * 1024, vo2, so_v); } \
        else { dma_piece(rsV, lds0 + (st) + ML_KB + (w - 4) * 1024, vo1, so_v); } } while (0)
    ML_DMA(0, 0);
    bf16x8 qf[6];
#pragma unroll
    for (int kk = 0; kk < 6; ++kk) qf[kk] = *(const bf16x8*)(Q + (hbase + qidx) * 96 + 16 * kk + 8 * hi);
    mla_q_prep(qf, F.in[I_L1_C_QN], (const float*)(F.ws + WS_ROPEC), (const float*)(F.ws + WS_ROPEC) + (size_t)NTOK * 16, tokbase + qidx, hi);
    float m = 0.f, l = 0.f; f32x16 o0, o1, negm;
#pragma unroll
    for (int r = 0; r < 16; ++r) { o0[r] = 0.f; o1[r] = 0.f; negm[r] = 0.f; }
    const int vlane = (4 * hi + ((lane & 15) >> 2)) * 64 + ((lane >> 4) & 1) * 32 + (lane & 3) * 8;
    const int klane = (r32 >> 4) * 3072 + (r32 & 15) * 64, ksw = (r32 >> 2) & 3, ke0 = ((hi) ^ ksw) * 16, ke1 = ((2 + hi) ^ ksw) * 16;
    asm volatile("s_waitcnt vmcnt(0) lgkmcnt(0)\n\ts_barrier" ::: "memory");
#define ML_TILE(t, CUR, NXT) do { \
        if ((t) + 1 < NT) ML_DMA((t) + 1, NXT); \
        const int kidx0 = 64 * (t); \
        LAS unsigned char* kp0 = lds + (CUR) + klane; LAS unsigned char* kp1 = kp0 + 6144; \
        LAS unsigned char* vp0 = lds + (CUR) + ML_KB + vlane; LAS unsigned char* vp1 = vp0 + 32 * 64; \
        if (kidx0 <= qidx0 + 31) \
            attn_step<96, true, FIXREF>(kp0, kp1, ke0, ke1, vp0, vp1, 4096, qf, negm, m, l, o0, o1, kidx0 + 31 > qidx0, kidx0 + 63 > qidx0, qidx, kidx0, 1 << 30, hi); \
        asm volatile("s_waitcnt vmcnt(0) lgkmcnt(0)\n\ts_barrier" ::: "memory"); } while (0)
#pragma unroll 1
    for (int t = 0; t < NT; t += 2) {
        ML_TILE(t, 0, ML_STAGE);
        ML_TILE(t + 1, ML_STAGE, 0);
    }
#undef ML_TILE
#undef ML_DMA
    l = swap32_sum(l);
    const float inv = 1.0f / l;
    { LAS unsigned char* st = lds + 2 * ML_STAGE + w * OST_WAVE;
      ostage_write(st, o0, o1, inv, r32, hi);
      asm volatile("s_waitcnt lgkmcnt(0)" ::: "memory");
      bf16_t* obase = (bf16_t*)(F.ws + WS_ATT) + (tokbase + qidx0) * DM + h * 64;
#pragma unroll
      for (int i = 0; i < 4; ++i) { const int row = 8 * i + (lane >> 3); *(u32x4*)(obase + (size_t)row * DM + (lane & 7) * 8) = *(const LAS u32x4*)(st + row * OST_ROW + (lane & 7) * 16); } }
}
__device__ __forceinline__ void mla_unit2(const Frame& F, int b, int h, int qb  ) {
    const int lane_ = lane_id_v();
    const bf16_t* Q = (const bf16_t*)(F.ws + WS_Q); const bf16_t* Kt = (const bf16_t*)(F.ws + WS_K); const bf16_t* V = (const bf16_t*)(F.ws + WS_KV);
    LAS unsigned char* lds = F.lds;
    const int lane = lane_, w = F.wave, hi = lane >> 5, r32 = lane & 31;
    const size_t tokbase = (size_t)b * SEQ;
    const int qidx0 = qb * 512 + 64 * w, qidx = qidx0 + r32;
    const int NT = 8 * (qb + 1);
    const size_t hbase = ((size_t)b * 16 + h) * SEQ;
    const __amdgpu_buffer_rsrc_t rsK = __builtin_amdgcn_make_buffer_rsrc((void*)(Kt + hbase * 96), (short)0, SEQ * 96 * 2, 0x00020000);
    const __amdgpu_buffer_rsrc_t rsV = __builtin_amdgcn_make_buffer_rsrc((void*)(V + hbase * 64), (short)0, SEQ * 64 * 2, 0x00020000);
    const int k16 = lane >> 2, pc = lane & 3, swz = pc ^ ((k16 >> 2) & 3);
    unsigned vo0, vo1, vo2;
    { const int kg = w / 3, cg = w % 3; vo0 = (unsigned)((kg * 16 + k16) * 192 + (cg * 4 + swz) * 16); }
    if (w < 4) { const int id = w + 8, kg = id / 3, cg = id % 3; vo1 = (unsigned)((kg * 16 + k16) * 192 + (cg * 4 + swz) * 16);
                 const int j = w + 4, d0 = j >> 2, kgv = j & 3; vo2 = (unsigned)((kgv * 16 + k16) * 128 + (d0 * 4 + pc) * 16); }
    else { const int j = w - 4, d0 = j >> 2, kgv = j & 3; vo1 = (unsigned)((kgv * 16 + k16) * 128 + (d0 * 4 + pc) * 16); vo2 = 0; }
    const unsigned lds0 = (unsigned)(uintptr_t)lds;
#define ML_DMA(t, st) do { const unsigned so_k = (unsigned)((t) * 64 * 192), so_v = (unsigned)((t) * 64 * 128); \
        dma_piece(rsK, lds0 + (st) + w * 1024, vo0, so_k); \
        if (w < 4) { dma_piece(rsK, lds0 + (st) + (w + 8) * 1024, vo1, so_k); dma_piece(rsV, lds0 + (st) + ML_KB + (w + 4) * 1024, vo2, so_v); } \
        else { dma_piece(rsV, lds0 + (st) + ML_KB + (w - 4) * 1024, vo1, so_v); } } while (0)
    ML_DMA(0, 0);
    bf16x8 qa[6], qb2[6];
    { const __amdgpu_buffer_rsrc_t rsQ = __builtin_amdgcn_make_buffer_rsrc((void*)(Q + hbase * 96), (short)0, SEQ * 96 * 2, 0x00020000);
      const unsigned qo = (unsigned)(qidx * 192 + hi * 16);
#pragma unroll
      for (int kk = 0; kk < 6; ++kk) { qa[kk] = __builtin_bit_cast(bf16x8, __builtin_amdgcn_raw_buffer_load_b128(rsQ, qo + kk * 32, 0, 0)); qb2[kk] = __builtin_bit_cast(bf16x8, __builtin_amdgcn_raw_buffer_load_b128(rsQ, qo + 32 * 192 + kk * 32, 0, 0)); } }
    { const float* cc_ = (const float*)(F.ws + WS_ROPEC); mla_q_prep(qa, F.in[I_L1_C_QN], cc_, cc_ + (size_t)NTOK * 16, tokbase + qidx, hi); mla_q_prep(qb2, F.in[I_L1_C_QN], cc_, cc_ + (size_t)NTOK * 16, tokbase + qidx + 32, hi); }
    float la = 0.f, lb = 0.f; f32x16 oa0, oa1, ob0, ob1;
#pragma unroll
    for (int r = 0; r < 16; ++r) { oa0[r] = 0.f; oa1[r] = 0.f; ob0[r] = 0.f; ob1[r] = 0.f; }
    const int vlane = (4 * hi + ((lane & 15) >> 2)) * 64 + ((lane >> 4) & 1) * 32 + (lane & 3) * 8;
    const int klane = (r32 >> 4) * 3072 + (r32 & 15) * 64, ksw = (r32 >> 2) & 3, ke0 = ((hi) ^ ksw) * 16, ke1 = ((2 + hi) ^ ksw) * 16;
    asm volatile("s_waitcnt vmcnt(0) lgkmcnt(0)\n\ts_barrier" ::: "memory");
#define ML_TILE(t, CUR, NXT) do { \
        if ((t) + 1 < NT) ML_DMA((t) + 1, NXT); \
        const int kidx0 = 64 * (t); \
        if (kidx0 <= qidx0 + 63) { \
            attn_step2<96>(lds + (CUR) + klane, ke0, ke1, lds + (CUR) + ML_KB + vlane, 4096, qa, qb2, la, lb, oa0, oa1, ob0, ob1, kidx0 + 31 > qidx0, kidx0 + 31 > qidx0 + 32, qidx, kidx0, hi); \
            attn_step2<96>(lds + (CUR) + klane + 6144, ke0, ke1, lds + (CUR) + ML_KB + vlane + 32 * 64, 4096, qa, qb2, la, lb, oa0, oa1, ob0, ob1, kidx0 + 63 > qidx0, kidx0 + 63 > qidx0 + 32, qidx, kidx0 + 32, hi); } \
        asm volatile("s_waitcnt vmcnt(0) lgkmcnt(0)\n\ts_barrier" ::: "memory"); } while (0)
#pragma unroll 1
    for (int t = 0; t < NT; t += 2) {
        ML_TILE(t, 0, ML_STAGE);
        ML_TILE(t + 1, ML_STAGE, 0);
    }
#undef ML_TILE
#undef ML_DMA
    la = swap32_sum(la); lb = swap32_sum(lb);
    const float ia = 1.0f / la, ib = 1.0f / lb;
    { LAS unsigned char* st = lds + 2 * ML_STAGE + w * 2 * OST_WAVE;
      ostage_write(st, oa0, oa1, ia, r32, hi); ostage_write(st + OST_WAVE, ob0, ob1, ib, r32, hi);
      asm volatile("s_waitcnt lgkmcnt(0)" ::: "memory");
      bf16_t* obase = (bf16_t*)(F.ws + WS_ATT) + (tokbase + qidx0) * DM + h * 64;
#pragma unroll
      for (int i = 0; i < 8; ++i) { const int row = 8 * i + (lane >> 3); *(u32x4*)(obase + (size_t)row * DM + (lane & 7) * 8) = *(const LAS u32x4*)(st + row * OST_ROW + (lane & 7) * 16); } }
}
__device__ __forceinline__ void mla_phase(const Frame& F) {
    float gq = 0.f, gk = 0.f;
    for (int i = 0; i < 96; ++i) { gq = fmaxf(gq, fabsf(F.in[I_L1_C_QN][i])); gk = fmaxf(gk, fabsf(F.in[I_L1_C_KN][i])); }
    const bool fix = gq * gk * 9.797959f * LOG2E < ATT_FIX_BOUND;
    if (fix) {
        for (int idx = F.bid; idx < 1024; idx += F.G) {
            const int bh = idx >> 1, s = idx & 1;
#pragma nounroll
            for (int u = 0; u < 2; ++u) mla_unit2(F, bh >> 4, bh & 15, u ? s : 3 - s);
        }
    } else {
        for (int idx = F.bid; idx < 2048; idx += F.G) {
            const int bh = idx >> 2, s = idx & 3;
#pragma nounroll
            for (int u = 0; u < 2; ++u) mla_unit<false>(F, bh >> 4, bh & 15, u ? s : 7 - s);
        }
    }
}

__device__ __forceinline__ void mla_rowstats(const Frame& F) {
    const int lane_ = lane_id_v();
    const bf16_t* P1 = (const bf16_t*)(F.ws + WS_PROJ1); float* rs = (float*)(F.ws + RT_ROWST);
    for (int t = F.bid * 8 + F.wave; t < NTOK; t += F.G * 8) {
        const bf16_t* pr = P1 + (size_t)t * L1_INP;
        const u32x2 a = *(const u32x2*)(pr + lane_ * 4); const unsigned a2 = *(const unsigned*)(pr + 256 + lane_ * 2); const u32x2 c = *(const u32x2*)(pr + CQ + lane_ * 4);
        const float s1 = bf_lo(a.x) * bf_lo(a.x) + bf_hi(a.x) * bf_hi(a.x) + bf_lo(a.y) * bf_lo(a.y) + bf_hi(a.y) * bf_hi(a.y) + bf_lo(a2) * bf_lo(a2) + bf_hi(a2) * bf_hi(a2);
        const float s2 = bf_lo(c.x) * bf_lo(c.x) + bf_hi(c.x) * bf_hi(c.x) + bf_lo(c.y) * bf_lo(c.y) + bf_hi(c.y) * bf_hi(c.y);
        const float rq = __builtin_amdgcn_rsqf(wave_sum(s1) * (1.f / CQ) + EPS), rkv = __builtin_amdgcn_rsqf(wave_sum(s2) * (1.f / CKV) + EPS);
        if (lane_ == 0) *(f32x2*)(rs + 2 * t) = (f32x2){rq, rkv};
    }
}
__device__ __forceinline__ void moe_route1(const Frame& F) {
    const int lane_ = lane_id_v(), tid_ = F.wave * 64 + lane_; (void)tid_;
    const bf16_t* x = (const bf16_t*)(F.ws + WS_X3); const float* gain = F.in[I_L1_FFN_NORM]; const float* router = F.in[I_L1_ROUTER];
    unsigned char* dst = (unsigned char*)(F.ws + WS_H3F8);
    int* tok_e = (int*)(F.ws + RT_TOKE); float* tok_g = (float*)(F.ws + RT_TOKG); int* wgcnt = (int*)(F.ws + RT_WGCNT);
    LAS int* cnt = (LAS int*)(F.lds + 32768);
    if (tid_ < 8) cnt[tid_] = 0;
    __syncthreads();
    f32x4 rr[4][4][2];
#pragma unroll
    for (int j = 0; j < 4; ++j)
#pragma unroll
        for (int c = 0; c < 4; ++c) { const int d = (lane_ + 64 * j) * 4 + c; rr[j][c][0] = *(const f32x4*)(router + d * 8); rr[j][c][1] = *(const f32x4*)(router + d * 8 + 4); }
    f32x4 gv[4];
#pragma unroll
    for (int j = 0; j < 4; ++j) gv[j] = ((const f32x4*)gain)[lane_ + 64 * j];
    u32x2 nx[4];
    { const int m0 = F.bid * 8 + F.wave; const u32x2* xr = (const u32x2*)(x + (size_t)m0 * DM) + lane_;
#pragma unroll
      for (int j = 0; j < 4; ++j) nx[j] = xr[64 * j]; }
    for (int m = F.bid * 8 + F.wave; m < NTOK; m += F.G * 8) {
        u32x2 cx[4];
#pragma unroll
        for (int j = 0; j < 4; ++j) cx[j] = nx[j];
        if (m + F.G * 8 < NTOK) { const u32x2* xr = (const u32x2*)(x + (size_t)(m + F.G * 8) * DM) + lane_;
#pragma unroll
            for (int j = 0; j < 4; ++j) nx[j] = xr[64 * j]; }
        f32x4 v[4]; float s = 0.f;
#pragma unroll
        for (int j = 0; j < 4; ++j) { const u32x2 xx = cx[j]; v[j] = (f32x4){bf_lo(xx.x), bf_hi(xx.x), bf_lo(xx.y), bf_hi(xx.y)}; s += (v[j].x * v[j].x + v[j].y * v[j].y) + (v[j].z * v[j].z + v[j].w * v[j].w); }
        const float rstd = __builtin_amdgcn_rsqf(wave_sum(s) * (1.f / DM) + EPS);
        float lg[8];
#pragma unroll
        for (int e = 0; e < 8; ++e) lg[e] = 0.f;
        unsigned* o8 = (unsigned*)(dst + (size_t)m * DM) + lane_;
#pragma unroll
        for (int j = 0; j < 4; ++j) {
            f32x4 hv = v[j] * rstd * gv[j];
            o8[64 * j] = pk4_fp8(hv.x, hv.y, hv.z, hv.w);
#pragma unroll
            for (int c = 0; c < 4; ++c) { const f32x4 r0 = rr[j][c][0], r1 = rr[j][c][1];
                lg[0] += hv[c] * r0.x; lg[1] += hv[c] * r0.y; lg[2] += hv[c] * r0.z; lg[3] += hv[c] * r0.w; lg[4] += hv[c] * r1.x; lg[5] += hv[c] * r1.y; lg[6] += hv[c] * r1.z; lg[7] += hv[c] * r1.w; }
        }
        { const bool b0 = lane_ & 1, b1 = (lane_ >> 1) & 1, b2 = (lane_ >> 2) & 1;
          float k4[4], k2[2], k1;
#pragma unroll
          for (int i = 0; i < 4; ++i) { const float keep = b0 ? lg[4 + i] : lg[i], send = b0 ? lg[i] : lg[4 + i]; k4[i] = keep + __shfl_xor(send, 1); }
#pragma unroll
          for (int i = 0; i < 2; ++i) { const float keep = b1 ? k4[2 + i] : k4[i], send = b1 ? k4[i] : k4[2 + i]; k2[i] = keep + __shfl_xor(send, 2); }
          { const float keep = b2 ? k2[1] : k2[0], send = b2 ? k2[0] : k2[1]; k1 = keep + __shfl_xor(send, 4); }
          k1 += __shfl_xor(k1, 8); k1 += __shfl_xor(k1, 16); k1 += __shfl_xor(k1, 32);
#pragma unroll
          for (int e = 0; e < 8; ++e) lg[e] = __uint_as_float(__builtin_amdgcn_readlane(__float_as_uint(k1), (e >> 2) | (((e >> 1) & 1) << 1) | ((e & 1) << 2))); }
        int e0 = 0; float v0 = lg[0];
#pragma unroll
        for (int e = 1; e < 8; ++e) if (lg[e] > v0) { v0 = lg[e]; e0 = e; }
        int e1 = -1; float v1 = -INFINITY;
#pragma unroll
        for (int e = 0; e < 8; ++e) if (e != e0 && lg[e] > v1) { v1 = lg[e]; e1 = e; }
        const float p1 = __expf(v1 - v0), g0 = 1.0f / (1.0f + p1), g1 = p1 * g0;
        if (lane_ == 0) { tok_e[2 * m] = e0; tok_e[2 * m + 1] = e1; tok_g[2 * m] = g0; tok_g[2 * m + 1] = g1;
            __hip_atomic_fetch_add(cnt + e0, 1, __ATOMIC_RELAXED, __HIP_MEMORY_SCOPE_WORKGROUP); __hip_atomic_fetch_add(cnt + e1, 1, __ATOMIC_RELAXED, __HIP_MEMORY_SCOPE_WORKGROUP); }
    }
    __syncthreads();
    if (tid_ < 8) wgcnt[F.bid * 8 + tid_] = cnt[tid_];
}
__device__ __forceinline__ void moe_route2(const Frame& F) {
    const int lane_ = lane_id_v(), tid_ = F.wave * 64 + lane_; (void)tid_;
    const int* tok_e = (const int*)(F.ws + RT_TOKE); int* tok_s = (int*)(F.ws + RT_TOKS); int* row_tok = (int*)(F.ws + RT_ROWTOK);
    const int* wgcnt = (const int*)(F.ws + RT_WGCNT); int* tile_e = (int*)(F.ws + RT_TILEE);
    LAS int* tot = (LAS int*)F.lds;
    if (tid_ < 32) tot[tid_] = 0;
    __syncthreads();
    { const int e = tid_ & 7; int a = 0, b = 0;
      for (int wg = tid_ >> 3; wg < F.G; wg += 64) { const int c = wgcnt[wg * 8 + e]; a += c; if (wg < F.bid) b += c; }
      __hip_atomic_fetch_add(tot + e, a, __ATOMIC_RELAXED, __HIP_MEMORY_SCOPE_WORKGROUP); __hip_atomic_fetch_add(tot + 8 + e, b, __ATOMIC_RELAXED, __HIP_MEMORY_SCOPE_WORKGROUP); }
    __syncthreads();
    if (tid_ == 0) { int ps = 0; for (int e = 0; e < 8; ++e) { tot[16 + e] = ps; ps += (tot[e] + 255) / 256 * 256; } tot[32] = ps; }
    __syncthreads();
    if (F.bid == 0) {
        const int used = tot[32] / 256;
        for (int t = tid_; t < MOE_TILES_MAX; t += 512) { int e = -1; if (t < used) { e = 7; for (int q = 7; q >= 1; --q) if (t * 256 < tot[16 + q]) e = q - 1; } tile_e[t] = e < 0 ? 0 : e; }
        if (tid_ == 0) tile_e[MOE_TILES_MAX] = used;
    }
    if (F.bid < 8) {
        const int e = F.bid, lo = tot[16 + e] + tot[e], hi = tot[16 + e] + (tot[e] + 255) / 256 * 256;
        for (int p = lo + tid_; p < hi; p += 512) row_tok[p] = -1;
    }
    { const int gw = F.bid * 8 + F.wave, NGW = F.G * 8;
      for (int j0 = 0; gw + j0 * NGW < NTOK; j0 += 32) {
          const int m = gw + (j0 + (lane_ >> 1)) * NGW, k = lane_ & 1;
          if (m < NTOK) { const int e = tok_e[2 * m + k];
              const int slot = tot[16 + e] + tot[8 + e] + __hip_atomic_fetch_add(tot + 24 + e, 1, __ATOMIC_RELAXED, __HIP_MEMORY_SCOPE_WORKGROUP);
              row_tok[slot] = m; tok_s[2 * m + k] = slot; } } }
    __syncthreads();
}
__device__ __forceinline__ void moe_combine(const Frame& F, bool dry) {
    const int lane_ = lane_id_v();
    const f32x2* tok_g = (const f32x2*)(F.ws + RT_TOKG); const u32x2* tok_s = (const u32x2*)(F.ws + RT_TOKS); const unsigned char* Y = (const unsigned char*)(F.ws + WS_Y);
    for (int m = (F.bid * 8 + F.wave) * 2; m < NTOK; m += F.G * 16) {
        const f32x2 ga = tok_g[m], gb = tok_g[m + 1]; const u32x2 sa = tok_s[m], sb = tok_s[m + 1];
        f32x4* xa = (f32x4*)(F.out + (size_t)m * DM) + lane_; f32x4* xb = xa + DM / 4;
        const u32x2* x3a = (const u32x2*)((const bf16_t*)(F.ws + WS_X3) + (size_t)m * DM) + lane_; const u32x2* x3b = x3a + DM / 4;
        const unsigned* ya0 = (const unsigned*)(Y + (size_t)sa.x * DM) + lane_; const unsigned* ya1 = (const unsigned*)(Y + (size_t)sa.y * DM) + lane_;
        const unsigned* yb0 = (const unsigned*)(Y + (size_t)sb.x * DM) + lane_; const unsigned* yb1 = (const unsigned*)(Y + (size_t)sb.y * DM) + lane_;
        f32x4 va[4], vb[4]; unsigned a0[4], a1[4], b0[4], b1[4];
#pragma unroll
        for (int j = 0; j < 4; ++j) { { const u32x2 p = x3a[64 * j], q = x3b[64 * j]; va[j] = (f32x4){bf_lo(p.x), bf_hi(p.x), bf_lo(p.y), bf_hi(p.y)}; vb[j] = (f32x4){bf_lo(q.x), bf_hi(q.x), bf_lo(q.y), bf_hi(q.y)}; } a0[j] = ya0[64 * j]; a1[j] = ya1[64 * j]; b0[j] = yb0[64 * j]; b1[j] = yb1[64 * j]; }
#pragma unroll
        for (int j = 0; j < 4; ++j) {
            const float gax = ga.x * 0.0625f, gay = ga.y * 0.0625f, gbx = gb.x * 0.0625f, gby = gb.y * 0.0625f;
            f32x4 v = va[j];
            v.x += gax * __builtin_amdgcn_cvt_f32_fp8((int)a0[j], 0) + gay * __builtin_amdgcn_cvt_f32_fp8((int)a1[j], 0); v.y += gax * __builtin_amdgcn_cvt_f32_fp8((int)a0[j], 1) + gay * __builtin_amdgcn_cvt_f32_fp8((int)a1[j], 1);
            v.z += gax * __builtin_amdgcn_cvt_f32_fp8((int)a0[j], 2) + gay * __builtin_amdgcn_cvt_f32_fp8((int)a1[j], 2); v.w += gax * __builtin_amdgcn_cvt_f32_fp8((int)a0[j], 3) + gay * __builtin_amdgcn_cvt_f32_fp8((int)a1[j], 3);
            if (!dry) xa[64 * j] = v;
            v = vb[j];
            v.x += gbx * __builtin_amdgcn_cvt_f32_fp8((int)b0[j], 0) + gby * __builtin_amdgcn_cvt_f32_fp8((int)b1[j], 0); v.y += gbx * __builtin_amdgcn_cvt_f32_fp8((int)b0[j], 1) + gby * __builtin_amdgcn_cvt_f32_fp8((int)b1[j], 1);
            v.z += gbx * __builtin_amdgcn_cvt_f32_fp8((int)b0[j], 2) + gby * __builtin_amdgcn_cvt_f32_fp8((int)b1[j], 2); v.w += gbx * __builtin_amdgcn_cvt_f32_fp8((int)b0[j], 3) + gby * __builtin_amdgcn_cvt_f32_fp8((int)b1[j], 3);
            if (!dry) xb[64 * j] = v; }
    }
}

constexpr int NPHASE = 21;
__global__ void __launch_bounds__(512, 2) mk_fwd(Args args) {
    extern __shared__ __attribute__((aligned(16))) unsigned char lds_raw[];
    Frame F;
    F.lds = (LAS unsigned char*)lds_raw;
    F.wave = __builtin_amdgcn_readfirstlane((int)threadIdx.x >> 6);
    F.G = gridDim.x; F.bid = blockIdx.x; F.ws = args.ws; F.out = args.out; F.in = args.in;
    volatile LAS unsigned* MISC = (volatile LAS unsigned*)(F.lds + LDS_MISC);
    { const int l0 = lane_id_v(); if (F.wave == 0) MISC[l0] = 0u; }
    __syncthreads();
    unsigned* ctl = (unsigned*)(args.ws + WS_CTL);
    XcdBarrier bar; bar.bar = ctl + CW_BAR; bar.x = 0; bar.st = nullptr; bar.wave = F.wave;
    if (!MK_PER_PHASE) bar = xcd_barrier_post(ctl + CW_BAR, MISC, F.wave);
    const int lo = args.ph_lo, hi = args.ph_hi; const unsigned probe = args.probe; (void)probe;
    unsigned char* ws = args.ws;
#define IN(k) (lo <= (k) && (k) < hi)
#if PROBE_MASK != 0
#define DRY(k) (rep_ < (int)((probe >> (k)) & 1u))
#define REPS(k) _Pragma("nounroll") for (int rep_ = 0; rep_ <= (int)((probe >> (k)) & 1u); ++rep_)
#else
#define DRY(k) false
#define REPS(k)
#endif
#define SEAM(k) do { if (IN(k) && IN((k) + 1)) { if (!MK_PER_PHASE) xcd_barrier(bar); } } while (0)
    int ph = 0;
    if (IN(0)) REPS(0) { p0_weights(F); p0_rope(F); x_rows(F, F.in[I_X], (bf16_t*)(ws + WS_H), (float*)(ws + RT_ROWST)); } SEAM(0);
    if (IN(1)) REPS(1) { pg8::Gemm g{(const bf16_t*)(ws + WS_H), (const bf16_t*)(ws + W0_IN), DM, DM, 0, nullptr}; pg8::StaticOrder S; S.init(NTOK / 256, L0_IN / 256, F.G, F.bid);
        pg8::EpiQKV0 E{(bf16_t*)(ws + WS_PROJ0), (const float*)(ws + WS_ROPEH), (const float*)(ws + WS_ROPEH) + (size_t)NTOK * 32, (const float*)(ws + RT_ROWST), F.in[I_L0_A_QN], F.in[I_L0_A_KN], F.in[I_L0_B_QN], F.in[I_L0_B_KN]};
        pg8::gemm_phase<pg8::EpiQKV0, false, 2, L0_IN / 256>(F.lds, g, S, E, 0, F.wave); } SEAM(1);
    if (IN(2)) REPS(2) { band_phase(F, 0); } SEAM(2);
    if (IN(3)) REPS(3) { band_phase(F, 1); } SEAM(3);
    if (IN(4)) REPS(4) { pg8::Gemm g{(const bf16_t*)(ws + WS_MIX), (const bf16_t*)(ws + W0_OUT), DM, DM, 0, nullptr}; pg8::StaticOrder S; S.init(NTOK / 256, DM / 256, F.G, F.bid);
        pg8::EpiRes<true, true, true> E{ws + WS_H, ws + WS_X12, false, (float*)(ws + WS_SSX), (LAS float*)(F.lds + RING_BYTES + 2048)}; pg8::gemm_phase<pg8::EpiRes<true, true, true>, false, 2, DM / 256>(F.lds, g, S, E, 0, F.wave); } SEAM(4);
    if (IN(6)) REPS(6) { pg8::Gemm g{(const bf16_t*)(ws + WS_X12), (const bf16_t*)(ws + W0_GU), DM, DM, 0, nullptr}; pg8::StaticOrder S; S.init(NTOK / 256, 2 * DFF / 256, F.G, F.bid);
        pg8::EpiSwiGLU E{(bf16_t*)(ws + WS_HID0), DFF, 0, (const float*)(ws + WS_SSX)}; pg8::gemm_phase<pg8::EpiSwiGLU, false, 2, 2 * DFF / 256>(F.lds, g, S, E, 0, F.wave); } SEAM(6);
    if (IN(7)) REPS(7) { pg8::Gemm g{(const bf16_t*)(ws + WS_HID0), (const bf16_t*)(ws + W0_DN), DFF, DFF, 0, nullptr}; pg8::StaticOrder S; S.init(NTOK / 256, DM / 256, F.G, F.bid);
        pg8::EpiRes<true, true, true> E{ws + WS_X12, ws + WS_X12, DRY(7), (float*)(ws + WS_SSX), (LAS float*)(F.lds + RING_BYTES + 2048)}; pg8::gemm_phase<pg8::EpiRes<true, true, true>, false, 2, DM / 256>(F.lds, g, S, E, 0, F.wave); } SEAM(7);
    if (IN(9)) REPS(9) { pg8::Gemm g{(const bf16_t*)(ws + WS_X12), (const bf16_t*)(ws + W1_IN), DM, DM, 0, nullptr}; pg8::StaticOrder S; S.init(NTOK / 256, L1_INP / 256, F.G, F.bid);
        pg8::EpiProj1 E{(bf16_t*)(ws + WS_PROJ1), (float*)(ws + WS_ROPEH), (LAS float*)(F.lds + RING_BYTES + 2048), (const float*)(ws + WS_SSX)}; pg8::gemm_phase<pg8::EpiProj1, false, 2, L1_INP / 256>(F.lds, g, S, E, 0, F.wave); } SEAM(9);
    if (IN(11)) REPS(11) {
        { pg8::Gemm g{(const bf16_t*)(ws + WS_PROJ1), (const bf16_t*)(ws + W1_UQ), L1_INP, CQ, 0, nullptr}; pg8::StaticOrder S; S.init(NTOK / 256, NUQ / 256, F.G, F.bid);
          pg8::EpiBf16Row E{(bf16_t*)(ws + WS_Q), NUQ, (const float*)(ws + WS_ROPEH), 0}; pg8::gemm_phase<pg8::EpiBf16Row, false, 2, NUQ / 256>(F.lds, g, S, E, 0, F.wave); } }
    if (IN(12)) REPS(12) {
        { pg8::Gemm g{(const bf16_t*)(ws + WS_PROJ1) + CQ, (const bf16_t*)(ws + W1_UKV), L1_INP, CKV, 0, nullptr}; pg8::StaticOrder S; S.init(NTOK / 256, NUKV / 256, F.G, F.bid);
          const float* cc_ = (const float*)(ws + WS_ROPEC);
          pg8::EpiKV1 E{(bf16_t*)(ws + WS_K), (bf16_t*)(ws + WS_KV), (const float*)(ws + WS_ROPEH), (const bf16_t*)(ws + WS_PROJ1), cc_, cc_ + (size_t)NTOK * 16, F.in[I_L1_C_KN]};
          pg8::gemm_phase<pg8::EpiKV1, false, 2, NUKV / 256>(F.lds, g, S, E, 0, F.wave); } } SEAM(12);
    if (IN(14)) REPS(14) { mla_phase(F); } SEAM(14);
    if (IN(15)) REPS(15) { pg8::Gemm g{(const bf16_t*)(ws + WS_ATT), (const bf16_t*)(ws + W1_OUT), DM, DM, 0, nullptr}; pg8::StaticOrder S; S.init(NTOK / 256, DM / 256, F.G, F.bid);
        pg8::EpiRes<true, true> E{ws + WS_X12, ws + WS_X3, false, nullptr, nullptr}; pg8::gemm_phase<pg8::EpiRes<true, true>, false, 2, DM / 256>(F.lds, g, S, E, 0, F.wave); } SEAM(15);
    if (IN(16)) REPS(16) { moe_route1(F); } SEAM(16);
    if (IN(17)) REPS(17) { moe_route2(F); } SEAM(17);
    if (IN(18)) REPS(18) {
        const int* tile_e = (const int*)(ws + RT_TILEE); const int used = tile_e[MOE_TILES_MAX];
        pg8::Gemm g{(const bf16_t*)(ws + WS_H3F8), (const bf16_t*)(ws + WE_GU), DM, DM, (size_t)2 * DFE * DM, (const int*)(ws + RT_ROWTOK)}; pg8::StaticOrder S; S.init(used, 2 * DFE / 256, F.G, F.bid, 0, tile_e);
        static_assert(WGU_SCALE == 32.0f && WDN_SCALE == 64.0f, "MFMA block scales below");
        pg8::EpiSwiGLU8 E{(unsigned char*)(ws + WS_HIDE), DFE, DRY(18)}; pg8::gemm_phase<pg8::EpiSwiGLU8, true, 1, 0, 0x7a7a7a7a>(F.lds, g, S, E, 0, F.wave); } SEAM(18);
    if (IN(19)) REPS(19) {
        const int* tile_e = (const int*)(ws + RT_TILEE); const int used = tile_e[MOE_TILES_MAX];
        pg8::Gemm g{(const bf16_t*)(ws + WS_HIDE), (const bf16_t*)(ws + WE_DN), DFE, DFE, (size_t)DM * DFE, nullptr}; pg8::StaticOrder S; S.init(used, DM / 256, F.G, F.bid, 0, tile_e);
        pg8::EpiFp8 E{(unsigned char*)(ws + WS_Y), DM}; pg8::gemm_phase<pg8::EpiFp8, false, 1, 0, 0x7d7d7d7d>(F.lds, g, S, E, 0, F.wave); } SEAM(19);
    if (IN(20)) REPS(20) { moe_combine(F, DRY(20)); }
    (void)ph;
#undef IN
#undef SEAM
}

extern "C" void kernel_launch(void* const* d_in, const int* in_sizes, int n_in, void* d_out, int out_size, void* d_ws, size_t ws_size, hipStream_t stream) {
    static int grid = 0;
    if (grid == 0) {
        if (n_in != 28 || in_sizes[0] != NTOK * DM || out_size != NTOK * DM || ws_size < WS_END) {
            fprintf(stderr, "kernel_launch: unexpected shapes (n_in %d, in0 %d, out %d, ws %zu < %zu); nothing launched\n", n_in, n_in > 0 ? in_sizes[0] : -1, out_size, ws_size, (size_t)WS_END); grid = -1; return; }
        int dev = 0, cus = 0, per_cu = 0;
        if (hipGetDevice(&dev) != hipSuccess || hipDeviceGetAttribute(&cus, hipDeviceAttributeMultiprocessorCount, dev) != hipSuccess) { grid = -1; return; }
        if (hipFuncSetAttribute((const void*)mk_fwd, hipFuncAttributeMaxDynamicSharedMemorySize, LDS_BYTES) != hipSuccess) { fprintf(stderr, "kernel_launch: hipFuncSetAttribute failed\n"); grid = -1; return; }
        if (hipOccupancyMaxActiveBlocksPerMultiprocessor(&per_cu, (const void*)mk_fwd, 512, LDS_BYTES) != hipSuccess || per_cu < 1) fprintf(stderr, "kernel_launch: occupancy query reports %d\n", per_cu);
        (void)hipGetLastError();
        grid = cus;
    }
    if (grid < 0) return;
    if (hipMemsetAsync((char*)d_ws + WS_CTL, 0, CTL_ZERO_BYTES, stream) != hipSuccess) return;
    Args a{};
    for (int i = 0; i < 28; ++i) a.in[i] = (const float*)d_in[i];
    a.out = (float*)d_out; a.ws = (unsigned char*)d_ws; a.probe = PROBE_MASK; a.pad = 0;
    if (MK_PER_PHASE) {
        for (int p = 0; p < NPHASE; ++p) { a.ph_lo = p; a.ph_hi = p + 1; hipLaunchKernelGGL(mk_fwd, dim3(grid), dim3(512), LDS_BYTES, stream, a); }
    } else {
        a.ph_lo = 0; a.ph_hi = NPHASE; hipLaunchKernelGGL(mk_fwd, dim3(grid), dim3(512), LDS_BYTES, stream, a);
    }
}
```

```cpp
#include <hip/hip_runtime.h>
#include <cstdio>
#include <cstdint>

#ifndef PROBE_MASK
#define PROBE_MASK 0u
#endif
#ifndef MK_PER_PHASE
#define MK_PER_PHASE 0
#endif

#define LAS __attribute__((address_space(3)))
#define GAS __attribute__((address_space(1)))
typedef unsigned short bf16_t;
typedef short bf16x8 __attribute__((ext_vector_type(8)));
typedef short s16x4 __attribute__((ext_vector_type(4)));
typedef float f32x2 __attribute__((ext_vector_type(2)));
typedef float f32x4 __attribute__((ext_vector_type(4)));
typedef float f32x16 __attribute__((ext_vector_type(16)));
typedef unsigned u32x2 __attribute__((ext_vector_type(2)));
typedef unsigned u32x4 __attribute__((ext_vector_type(4)));
typedef int v8i_t __attribute__((ext_vector_type(8)));
typedef int v4i_t __attribute__((ext_vector_type(4)));
typedef short bf16x16_t __attribute__((ext_vector_type(16)));

constexpr int NTOK = 65536, DM = 1024, SEQ = 2048, NBATCH = 32;
constexpr int L0_IN = 2304, DFF = 2816, L1_INP = 768  , CQ = 384, CKV = 256, NUQ = 1536, NUKV = 2048;
constexpr int NEXP = 8, DFE = 3584, MOE_ROWS_MAX = 133120  , MOE_TILES_MAX = 520, MOE_CHUNK_TILES = 130;
constexpr float EPS = 1e-6f;
constexpr float LOG2E = 1.4426950408889634f;
constexpr float WGU_SCALE = 32.0f, WDN_SCALE = 64.0f;

constexpr size_t MiB = 1u << 20;
constexpr size_t WS_CTL = 0, CTL_ZERO_BYTES = 64 * 1024;
constexpr size_t WS_ROUTE = 1 * MiB;
constexpr size_t RT_TOKE = WS_ROUTE;
constexpr size_t RT_TOKG = RT_TOKE + (size_t)NTOK * 8;
constexpr size_t RT_TOKS = RT_TOKG + (size_t)NTOK * 8;
constexpr size_t RT_ROWTOK = RT_TOKS + (size_t)NTOK * 8;
constexpr size_t RT_WGCNT = RT_ROWTOK + (size_t)MOE_ROWS_MAX * 4;
constexpr size_t RT_TILEE = RT_WGCNT + 1024 * 8 * 4;
constexpr size_t RT_ROWST = RT_TILEE + 4096;
constexpr size_t RT_END = RT_ROWST + (size_t)NTOK * 8;
static_assert(RT_END <= 4 * MiB, "route tables");
constexpr size_t WS_W = 4 * MiB;
constexpr size_t W0_IN = WS_W;
constexpr size_t W0_OUT = W0_IN + (size_t)L0_IN * DM * 2;
constexpr size_t W0_GU = W0_OUT + (size_t)DM * DM * 2;
constexpr size_t W0_DN = W0_GU + (size_t)2 * DFF * DM * 2;
constexpr size_t W1_IN = W0_DN + (size_t)DM * DFF * 2;
constexpr size_t W1_UQ = W1_IN + (size_t)L1_INP * DM * 2;
constexpr size_t W1_UKV = W1_UQ + (size_t)NUQ * CQ * 2;
constexpr size_t W1_OUT = W1_UKV + (size_t)NUKV * CKV * 2;
constexpr size_t WE_GU = W1_OUT + (size_t)DM * DM * 2;
constexpr size_t WE_DN = WE_GU + (size_t)NEXP * 2 * DFE * DM;
constexpr size_t WS_W_END = WE_DN + (size_t)NEXP * DM * DFE;
static_assert(WS_W_END <= 202 * MiB, "weights");
constexpr size_t WS_H = 202 * MiB;
constexpr size_t WS_PROJ0 = 330 * MiB;
constexpr size_t WS_MIX = 618 * MiB;
constexpr size_t WS_PART = 746 * MiB;
constexpr size_t WS_LSE = 874 * MiB;
constexpr size_t WS_X12 = 746 * MiB;
constexpr size_t WS_SSX = 1004 * MiB;
constexpr size_t WS_ROPEH = 1000 * MiB;
constexpr size_t WS_ROPEC = 1016 * MiB;
constexpr size_t WS_HID0 = 330 * MiB;
constexpr size_t WS_PROJ1 = 878 * MiB;
constexpr size_t WS_Q = 426 * MiB;
constexpr size_t WS_KV = 618 * MiB;
constexpr size_t WS_K = 202 * MiB;
constexpr size_t WS_ATT = 874 * MiB;
constexpr size_t WS_X3 = 117 * MiB;
constexpr size_t WS_H3F8 = 245 * MiB;
constexpr size_t WS_HIDE = 309 * MiB;
constexpr size_t WS_Y = 764 * MiB;
constexpr size_t WS_H3S = 894 * MiB;
static_assert(WS_Y + (size_t)MOE_ROWS_MAX * DM <= WS_H3S && WS_H3S + (size_t)MOE_ROWS_MAX * DM <= 1024 * MiB, "h3s map");
static_assert(WE_DN + (size_t)NEXP * DM * DFE <= WS_X3 && WS_X3 + (size_t)NTOK * DM * 2 <= WS_H3F8, "x3 map");
constexpr size_t WS_END = 1024 * MiB;
static_assert(WS_H3F8 + (size_t)NTOK * DM <= WS_HIDE && WS_HIDE + (size_t)MOE_ROWS_MAX * DFE <= WS_Y && WS_Y + (size_t)MOE_ROWS_MAX * DM * 2 <= WS_END, "moe map");
static_assert(WS_ATT + (size_t)NTOK * DM * 2 <= WS_ROPEC, "att map");

constexpr int CW_BAR = 1024;

constexpr int RING_BYTES = 131072;
constexpr int LDS_ROWTAB = RING_BYTES;
constexpr int LDS_BYTES = 147456;
constexpr int LDS_MISC = LDS_BYTES - 256;

#define RLX_AGENT __ATOMIC_RELAXED, __HIP_MEMORY_SCOPE_AGENT
#define LDS_WAIT() asm volatile("s_waitcnt lgkmcnt(0)" ::: "memory")
#define VM_WAIT() asm volatile("s_waitcnt vmcnt(0)" ::: "memory")
__device__ __forceinline__ unsigned cvt_pk_bf16(float lo, float hi) { unsigned r; asm volatile("v_cvt_pk_bf16_f32 %0, %1, %2" : "=v"(r) : "v"(lo), "v"(hi)); return r; }
__device__ __forceinline__ unsigned pk4_fp8(float a, float b, float c, float d) { int w = 0; w = __builtin_amdgcn_cvt_pk_fp8_f32(a, b, w, false); w = __builtin_amdgcn_cvt_pk_fp8_f32(c, d, w, true); return (unsigned)w; }
__device__ __forceinline__ float bf_lo(unsigned u) { return __uint_as_float(u << 16); }
__device__ __forceinline__ float bf_hi(unsigned u) { return __uint_as_float(u & 0xffff0000u); }
__device__ __forceinline__ int lane_id() { return (int)__builtin_amdgcn_mbcnt_hi(~0u, __builtin_amdgcn_mbcnt_lo(~0u, 0u)); }
__device__ __forceinline__ int lane_id_v() { int l; asm volatile("v_mbcnt_lo_u32_b32 %0, -1, 0\n\tv_mbcnt_hi_u32_b32 %0, -1, %0" : "=v"(l)); return l; }
__device__ __forceinline__ float wave_sum(float v) {
#pragma unroll
    for (int o = 1; o < 64; o <<= 1) v += __shfl_xor(v, o);
    return v;
}
__device__ __forceinline__ float fq_sum(float v) {
    auto a = __builtin_amdgcn_permlane16_swap(__float_as_uint(v), __float_as_uint(v), false, false); v = __uint_as_float(a[0]) + __uint_as_float(a[1]);
    auto b = __builtin_amdgcn_permlane32_swap(__float_as_uint(v), __float_as_uint(v), false, false); return __uint_as_float(b[0]) + __uint_as_float(b[1]); }
__device__ __forceinline__ float swap32_max(float v) { auto rr = __builtin_amdgcn_permlane32_swap(__float_as_uint(v), __float_as_uint(v), false, false); return fmaxf(__uint_as_float(rr[0]), __uint_as_float(rr[1])); }
__device__ __forceinline__ float swap32_sum(float v) { auto rr = __builtin_amdgcn_permlane32_swap(__float_as_uint(v), __float_as_uint(v), false, false); return __uint_as_float(rr[0]) + __uint_as_float(rr[1]); }

#define XB_TMO      128
#define XB_XCNT(j)  (256  + 64 * (j))
#define XB_XSUB(j)  (1280 + 64 * (j))
#define XB_XGEN(j)  (2304 + 64 * (j))
#define XB_TOP      3328
#define XB_TOPGEN   3392
#define XCD_BAR_WORDS 3456
#define XB_SPIN_CAP (1u << 18)
__device__ __forceinline__ unsigned xb_ld(unsigned* p)              { return __hip_atomic_load(p, __ATOMIC_RELAXED, __HIP_MEMORY_SCOPE_AGENT); }
__device__ __forceinline__ unsigned xb_add(unsigned* p, unsigned v) { return __hip_atomic_fetch_add(p, v, __ATOMIC_RELAXED, __HIP_MEMORY_SCOPE_AGENT); }
__device__ __forceinline__ unsigned xb_xcc_id() { return (unsigned)__builtin_amdgcn_s_getreg((3 << 11) | 20) & 0xFu; }
#define XB_SPIN(cond, bar) do { unsigned _sp = 0; while (cond) { __builtin_amdgcn_s_sleep(1); \
    if ((++_sp & 255u) == 0u) { if (xb_ld(&(bar)[XB_TMO])) break; if (_sp > XB_SPIN_CAP) { atomicAdd(&(bar)[XB_TMO], 1u); break; } } } } while (0)
struct XcdBarrier { unsigned* bar; unsigned x; volatile LAS unsigned* st; int wave; };
__device__ __forceinline__ XcdBarrier xcd_barrier_post(unsigned* bar, volatile LAS unsigned* st, int wave) {
    XcdBarrier b; b.bar = bar; b.x = xb_xcc_id(); b.st = st; b.wave = wave;
    if (wave == 0 && lane_id() == 0) (void)xb_add(&bar[XB_XCNT(b.x)], 1u);
    return b;
}
__device__ __forceinline__ void xcd_barrier_complete(unsigned* bar, unsigned x, unsigned& nloc, unsigned& nx) {
    const unsigned G = gridDim.x * gridDim.y * gridDim.z;
    unsigned sum, cnt, mine, sp = 0u;
    for (;;) {
        sum = 0u; cnt = 0u; mine = 0u;
#pragma unroll
        for (unsigned j = 0; j < 16; ++j) { const unsigned c = xb_ld(&bar[XB_XCNT(j)]); sum += c; cnt += (c > 0u) ? 1u : 0u; mine = (j == x) ? c : mine; }
        if (sum == G) break;
        __builtin_amdgcn_s_sleep(1);
        if ((++sp & 255u) == 0u) { if (xb_ld(&bar[XB_TMO])) break; if (sp > XB_SPIN_CAP) { atomicAdd(&bar[XB_TMO], 1u); break; } }
    }
    nloc = mine > 0u ? mine : 1u; nx = cnt > 0u ? cnt : 1u;
}
__device__ __forceinline__ void xcd_barrier(const XcdBarrier& b) {
    asm volatile("s_waitcnt vmcnt(0)" ::: "memory");
    __syncthreads();
    if (b.wave == 0 && lane_id() == 0) {
        unsigned* bar = b.bar;
        __builtin_amdgcn_s_waitcnt(0);
        unsigned nloc = b.st[0], nx = b.st[1];
        if (nloc == 0u) { xcd_barrier_complete(bar, b.x, nloc, nx); b.st[0] = nloc; b.st[1] = nx; }
        const unsigned old = xb_add(&bar[XB_XSUB(b.x)], 1u);
        const unsigned gen = old / nloc;
        if (old + 1u == (gen + 1u) * nloc) {
            __builtin_amdgcn_fence(__ATOMIC_RELEASE, "agent");
            asm volatile("s_waitcnt vmcnt(0)" ::: "memory");
            const unsigned og = xb_add(&bar[XB_TOP], 1u);
            const unsigned tg = og / nx;
            if (og + 1u == (tg + 1u) * nx) xb_add(&bar[XB_TOPGEN], 1u);
            else XB_SPIN(xb_ld(&bar[XB_TOPGEN]) == tg, bar);
            __builtin_amdgcn_fence(__ATOMIC_ACQUIRE, "agent");
            xb_add(&bar[XB_XGEN(b.x)], 1u);
            asm volatile("s_waitcnt vmcnt(0)" ::: "memory");
        } else {
            XB_SPIN(xb_ld(&bar[XB_XGEN(b.x)]) == gen, bar);
            __builtin_amdgcn_fence(__ATOMIC_ACQUIRE, "agent");
            asm volatile("s_waitcnt vmcnt(0)" ::: "memory");
        }
    }
    __syncthreads();
}

namespace pg8 {
constexpr int BM = 256, BK = 64, HALF = 128, HTB = HALF * BK * 2, STAGE_BYTES = 8 * HTB, NXCD = 8, WGM = 8;
__host__ __device__ __forceinline__ int lds_byte(int r, int c) { const int st = (r >> 4) * 2 + (c >> 5), rr = r & 15, cc = c & 31, ob = rr * 64 + cc * 2; return st * 1024 + (ob ^ (((ob >> 9) & 1) << 5)); }
__host__ __device__ __forceinline__ void stage_rc(int b, int& R, int& C) { const int st = b / 1024, sb = b % 1024, swz = sb ^ (((sb >> 9) & 1) << 5); R = (st >> 1) * 16 + swz / 64; C = (st & 1) * 32 + (swz % 64) / 2; }
__host__ __device__ __forceinline__ int perm32(int rho) { const int n = rho >> 4, i = rho & 15; return 8 * (i >> 2) + 4 * n + (i & 3); }

struct Unit { int pm, pn, e; };
struct Gemm { const bf16_t* A; const bf16_t* Bt; int lda, K; size_t bstride; const int* rowtab; };

struct StaticOrder {
    int nM, nN, nwg, G, c, pm0; const int* tile_e;
    __device__ void init(int nM_, int nN_, int G_, int c_, int pm0_ = 0, const int* te = nullptr) { nM = nM_; nN = nN_; nwg = nM * nN; G = G_; c = c_; pm0 = pm0_; tile_e = te; }
    template <int NN> __device__ bool next_dense(int i, Unit& u) const {
        const int L = i * G + c; if (L >= nwg) return false;
        const int wgid = (L % NXCD) * ((NTOK / 256) * NN / NXCD) + L / NXCD;
        const int gid = wgid / (WGM * NN), w = wgid % (WGM * NN);
        u.pm = gid * WGM + (w % WGM); u.pn = w / WGM; u.e = 0; return true;
    }
    __device__ bool next(int i, Unit& u) const {
        const int L = i * G + c; if (L >= nwg) return false;
        int wgid = L; { const int q = nwg / NXCD, r = nwg % NXCD, xcd = wgid % NXCD, off = wgid / NXCD; wgid = (xcd < r ? xcd * (q + 1) : r * (q + 1) + (xcd - r) * q) + off; }
        const int nig = WGM * nN, gid = wgid / nig, fm = gid * WGM, gsz = (nM - fm) < WGM ? (nM - fm) : WGM;
        u.pm = pm0 + fm + ((wgid % nig) % gsz); u.pn = (wgid % nig) / gsz;
        u.e = tile_e ? __builtin_amdgcn_readfirstlane(tile_e[u.pm]) : 0;
        return true;
    }
};

template <class Epi, bool GATHER, int ESZ = 2, int NNC = 0, int WSC = 0x7f7f7f7f  >
__device__ __forceinline__ void gemm_phase(LAS unsigned char* lds, const Gemm g, const StaticOrder& S, const Epi& E, int a_row0  , int wave_id) {
    const int wid = wave_id, wr = wid >> 2, wc = wid & 3;
    const int K = g.K, nt = K * ESZ / 128, lda = g.lda;
    const unsigned hstepA = (unsigned)(HALF * lda * ESZ), hstepB = (unsigned)(HALF * K * ESZ);
    const unsigned ldsw0 = (unsigned)wid * 1024u;
    const __amdgpu_buffer_rsrc_t rsA = __builtin_amdgcn_make_buffer_rsrc((void*)g.A, (short)0, 0x7ffffff0, 0x00020000);
    const __amdgpu_buffer_rsrc_t rsB = __builtin_amdgcn_make_buffer_rsrc((void*)g.Bt, (short)0, 0x7ffffff0, 0x00020000);
#define PG8_SA(b, h) (((b) * 2 + (h)) * HTB)
#define PG8_SB(b, h) ((4 + (b) * 2 + (h)) * HTB)
#define PG8_STAGE_B(bufoff, soff) do { _Pragma("unroll") for (int _i = 0; _i < 2; ++_i) \
        __builtin_amdgcn_raw_ptr_buffer_load_lds(rsB, (LAS unsigned*)(lds + (bufoff) + ldsw + _i * 8192), 16, voffB[_i], (soff), 0, 0); } while (0)
#define PG8_STAGE_A(bufoff, abase, h, kofs, VO) do { _Pragma("unroll") for (int _i = 0; _i < 2; ++_i) { if constexpr (GATHER) \
        __builtin_amdgcn_raw_ptr_buffer_load_lds(rsA, (LAS unsigned*)(lds + (bufoff) + ldsw + _i * 8192), 16, VO[h][_i], (kofs), 0, 0); else \
        __builtin_amdgcn_raw_ptr_buffer_load_lds(rsA, (LAS unsigned*)(lds + (bufoff) + ldsw + _i * 8192), 16, voffA[_i], (abase) + (h) * hstepA + (kofs), 0, 0); } } while (0)
#define PG8_LD1(base, i) __builtin_shufflevector(*(const LAS v4i_t*)(lds + (base) + (i) * 2048), *(const LAS v4i_t*)(lds + (base) + (i) * 2048 + 1024), 0, 1, 2, 3, 4, 5, 6, 7)
#define PG8_LD1H(off, i) __builtin_shufflevector(*(const LAS v4i_t*)(ldsB + (off) + (i) * 2048), *(const LAS v4i_t*)(ldsB + (off) + (i) * 2048 + 1024), 0, 1, 2, 3, 4, 5, 6, 7)
#define PG8_LDA(dst, b, h) do { _Pragma("unroll") for (int m = 0; m < 4; ++m) dst[m] = PG8_LD1(PG8_SA(b, h) + aoff, m); } while (0)
#define PG8_LDB(dst, b, h) do { _Pragma("unroll") for (int n = 0; n < 2; ++n) dst[n] = PG8_LD1H(PG8_SB(b, h) - 65536, n); } while (0)
#define PG8_LO(x) __builtin_bit_cast(bf16x8, __builtin_shufflevector(x, x, 0, 1, 2, 3))
#define PG8_HI(x) __builtin_bit_cast(bf16x8, __builtin_shufflevector(x, x, 4, 5, 6, 7))
#define PG8_MMA(ai, bj, At, Bt) do { __builtin_amdgcn_s_setprio(1); if constexpr (ESZ == 2) { _Pragma("unroll") for (int m = 0; m < 4; ++m) _Pragma("unroll") for (int n = 0; n < 2; ++n) { \
        acc[ai][bj][m][n] = __builtin_amdgcn_mfma_f32_16x16x32_bf16(PG8_LO(Bt[n]), PG8_LO(At[m]), acc[ai][bj][m][n], 0, 0, 0); \
        acc[ai][bj][m][n] = __builtin_amdgcn_mfma_f32_16x16x32_bf16(PG8_HI(Bt[n]), PG8_HI(At[m]), acc[ai][bj][m][n], 0, 0, 0); } } \
        else { _Pragma("unroll") for (int m = 0; m < 4; ++m) _Pragma("unroll") for (int n = 0; n < 2; ++n) \
        acc[ai][bj][m][n] = __builtin_amdgcn_mfma_scale_f32_16x16x128_f8f6f4(Bt[n], At[m], acc[ai][bj][m][n], 0, 0, 0, WSC, 0, 0x7f7f7f7f); } \
        __builtin_amdgcn_s_setprio(0); } while (0)
#define PG8_WAIT_V(n) asm volatile("s_waitcnt vmcnt(" #n ")" ::: "memory")
#define PG8_WAIT_L(n) asm volatile("s_waitcnt lgkmcnt(" #n ")" ::: "memory")
#define PG8_BAR __builtin_amdgcn_s_barrier()
#define PG8_SCHED __builtin_amdgcn_sched_barrier(0)
    Unit cur, nxt; int ui = 0;
    if (!(NNC > 0 ? S.template next_dense<NNC ? NNC : 1>(0, cur) : S.next(0, cur))) return;
    f32x4 acc[2][2][4][2];
    v8i_t At[4], B0[2], B1[2];
    unsigned voC[2][2];
    LAS int* rtab = (LAS int*)(lds + RING_BYTES);
#pragma unroll
    for (int h = 0; h < 2; ++h)
#pragma unroll
        for (int i = 0; i < 2; ++i) voC[h][i] = 0;
    unsigned cA = (unsigned)((cur.pm * BM - a_row0) * lda * ESZ), cB = (unsigned)((cur.e * (int)g.bstride + cur.pn * BM * K) * ESZ);
    for (;;) {
        float zr; asm volatile("v_mov_b32 %0, 0" : "=v"(zr));
#pragma unroll
        for (int a = 0; a < 2; ++a)
#pragma unroll
            for (int b = 0; b < 2; ++b)
#pragma unroll
                for (int m = 0; m < 4; ++m)
#pragma unroll
                    for (int n = 0; n < 2; ++n) { acc[a][b][m][n] = (f32x4){zr, zr, zr, zr}; }
        const int lane = lane_id_v(), tid = wid * 64 + lane, fr = lane & 15, fq = lane >> 4;
        unsigned voffA[2], voffB[2];
#pragma unroll
        for (int i = 0; i < 2; ++i) { int R_, C_; stage_rc(tid * 16 + i * 8192, R_, C_); voffA[i] = (unsigned)(R_ * lda * ESZ + C_ * 2); voffB[i] = (unsigned)(R_ * K * ESZ + C_ * 2); }
        const int aoff = lds_byte(wr * 64 + fr, fq * 8), boff = lds_byte(wc * 32 + fr, fq * 8);
        LAS unsigned char* ldsB = lds + 65536 + boff;
        if (ui == 0) {
            const unsigned ldsw = ldsw0;
            if constexpr (GATHER) {
#pragma unroll
                for (int h = 0; h < 2; ++h)
#pragma unroll
                    for (int i = 0; i < 2; ++i) { int R_, C_; stage_rc(tid * 16 + i * 8192, R_, C_); int t = g.rowtab[cur.pm * BM + h * HALF + R_]; t = t < 0 ? 0 : t; voC[h][i] = (unsigned)t * (unsigned)(lda * ESZ) + (unsigned)C_ * 2u; }
                VM_WAIT();
            }
            PG8_STAGE_B(PG8_SB(0, 0), cB); PG8_STAGE_B(PG8_SB(0, 1), cB + hstepB); PG8_STAGE_A(PG8_SA(0, 0), cA, 0, 0u, voC); PG8_STAGE_A(PG8_SA(0, 1), cA, 1, 0u, voC);
            if (wr == 1) PG8_BAR;
            PG8_WAIT_V(2); PG8_BAR;
            PG8_STAGE_B(PG8_SB(1, 0), cB + 128u); PG8_STAGE_A(PG8_SA(1, 0), cA, 0, 128u, voC); PG8_STAGE_B(PG8_SB(1, 1), cB + hstepB + 128u);
            PG8_WAIT_V(6); PG8_BAR;
        }
        const bool has_next = NNC > 0 ? S.template next_dense<NNC ? NNC : 1>(ui + 1, nxt) : S.next(ui + 1, nxt);
        const unsigned nA = has_next ? (unsigned)((nxt.pm * BM - a_row0) * lda * ESZ) : cA, nB = has_next ? (unsigned)((nxt.e * (int)g.bstride + nxt.pn * BM * K) * ESZ) : cB;
        if constexpr (GATHER) {
            if (has_next && wid == 0) __builtin_amdgcn_global_load_lds((const unsigned*)(g.rowtab + nxt.pm * BM + lane * 4), (LAS unsigned*)(lds + RING_BYTES + ((ui + 1) & 1) * 1024), 16, 0, 0);
        }
#pragma unroll 1
        for (int t = 0; t < nt; t += 2) {
            unsigned ldsw = ldsw0; asm volatile("" : "+s"(ldsw));
            int last_i = __builtin_amdgcn_readfirstlane((t == nt - 2) ? 1 : 0); asm volatile("" : "+s"(last_i));
            const bool last = last_i != 0;
            const unsigned k1 = (unsigned)(t + 1) * 128u;
            const unsigned a2 = last ? nA : cA, k2 = last ? 0u : (unsigned)(t + 2) * 128u;
            const unsigned b2 = last ? nB : cB + (unsigned)(t + 2) * 128u;
            const unsigned b3 = b2 + 128u, k3 = k2 + 128u;
            PG8_LDB(B0, 0, 0); PG8_LDB(B1, 0, 1); PG8_SCHED; PG8_LDA(At, 0, 0); PG8_STAGE_A(PG8_SA(1, 1), cA, 1, k1, voC);
            PG8_WAIT_V(8); PG8_WAIT_L(0); PG8_BAR; PG8_MMA(0, 0, At, B0); PG8_MMA(0, 1, At, B1); PG8_BAR; PG8_SCHED;
            if constexpr (GATHER) {
                if (last && has_next) {
#pragma unroll
                    for (int h = 0; h < 2; ++h)
#pragma unroll
                        for (int i = 0; i < 2; ++i) { int R_, C_; stage_rc(tid * 16 + i * 8192, R_, C_); int tk = rtab[((ui + 1) & 1) * 256 + h * HALF + R_]; tk = tk < 0 ? 0 : tk; voC[h][i] = (unsigned)tk * (unsigned)(lda * ESZ) + (unsigned)C_ * 2u; }
                }
            }
            PG8_LDA(At, 0, 1); PG8_STAGE_B(PG8_SB(0, 0), b2); PG8_STAGE_B(PG8_SB(0, 1), b2 + hstepB);
            PG8_STAGE_A(PG8_SA(0, 0), a2, 0, k2, voC);
            PG8_WAIT_V(8); PG8_WAIT_L(0); PG8_BAR; PG8_MMA(1, 0, At, B0); PG8_MMA(1, 1, At, B1); PG8_BAR; PG8_SCHED;
            PG8_LDB(B0, 1, 0); PG8_LDB(B1, 1, 1); PG8_SCHED; PG8_LDA(At, 1, 0);
            PG8_STAGE_A(PG8_SA(0, 1), a2, 1, k2, voC);
            PG8_WAIT_V(8); PG8_WAIT_L(0); PG8_BAR; PG8_MMA(0, 0, At, B0); PG8_MMA(0, 1, At, B1); PG8_BAR; PG8_SCHED;
            PG8_LDA(At, 1, 1); PG8_STAGE_B(PG8_SB(1, 0), b3); PG8_STAGE_B(PG8_SB(1, 1), b3 + hstepB);
            PG8_STAGE_A(PG8_SA(1, 0), a2, 0, k3, voC);
            PG8_WAIT_V(8); PG8_WAIT_L(0); PG8_BAR; PG8_MMA(1, 0, At, B0); PG8_MMA(1, 1, At, B1); PG8_BAR; PG8_SCHED;
        }
        if (wr == 0) PG8_BAR;
        { const int l2 = lane_id_v(); E(acc, cur, wr, wc, l2 & 15, l2 >> 4); }
        if (!has_next) break;
        cur = nxt; cA = nA; cB = nB; ++ui;
        if (wr == 1) PG8_BAR;
    }
    PG8_WAIT_V(0);
    PG8_BAR;
#undef PG8_SA
#undef PG8_SB
#undef PG8_STAGE_A
#undef PG8_STAGE_B
#undef PG8_LD1
#undef PG8_LD1H
#undef PG8_LDA
#undef PG8_LDB
#undef PG8_LO
#undef PG8_HI
#undef PG8_MMA
#undef PG8_WAIT_V
#undef PG8_WAIT_L
#undef PG8_BAR
#undef PG8_SCHED
}


struct EpiBf16 {
    bf16_t* O; int ldc; float sc;
    __device__ __forceinline__ void operator()(const f32x4 (&acc)[2][2][4][2], const Unit& u, int wr, int wc, int fr, int fq) const {
        const int row0 = u.pm * BM + wr * 64 + fr, col0 = u.pn * BM + wc * 32 + 8 * fq;
#pragma unroll
        for (int ai = 0; ai < 2; ++ai)
#pragma unroll
            for (int m = 0; m < 4; ++m) { bf16_t* rowp = O + (size_t)(row0 + ai * HALF + m * 16) * ldc + col0;
#pragma unroll
                for (int bj = 0; bj < 2; ++bj) { const f32x4 v0 = acc[ai][bj][m][0] * sc, v1 = acc[ai][bj][m][1] * sc;
                    u32x4 w; w.x = cvt_pk_bf16(v0[0], v0[1]); w.y = cvt_pk_bf16(v0[2], v0[3]); w.z = cvt_pk_bf16(v1[0], v1[1]); w.w = cvt_pk_bf16(v1[2], v1[3]);
                    *(u32x4*)(rowp + bj * HALF) = w; } }
    }
};
struct EpiFp8 {
    unsigned char* O; int ldc; const int* rowmap;
    __device__ __forceinline__ void operator()(const f32x4 (&acc)[2][2][4][2], const Unit& u, int wr, int wc, int fr, int fq) const {
        const int row0 = u.pm * BM + wr * 64 + fr, col0 = u.pn * BM + wc * 32 + 8 * fq;
        int dr[8];
#pragma unroll
        for (int i = 0; i < 8; ++i) dr[i] = rowmap[row0 + (i >> 2) * HALF + (i & 3) * 16];
#pragma unroll
        for (int ai = 0; ai < 2; ++ai)
#pragma unroll
            for (int m = 0; m < 4; ++m) { const int d = dr[ai * 4 + m]; if (d < 0) continue; unsigned char* rowp = O + (size_t)d * ldc + col0;
#pragma unroll
                for (int bj = 0; bj < 2; ++bj) { const f32x4 v0 = acc[ai][bj][m][0], v1 = acc[ai][bj][m][1];
                    u32x2 w; w.x = pk4_fp8(__builtin_amdgcn_fmed3f(v0[0], -448.f, 448.f), __builtin_amdgcn_fmed3f(v0[1], -448.f, 448.f), __builtin_amdgcn_fmed3f(v0[2], -448.f, 448.f), __builtin_amdgcn_fmed3f(v0[3], -448.f, 448.f));
                    w.y = pk4_fp8(__builtin_amdgcn_fmed3f(v1[0], -448.f, 448.f), __builtin_amdgcn_fmed3f(v1[1], -448.f, 448.f), __builtin_amdgcn_fmed3f(v1[2], -448.f, 448.f), __builtin_amdgcn_fmed3f(v1[3], -448.f, 448.f));
                    *(u32x2*)(rowp + bj * HALF) = w; } }
    }
};
struct EpiProj1 {
    bf16_t* O; float* SS; LAS float* part; const float* ssx;
    __device__ __forceinline__ void operator()(const f32x4 (&acc)[2][2][4][2], const Unit& u, int wr, int wc, int fr, int fq) const {
        const int row0 = u.pm * BM + wr * 64 + fr, col0 = u.pn * BM + wc * 32 + 8 * fq, wid = wr * 4 + wc;
        float rsv[8];
#pragma unroll
        for (int i = 0; i < 8; ++i) { const f32x4 x4 = *(const f32x4*)(ssx + (size_t)(row0 + (i >> 2) * HALF + (i & 3) * 16) * 4); rsv[i] = __builtin_amdgcn_rsqf(((x4[0] + x4[1]) + (x4[2] + x4[3])) * (1.f / DM) + EPS); }
#pragma unroll
        for (int ai = 0; ai < 2; ++ai)
#pragma unroll
            for (int m = 0; m < 4; ++m) { bf16_t* rowp = O + (size_t)(row0 + ai * HALF + m * 16) * L1_INP + col0;
                const float rstd = rsv[ai * 4 + m];
#pragma unroll
                for (int bj = 0; bj < 2; ++bj) { const f32x4 v0 = acc[ai][bj][m][0] * rstd, v1 = acc[ai][bj][m][1] * rstd;
                    u32x4 w; w.x = cvt_pk_bf16(v0[0], v0[1]); w.y = cvt_pk_bf16(v0[2], v0[3]); w.z = cvt_pk_bf16(v1[0], v1[1]); w.w = cvt_pk_bf16(v1[2], v1[3]);
                    *(u32x4*)(rowp + bj * HALF) = w;
                    float ss = (bf_lo(w.x) * bf_lo(w.x) + bf_hi(w.x) * bf_hi(w.x)) + (bf_lo(w.y) * bf_lo(w.y) + bf_hi(w.y) * bf_hi(w.y)) + (bf_lo(w.z) * bf_lo(w.z) + bf_hi(w.z) * bf_hi(w.z)) + (bf_lo(w.w) * bf_lo(w.w) + bf_hi(w.w) * bf_hi(w.w));
                    ss = fq_sum(ss);
                    if (fq == 0) part[((wid * 2 + bj) * 8 + ai * 4 + m) * 16 + fr] = ss; } }
        asm volatile("s_waitcnt lgkmcnt(0)\n\ts_barrier" ::: "memory");
        { const int t = wid * 64 + fq * 16 + fr, bj = t >> 8, wr2 = (t >> 7) & 1, am = (t >> 4) & 7, fr2 = t & 15;
          const LAS float* pp = part + ((wr2 * 4 * 2 + bj) * 8 + am) * 16 + fr2;
          const float ssum = (pp[0] + pp[2 * 8 * 16]) + (pp[2 * 2 * 8 * 16] + pp[3 * 2 * 8 * 16]);
          const int row = u.pm * BM + (am >> 2) * HALF + wr2 * 64 + (am & 3) * 16 + fr2, sl = u.pn * 2 + bj;
          SS[(size_t)row * 8 + sl + (sl >= 3 ? 1 : 0)] = ssum; }
    }
};
struct EpiBf16Row {
    bf16_t* O; int ldc; const float* rs; int which;
    __device__ __forceinline__ void operator()(const f32x4 (&acc)[2][2][4][2], const Unit& u, int wr, int wc, int fr, int fq) const {
        const int row0 = u.pm * BM + wr * 64 + fr;
        float scv[8];
#pragma unroll
        for (int i = 0; i < 8; ++i) { const f32x4 s4 = *(const f32x4*)(rs + (size_t)(row0 + (i >> 2) * HALF + (i & 3) * 16) * 8); scv[i] = __builtin_amdgcn_rsqf(((s4[0] + s4[1]) + s4[2]) * (1.f / CQ) + EPS); }
#pragma unroll
        for (int ai = 0; ai < 2; ++ai)
#pragma unroll
            for (int m = 0; m < 4; ++m) { const int row = row0 + ai * HALF + m * 16; const float sc = scv[ai * 4 + m]; const int b = row >> 11, t = row & (SEQ - 1);
#pragma unroll
                for (int bj = 0; bj < 2; ++bj) { const f32x4 v0 = acc[ai][bj][m][0] * sc, v1 = acc[ai][bj][m][1] * sc;
                    u32x4 w; w.x = cvt_pk_bf16(v0[0], v0[1]); w.y = cvt_pk_bf16(v0[2], v0[3]); w.z = cvt_pk_bf16(v1[0], v1[1]); w.w = cvt_pk_bf16(v1[2], v1[3]);
                    const int col = u.pn * BM + bj * HALF + wc * 32 + 8 * fq;
                    bf16_t* dst;
                    if (which == 0) { const int hd = col / 96, d = col - hd * 96; dst = O + (((size_t)b * 16 + hd) * SEQ + t) * 96 + d; }
                    else { const int hd = col >> 7, d = col & 127;
                        dst = d < 64 ? O + (size_t)row * 1024 + hd * 64 + d : O + (size_t)NTOK * 1024 + (((size_t)b * 16 + hd) * SEQ + t) * 64 + (d - 64); }
                    *(u32x4*)dst = w; } }
    }
};
template <bool RB, bool OB, bool ST = false>
struct EpiRes {
    const void* res; void* out; bool dry; float* SS; LAS float* part;
    __device__ __forceinline__ void operator()(const f32x4 (&acc)[2][2][4][2], const Unit& u, int wr, int wc, int fr, int fq) const {
        const int row0 = u.pm * BM + wr * 64 + fr, col0 = u.pn * BM + wc * 32 + 8 * fq;
        u32x4 xball_[2][4][2];
        if constexpr (RB) {
#pragma unroll
            for (int ai = 0; ai < 2; ++ai)
#pragma unroll
                for (int m = 0; m < 4; ++m)
#pragma unroll
                    for (int bj = 0; bj < 2; ++bj) xball_[ai][m][bj] = __builtin_nontemporal_load((const u32x4*)((const bf16_t*)res + (size_t)(row0 + ai * HALF + m * 16) * DM + col0 + bj * HALF));
            __builtin_amdgcn_sched_barrier(0);
        }
#pragma unroll
        for (int ai = 0; ai < 2; ++ai) {
            u32x4 xb_[4][2]; f32x4 xf_[4][2][2];
#pragma unroll
            for (int m = 0; m < 4; ++m)
#pragma unroll
                for (int bj = 0; bj < 2; ++bj) { const size_t o = (size_t)(row0 + ai * HALF + m * 16) * DM + col0 + bj * HALF;
                    if constexpr (RB) xb_[m][bj] = xball_[ai][m][bj]; else { xf_[m][bj][0] = *(const f32x4*)((const float*)res + o); xf_[m][bj][1] = *(const f32x4*)((const float*)res + o + 4); } }
            __builtin_amdgcn_sched_barrier(0);
#pragma unroll
            for (int m = 0; m < 4; ++m) { const size_t off = (size_t)(row0 + ai * HALF + m * 16) * DM + col0; float ssr = 0.f;
#pragma unroll
                for (int bj = 0; bj < 2; ++bj) { const size_t o = off + bj * HALF;
                    f32x4 r0, r1;
                    if constexpr (RB) { const u32x4 x = xb_[m][bj]; r0 = (f32x4){bf_lo(x.x), bf_hi(x.x), bf_lo(x.y), bf_hi(x.y)}; r1 = (f32x4){bf_lo(x.z), bf_hi(x.z), bf_lo(x.w), bf_hi(x.w)}; }
                    else { r0 = xf_[m][bj][0]; r1 = xf_[m][bj][1]; }
                    r0 += acc[ai][bj][m][0]; r1 += acc[ai][bj][m][1];
                    if (!dry) {
                        if constexpr (OB) { u32x4 w; w.x = cvt_pk_bf16(r0[0], r0[1]); w.y = cvt_pk_bf16(r0[2], r0[3]); w.z = cvt_pk_bf16(r1[0], r1[1]); w.w = cvt_pk_bf16(r1[2], r1[3]); *(u32x4*)((bf16_t*)out + o) = w;
                            if constexpr (ST) ssr += (bf_lo(w.x) * bf_lo(w.x) + bf_hi(w.x) * bf_hi(w.x)) + (bf_lo(w.y) * bf_lo(w.y) + bf_hi(w.y) * bf_hi(w.y)) + (bf_lo(w.z) * bf_lo(w.z) + bf_hi(w.z) * bf_hi(w.z)) + (bf_lo(w.w) * bf_lo(w.w) + bf_hi(w.w) * bf_hi(w.w)); }
                        else { *(f32x4*)((float*)out + o) = r0; *(f32x4*)((float*)out + o + 4) = r1; } } }
                if constexpr (ST) { ssr = fq_sum(ssr); if (fq == 0) part[((wr * 4 + wc) * 8 + ai * 4 + m) * 16 + fr] = ssr; } }
        }
        if constexpr (ST) {
            asm volatile("s_waitcnt lgkmcnt(0)\n\ts_barrier" ::: "memory");
            const int t = (wr * 4 + wc) * 64 + fq * 16 + fr;
            if (t < 256) { const int wr2 = t >> 7, am = (t >> 4) & 7, fr2 = t & 15; const LAS float* pp = part + (wr2 * 4 * 8 + am) * 16 + fr2;
                const float ssum = (pp[0] + pp[8 * 16]) + (pp[2 * 8 * 16] + pp[3 * 8 * 16]);
                SS[(size_t)(u.pm * BM + (am >> 2) * HALF + wr2 * 64 + (am & 3) * 16 + fr2) * 4 + u.pn] = ssum; }
        }
    }
};
struct EpiSwiGLU {
    bf16_t* H; int ldc; int row_sub; const float* ss;
    __device__ __forceinline__ void operator()(const f32x4 (&acc)[2][2][4][2], const Unit& u, int wr, int wc, int fr, int fq) const {
        const int row0 = u.pm * BM - row_sub + wr * 64 + fr, col0 = u.pn * HALF + wc * 32 + 8 * fq;
        float rsv[8];
#pragma unroll
        for (int i = 0; i < 8; ++i) { const f32x4 s4 = *(const f32x4*)(ss + (size_t)(row0 + (i >> 2) * HALF + (i & 3) * 16) * 4); rsv[i] = __builtin_amdgcn_rsqf(((s4[0] + s4[1]) + (s4[2] + s4[3])) * (1.f / DM) + EPS); }
#pragma unroll
        for (int ai = 0; ai < 2; ++ai)
#pragma unroll
            for (int m = 0; m < 4; ++m) { bf16_t* rowp = H + (size_t)(row0 + ai * HALF + m * 16) * ldc + col0;
                const float rstd = rsv[ai * 4 + m];
                float r[8];
#pragma unroll
                for (int n = 0; n < 2; ++n)
#pragma unroll
                    for (int j = 0; j < 4; ++j) { const float gt = acc[ai][0][m][n][j] * rstd, up = acc[ai][1][m][n][j] * rstd;
                        r[n * 4 + j] = gt * __builtin_amdgcn_rcpf(1.0f + __builtin_amdgcn_exp2f(-gt * LOG2E)) * up; }
                u32x4 w; w.x = cvt_pk_bf16(r[0], r[1]); w.y = cvt_pk_bf16(r[2], r[3]); w.z = cvt_pk_bf16(r[4], r[5]); w.w = cvt_pk_bf16(r[6], r[7]);
                __builtin_nontemporal_store(w, (u32x4*)rowp); }
    }
};
struct EpiSwiGLU8 {
    unsigned char* H; int ldc; bool dry;
    __device__ __forceinline__ void operator()(const f32x4 (&acc)[2][2][4][2], const Unit& u, int wr, int wc, int fr, int fq) const {
        const int row0 = u.pm * BM + wr * 64 + fr, col0 = u.pn * HALF + wc * 32 + 8 * fq;
#pragma unroll
        for (int ai = 0; ai < 2; ++ai)
#pragma unroll
            for (int m = 0; m < 4; ++m) { unsigned char* rowp = H + (size_t)(row0 + ai * HALF + m * 16) * ldc + col0;
                float r[8];
#pragma unroll
                for (int n = 0; n < 2; ++n)
#pragma unroll
                    for (int j = 0; j < 4; ++j) { const float ga = acc[ai][0][m][n][j], ua = acc[ai][1][m][n][j];
                        const float e = __builtin_amdgcn_exp2f(-ga); const float q = __builtin_amdgcn_rcpf(__builtin_fmaf(e, LOG2E, LOG2E));
                        r[n * 4 + j] = __builtin_amdgcn_fmed3f((ga * ua) * q, -448.f, 448.f); }
                u32x2 w; w.x = pk4_fp8(r[0], r[1], r[2], r[3]); w.y = pk4_fp8(r[4], r[5], r[6], r[7]);
                if (!dry) __builtin_nontemporal_store(w, (u32x2*)rowp); }
    }
};
struct EpiQKV0 {
    bf16_t* O; const float* cosT; const float* sinT;
    const float* rs0;
    const float* g_aq; const float* g_ak; const float* g_bq; const float* g_bk;
    __device__ __forceinline__ void operator()(const f32x4 (&acc)[2][2][4][2], const Unit& u, int wr, int wc, int fr, int fq) const {
        const int hd = u.pn * 4 + wc;
        const float* g = hd < 8 ? g_aq : hd < 10 ? g_ak : hd < 12 ? nullptr : hd < 20 ? g_bq : hd < 28 ? g_bk : nullptr;
        const float qs = (hd < 8 || (hd >= 12 && hd < 20)) ? 0.125f * LOG2E : 1.0f;
        const int row0 = u.pm * BM + wr * 64 + fr;
        float r0v[8];
#pragma unroll
        for (int i = 0; i < 8; ++i) r0v[i] = rs0[row0 + (i >> 2) * HALF + (i & 3) * 16];
        if (g == nullptr) {
#pragma unroll
            for (int ai = 0; ai < 2; ++ai)
#pragma unroll
                for (int m = 0; m < 4; ++m) { const int row_ = row0 + ai * HALF + m * 16; bf16_t* rowp = O + (((size_t)(row_ >> 11) * 36 + hd) * SEQ + (row_ & (SEQ - 1))) * 64 + 8 * fq; const float r0 = r0v[ai * 4 + m];
#pragma unroll
                    for (int bj = 0; bj < 2; ++bj) { const f32x4 v0 = acc[ai][bj][m][0] * r0, v1 = acc[ai][bj][m][1] * r0;
                        u32x4 w; w.x = cvt_pk_bf16(v0[0], v0[1]); w.y = cvt_pk_bf16(v0[2], v0[3]); w.z = cvt_pk_bf16(v1[0], v1[1]); w.w = cvt_pk_bf16(v1[2], v1[3]);
                        *(u32x4*)(rowp + bj * 32) = w; } }
            return;
        }
        f32x4 gl[2], gh[2];
#pragma unroll
        for (int n = 0; n < 2; ++n) { gl[n] = *(const f32x4*)(g + 8 * fq + 4 * n); gh[n] = *(const f32x4*)(g + 32 + 8 * fq + 4 * n); }
        f32x4 ctb[2][2], stb[2][2];
#pragma unroll
        for (int n = 0; n < 2; ++n) { ctb[0][n] = *(const f32x4*)(cosT + (size_t)row0 * 32 + 8 * fq + 4 * n); stb[0][n] = *(const f32x4*)(sinT + (size_t)row0 * 32 + 8 * fq + 4 * n); }
#pragma unroll
        for (int ai = 0; ai < 2; ++ai)
#pragma unroll
            for (int m = 0; m < 4; ++m) {
                const int row = row0 + ai * HALF + m * 16, cb_ = (ai * 4 + m) & 1;
                if (ai * 4 + m < 7) { const int nr = row0 + ((ai * 4 + m + 1) >> 2) * HALF + ((ai * 4 + m + 1) & 3) * 16;
#pragma unroll
                    for (int n = 0; n < 2; ++n) { ctb[cb_ ^ 1][n] = *(const f32x4*)(cosT + (size_t)nr * 32 + 8 * fq + 4 * n); stb[cb_ ^ 1][n] = *(const f32x4*)(sinT + (size_t)nr * 32 + 8 * fq + 4 * n); } }
                __builtin_amdgcn_sched_barrier(0);
                float ss = 0.f;
#pragma unroll
                for (int bj = 0; bj < 2; ++bj)
#pragma unroll
                    for (int n = 0; n < 2; ++n) { const f32x4 x = acc[ai][bj][m][n]; ss += (x[0] * x[0] + x[1] * x[1]) + (x[2] * x[2] + x[3] * x[3]); }
                ss = fq_sum(ss);
                const float r0 = r0v[ai * 4 + m]; const float rstd = r0 * __builtin_amdgcn_rsqf(ss * (r0 * r0) * (1.0f / 64.0f) + EPS);
                float lo[8], hi[8];
#pragma unroll
                for (int n = 0; n < 2; ++n) { const f32x4 c = ctb[cb_][n], s = stb[cb_][n];
#pragma unroll
                    for (int j = 0; j < 4; ++j) { const float a = acc[ai][0][m][n][j] * rstd * gl[n][j], b = acc[ai][1][m][n][j] * rstd * gh[n][j];
                        lo[n * 4 + j] = (a * c[j] - b * s[j]) * qs; hi[n * 4 + j] = (b * c[j] + a * s[j]) * qs; } }
                bf16_t* rowp = O + (((size_t)(row >> 11) * 36 + hd) * SEQ + (row & (SEQ - 1))) * 64 + 8 * fq;
                u32x4 w; w.x = cvt_pk_bf16(lo[0], lo[1]); w.y = cvt_pk_bf16(lo[2], lo[3]); w.z = cvt_pk_bf16(lo[4], lo[5]); w.w = cvt_pk_bf16(lo[6], lo[7]);
                *(u32x4*)rowp = w;
                w.x = cvt_pk_bf16(hi[0], hi[1]); w.y = cvt_pk_bf16(hi[2], hi[3]); w.z = cvt_pk_bf16(hi[4], hi[5]); w.w = cvt_pk_bf16(hi[6], hi[7]);
                *(u32x4*)(rowp + 32) = w;
            }
    }
};
struct EpiKV1 {
    bf16_t* Ko; bf16_t* Vo; const float* rs; const bf16_t* P1; const float* cc; const float* sc; const float* gk;
    __device__ __forceinline__ void operator()(const f32x4 (&acc)[2][2][4][2], const Unit& u, int wr, int wc, int fr, int fq) const {
        const int hd = 2 * u.pn + (wc & 1);
        const int row0 = u.pm * BM + wr * 64 + fr;
        float sv[8];
#pragma unroll
        for (int i = 0; i < 8; ++i) { const f32x2 s2 = *(const f32x2*)(rs + (size_t)(row0 + (i >> 2) * HALF + (i & 3) * 16) * 8 + 4); sv[i] = __builtin_amdgcn_rsqf((s2[0] + s2[1]) * (1.f / CKV) + EPS); }
        if (wc >= 2) {
#pragma unroll
            for (int ai = 0; ai < 2; ++ai)
#pragma unroll
                for (int m = 0; m < 4; ++m) { const int row = row0 + ai * HALF + m * 16; const float s = sv[ai * 4 + m];
                    bf16_t* dst = Vo + (((size_t)(row >> 11) * 16 + hd) * SEQ + (row & (SEQ - 1))) * 64 + 8 * fq;
#pragma unroll
                    for (int bj = 0; bj < 2; ++bj) { const f32x4 v0 = acc[ai][bj][m][0] * s, v1 = acc[ai][bj][m][1] * s;
                        u32x4 w; w.x = cvt_pk_bf16(v0[0], v0[1]); w.y = cvt_pk_bf16(v0[2], v0[3]); w.z = cvt_pk_bf16(v1[0], v1[1]); w.w = cvt_pk_bf16(v1[2], v1[3]);
                        *(u32x4*)(dst + bj * 32) = w; } }
            return;
        }
        f32x4 gl[2], gh[2];
#pragma unroll
        for (int n = 0; n < 2; ++n) { gl[n] = *(const f32x4*)(gk + 8 * fq + 4 * n); gh[n] = *(const f32x4*)(gk + 32 + 8 * fq + 4 * n); }
        const f32x4 gr0 = *(const f32x4*)(gk + 64 + 4 * fq), gr1 = *(const f32x4*)(gk + 80 + 4 * fq);
#pragma unroll
        for (int ai2 = 0; ai2 < 4; ++ai2) { const int ai = ai2 >> 1, mh = ai2 & 1;
            u32x2 kr0v[2], kr1v[2]; f32x4 csv[2], snv[2];
#pragma unroll
            for (int m2 = 0; m2 < 2; ++m2) { const int row = row0 + ai * HALF + (2 * mh + m2) * 16; const bf16_t* kp = P1 + (size_t)row * L1_INP + CQ + CKV + 4 * fq;
                kr0v[m2] = *(const u32x2*)kp; kr1v[m2] = *(const u32x2*)(kp + 16); csv[m2] = *(const f32x4*)(cc + (size_t)row * 16 + 4 * fq); snv[m2] = *(const f32x4*)(sc + (size_t)row * 16 + 4 * fq); }
            __builtin_amdgcn_sched_barrier(0);
#pragma unroll
            for (int m2 = 0; m2 < 2; ++m2) { const int m = 2 * mh + m2;
                const int row = row0 + ai * HALF + m * 16; const float s = sv[ai * 4 + m];
                const u32x2 kr0 = kr0v[m2], kr1 = kr1v[m2];
                const f32x4 cs = csv[m2], sn = snv[m2];
                const f32x4 ra = (f32x4){bf_lo(kr0.x), bf_hi(kr0.x), bf_lo(kr0.y), bf_hi(kr0.y)}, rb = (f32x4){bf_lo(kr1.x), bf_hi(kr1.x), bf_lo(kr1.y), bf_hi(kr1.y)};
                float ss = (ra[0] * ra[0] + ra[1] * ra[1]) + (ra[2] * ra[2] + ra[3] * ra[3]) + (rb[0] * rb[0] + rb[1] * rb[1]) + (rb[2] * rb[2] + rb[3] * rb[3]);
#pragma unroll
                for (int bj = 0; bj < 2; ++bj)
#pragma unroll
                    for (int n = 0; n < 2; ++n) { const f32x4 x = acc[ai][bj][m][n] * s; ss += (x[0] * x[0] + x[1] * x[1]) + (x[2] * x[2] + x[3] * x[3]); }
                ss = fq_sum(ss);
                const float rstd = __builtin_amdgcn_rsqf(ss * (1.0f / 96.0f) + EPS), rl = rstd * s;
                bf16_t* dst = Ko + (((size_t)(row >> 11) * 16 + hd) * SEQ + (row & (SEQ - 1))) * 96;
                { const f32x4 a0 = acc[ai][0][m][0] * rl * gl[0], a1 = acc[ai][0][m][1] * rl * gl[1], b0 = acc[ai][1][m][0] * rl * gh[0], b1 = acc[ai][1][m][1] * rl * gh[1];
                  u32x4 w; w.x = cvt_pk_bf16(a0[0], a0[1]); w.y = cvt_pk_bf16(a0[2], a0[3]); w.z = cvt_pk_bf16(a1[0], a1[1]); w.w = cvt_pk_bf16(a1[2], a1[3]);
                  *(u32x4*)(dst + 8 * fq) = w;
                  w.x = cvt_pk_bf16(b0[0], b0[1]); w.y = cvt_pk_bf16(b0[2], b0[3]); w.z = cvt_pk_bf16(b1[0], b1[1]); w.w = cvt_pk_bf16(b1[2], b1[3]);
                  *(u32x4*)(dst + 32 + 8 * fq) = w; }
                { const f32x4 a = ra * rstd * gr0, b = rb * rstd * gr1; const f32x4 oa = a * cs - b * sn, ob = b * cs + a * sn;
                  u32x2 p; p.x = cvt_pk_bf16(oa[0], oa[1]); p.y = cvt_pk_bf16(oa[2], oa[3]); *(u32x2*)(dst + 64 + 4 * fq) = p;
                  p.x = cvt_pk_bf16(ob[0], ob[1]); p.y = cvt_pk_bf16(ob[2], ob[3]); *(u32x2*)(dst + 80 + 4 * fq) = p; }
            }
        }
    }
};
}

__device__ __forceinline__ void dma_piece(__amdgpu_buffer_rsrc_t rs, unsigned lds_dst, unsigned voff, unsigned soff) {
    asm volatile("s_mov_b32 m0, %0\n\ts_nop 0\n\tbuffer_load_dwordx4 %1, %2, %3 offen lds" :: "s"(lds_dst), "v"(voff), "s"(rs), "s"(soff) : "m0", "memory");
}
__device__ __forceinline__ int crow(int r, int hi) { return (r & 3) + 8 * (r >> 2) + 4 * hi; }
typedef short v4i16_t __attribute__((ext_vector_type(4)));
__device__ __forceinline__ s16x4 vtr(LAS unsigned char* p) { return __builtin_bit_cast(s16x4, __builtin_amdgcn_ds_read_tr16_b64_v4i16((LAS v4i16_t*)p)); }
constexpr float ATT_THR = 8.0f, ATT_FIX_BOUND = 60.0f;
template <int DQK, bool TWO, bool FIXREF>
__device__ __forceinline__ void attn_step(LAS unsigned char* kp0, LAS unsigned char* kp1, int ke0, int ke1, LAS unsigned char* vp0, LAS unsigned char* vp1, int vd0,
                                          const bf16x8 (&qf)[DQK / 16], f32x16& negm, float& mref, float& l, f32x16& o0, f32x16& o1,
                                          bool mask0, bool mask1, int qidx, int kidx0, int maxd, int hi) {
    f32x16 s0, s1;
    const f32x16 zf = (f32x16){0.f, 0.f, 0.f, 0.f, 0.f, 0.f, 0.f, 0.f, 0.f, 0.f, 0.f, 0.f, 0.f, 0.f, 0.f, 0.f};
    if constexpr (FIXREF) { s1 = zf; } else { s0 = negm; s1 = negm; }
    bf16x8 kfa[DQK / 16];
#pragma unroll
    for (int kk = 0; kk < DQK / 16; ++kk) kfa[kk] = *(const LAS bf16x8*)(kp0 + (kk >> 1) * 1024 + ((kk & 1) ? ke1 : ke0));
#pragma unroll
    for (int kk = 0; kk < DQK / 16; ++kk) s0 = __builtin_amdgcn_mfma_f32_32x32x16_bf16(kfa[kk], qf[kk], (FIXREF && kk == 0) ? zf : s0, 0, 0, 0);
    if constexpr (TWO) {
#pragma unroll
        for (int kk = 0; kk < DQK / 16; ++kk) kfa[kk] = *(const LAS bf16x8*)(kp1 + (kk >> 1) * 1024 + ((kk & 1) ? ke1 : ke0));
#pragma unroll
        for (int kk = 0; kk < DQK / 16; ++kk) s1 = __builtin_amdgcn_mfma_f32_32x32x16_bf16(kfa[kk], qf[kk], (FIXREF && kk == 0) ? zf : s1, 0, 0, 0);
    }
    if (mask0) {
#pragma unroll
        for (int r = 0; r < 16; ++r) { const int d = qidx - (kidx0 + crow(r, hi)); if (d < 0 || d > maxd) s0[r] = -INFINITY; }
    }
    if constexpr (TWO) { if (mask1) {
#pragma unroll
        for (int r = 0; r < 16; ++r) { const int d = qidx - (kidx0 + 32 + crow(r, hi)); if (d < 0 || d > maxd) s1[r] = -INFINITY; }
    } }
    if constexpr (!FIXREF) {
    float rm = fmaxf(fmaxf(s0[0], s0[1]), fmaxf(s0[2], s0[3]));
#pragma unroll
    for (int r = 4; r < 16; r += 4) rm = fmaxf(rm, fmaxf(fmaxf(s0[r], s0[r + 1]), fmaxf(s0[r + 2], s0[r + 3])));
    if constexpr (TWO) {
#pragma unroll
        for (int r = 0; r < 16; r += 4) rm = fmaxf(rm, fmaxf(fmaxf(s1[r], s1[r + 1]), fmaxf(s1[r + 2], s1[r + 3])));
    }
    rm = swap32_max(rm);
    if (__builtin_expect(__any(rm > ATT_THR), 0)) {
        const float dl = fmaxf(rm, 0.f); mref += dl;
#pragma unroll
        for (int r = 0; r < 16; ++r) { s0[r] -= dl; negm[r] -= dl; if constexpr (TWO) s1[r] -= dl; }
        const float f = __builtin_amdgcn_exp2f(-dl); l *= f;
#pragma unroll
        for (int r = 0; r < 16; ++r) { o0[r] *= f; o1[r] *= f; }
    }
    }
    float ps = 0.f;
#pragma unroll
    for (int r = 0; r < 16; ++r) { s0[r] = __builtin_amdgcn_exp2f(s0[r]); ps += s0[r]; }
    if constexpr (TWO) {
#pragma unroll
        for (int r = 0; r < 16; ++r) { s1[r] = __builtin_amdgcn_exp2f(s1[r]); ps += s1[r]; }
    }
    l += ps;
    {
        u32x4 pw0, pw1;
        pw0.x = cvt_pk_bf16(s0[0], s0[1]); pw0.y = cvt_pk_bf16(s0[2], s0[3]); pw0.z = cvt_pk_bf16(s0[4], s0[5]); pw0.w = cvt_pk_bf16(s0[6], s0[7]);
        pw1.x = cvt_pk_bf16(s0[8], s0[9]); pw1.y = cvt_pk_bf16(s0[10], s0[11]); pw1.z = cvt_pk_bf16(s0[12], s0[13]); pw1.w = cvt_pk_bf16(s0[14], s0[15]);
        const bf16x8 pf0 = __builtin_bit_cast(bf16x8, pw0), pf1 = __builtin_bit_cast(bf16x8, pw1);
#pragma unroll
        for (int ks = 0; ks < 2; ++ks) {
            const s16x4 a0 = vtr(vp0 + ks * 1024), a1 = vtr(vp0 + ks * 1024 + 512);
            const s16x4 b0 = vtr(vp0 + vd0 + ks * 1024), b1 = vtr(vp0 + vd0 + ks * 1024 + 512);
            const bf16x8 va = (bf16x8){a0[0], a0[1], a0[2], a0[3], a1[0], a1[1], a1[2], a1[3]};
            const bf16x8 vb = (bf16x8){b0[0], b0[1], b0[2], b0[3], b1[0], b1[1], b1[2], b1[3]};
            o0 = __builtin_amdgcn_mfma_f32_32x32x16_bf16(va, ks ? pf1 : pf0, o0, 0, 0, 0);
            o1 = __builtin_amdgcn_mfma_f32_32x32x16_bf16(vb, ks ? pf1 : pf0, o1, 0, 0, 0);
        }
    }
    if constexpr (TWO) {
        u32x4 pw0, pw1;
        pw0.x = cvt_pk_bf16(s1[0], s1[1]); pw0.y = cvt_pk_bf16(s1[2], s1[3]); pw0.z = cvt_pk_bf16(s1[4], s1[5]); pw0.w = cvt_pk_bf16(s1[6], s1[7]);
        pw1.x = cvt_pk_bf16(s1[8], s1[9]); pw1.y = cvt_pk_bf16(s1[10], s1[11]); pw1.z = cvt_pk_bf16(s1[12], s1[13]); pw1.w = cvt_pk_bf16(s1[14], s1[15]);
        const bf16x8 pf0 = __builtin_bit_cast(bf16x8, pw0), pf1 = __builtin_bit_cast(bf16x8, pw1);
#pragma unroll
        for (int ks = 0; ks < 2; ++ks) {
            const s16x4 a0 = vtr(vp1 + ks * 1024), a1 = vtr(vp1 + ks * 1024 + 512);
            const s16x4 b0 = vtr(vp1 + vd0 + ks * 1024), b1 = vtr(vp1 + vd0 + ks * 1024 + 512);
            const bf16x8 va = (bf16x8){a0[0], a0[1], a0[2], a0[3], a1[0], a1[1], a1[2], a1[3]};
            const bf16x8 vb = (bf16x8){b0[0], b0[1], b0[2], b0[3], b1[0], b1[1], b1[2], b1[3]};
            o0 = __builtin_amdgcn_mfma_f32_32x32x16_bf16(va, ks ? pf1 : pf0, o0, 0, 0, 0);
            o1 = __builtin_amdgcn_mfma_f32_32x32x16_bf16(vb, ks ? pf1 : pf0, o1, 0, 0, 0);
        }
    }
}

template <int DQK>
__device__ __forceinline__ void attn_step2(LAS unsigned char* kp, int ke0, int ke1, LAS unsigned char* vp, int vd0, const bf16x8 (&qa)[DQK / 16], const bf16x8 (&qb)[DQK / 16],
                                           float& la, float& lb, f32x16& oa0, f32x16& oa1, f32x16& ob0, f32x16& ob1, bool maska, bool maskb, int qidx, int kidx0, int hi) {
    f32x16 sa, sb;
    const f32x16 zf = (f32x16){0.f, 0.f, 0.f, 0.f, 0.f, 0.f, 0.f, 0.f, 0.f, 0.f, 0.f, 0.f, 0.f, 0.f, 0.f, 0.f};
    bf16x8 kf[DQK / 16];
#pragma unroll
    for (int kk = 0; kk < DQK / 16; ++kk) kf[kk] = *(const LAS bf16x8*)(kp + (kk >> 1) * 1024 + ((kk & 1) ? ke1 : ke0));
    sa = __builtin_amdgcn_mfma_f32_32x32x16_bf16(kf[0], qa[0], zf, 0, 0, 0); sb = __builtin_amdgcn_mfma_f32_32x32x16_bf16(kf[0], qb[0], zf, 0, 0, 0);
#pragma unroll
    for (int kk = 1; kk < DQK / 16; ++kk) { sa = __builtin_amdgcn_mfma_f32_32x32x16_bf16(kf[kk], qa[kk], sa, 0, 0, 0); sb = __builtin_amdgcn_mfma_f32_32x32x16_bf16(kf[kk], qb[kk], sb, 0, 0, 0); }
    if (maska) {
#pragma unroll
        for (int r = 0; r < 16; ++r) { if (qidx - (kidx0 + crow(r, hi)) < 0) sa[r] = -INFINITY; }
    }
    if (maskb) {
#pragma unroll
        for (int r = 0; r < 16; ++r) { if (qidx + 32 - (kidx0 + crow(r, hi)) < 0) sb[r] = -INFINITY; }
    }
    s16x4 vfr[2][4];
#pragma unroll
    for (int ks = 0; ks < 2; ++ks) { vfr[ks][0] = vtr(vp + ks * 1024); vfr[ks][1] = vtr(vp + ks * 1024 + 512); vfr[ks][2] = vtr(vp + vd0 + ks * 1024); vfr[ks][3] = vtr(vp + vd0 + ks * 1024 + 512); }
    __builtin_amdgcn_sched_barrier(0);
    float pa = 0.f, pb = 0.f;
#pragma unroll
    for (int r = 0; r < 16; ++r) { sa[r] = __builtin_amdgcn_exp2f(sa[r]); pa += sa[r]; sb[r] = __builtin_amdgcn_exp2f(sb[r]); pb += sb[r]; }
    la += pa; lb += pb;
    u32x4 wa0, wa1, wb0, wb1;
    wa0.x = cvt_pk_bf16(sa[0], sa[1]); wa0.y = cvt_pk_bf16(sa[2], sa[3]); wa0.z = cvt_pk_bf16(sa[4], sa[5]); wa0.w = cvt_pk_bf16(sa[6], sa[7]);
    wa1.x = cvt_pk_bf16(sa[8], sa[9]); wa1.y = cvt_pk_bf16(sa[10], sa[11]); wa1.z = cvt_pk_bf16(sa[12], sa[13]); wa1.w = cvt_pk_bf16(sa[14], sa[15]);
    wb0.x = cvt_pk_bf16(sb[0], sb[1]); wb0.y = cvt_pk_bf16(sb[2], sb[3]); wb0.z = cvt_pk_bf16(sb[4], sb[5]); wb0.w = cvt_pk_bf16(sb[6], sb[7]);
    wb1.x = cvt_pk_bf16(sb[8], sb[9]); wb1.y = cvt_pk_bf16(sb[10], sb[11]); wb1.z = cvt_pk_bf16(sb[12], sb[13]); wb1.w = cvt_pk_bf16(sb[14], sb[15]);
#pragma unroll
    for (int ks = 0; ks < 2; ++ks) {
        const s16x4 a0 = vfr[ks][0], a1 = vfr[ks][1], b0 = vfr[ks][2], b1 = vfr[ks][3];
        const bf16x8 va = (bf16x8){a0[0], a0[1], a0[2], a0[3], a1[0], a1[1], a1[2], a1[3]};
        const bf16x8 vb = (bf16x8){b0[0], b0[1], b0[2], b0[3], b1[0], b1[1], b1[2], b1[3]};
        const bf16x8 pfa = __builtin_bit_cast(bf16x8, ks ? wa1 : wa0), pfb = __builtin_bit_cast(bf16x8, ks ? wb1 : wb0);
        oa0 = __builtin_amdgcn_mfma_f32_32x32x16_bf16(va, pfa, oa0, 0, 0, 0);
        ob0 = __builtin_amdgcn_mfma_f32_32x32x16_bf16(va, pfb, ob0, 0, 0, 0);
        oa1 = __builtin_amdgcn_mfma_f32_32x32x16_bf16(vb, pfa, oa1, 0, 0, 0);
        ob1 = __builtin_amdgcn_mfma_f32_32x32x16_bf16(vb, pfb, ob1, 0, 0, 0);
    }
}

constexpr int OST_ROW = 144, OST_WAVE = 32 * OST_ROW;
__device__ __forceinline__ void ostage_write(LAS unsigned char* st, const f32x16& o0, const f32x16& o1, float sc, int r32, int hi) {
#pragma unroll
    for (int g4 = 0; g4 < 4; ++g4) { u32x2 a, b2; a.x = cvt_pk_bf16(o0[4 * g4] * sc, o0[4 * g4 + 1] * sc); a.y = cvt_pk_bf16(o0[4 * g4 + 2] * sc, o0[4 * g4 + 3] * sc);
        b2.x = cvt_pk_bf16(o1[4 * g4] * sc, o1[4 * g4 + 1] * sc); b2.y = cvt_pk_bf16(o1[4 * g4 + 2] * sc, o1[4 * g4 + 3] * sc);
        *(LAS u32x2*)(st + r32 * OST_ROW + (8 * g4 + 4 * hi) * 2) = a; *(LAS u32x2*)(st + r32 * OST_ROW + (32 + 8 * g4 + 4 * hi) * 2) = b2; }
}
struct Args {
    const float* in[28]; float* out; unsigned char* ws; int ph_lo, ph_hi; unsigned probe; int pad;
};
struct Frame {
    LAS unsigned char* lds; int wave, G, bid;
    unsigned char* ws; float* out; const float* const* in;
};
enum { I_X = 0, I_POS, I_L0_ATTN_NORM, I_L0_W_IN, I_L0_A_QN, I_L0_A_KN, I_L0_A_SINKS, I_L0_B_QN, I_L0_B_KN, I_L0_W_OUT, I_L0_FFN_NORM, I_L0_W_GATE, I_L0_W_UP, I_L0_W_DOWN,
       I_L1_ATTN_NORM, I_L1_W_IN, I_L1_QA_NORM, I_L1_W_UQ, I_L1_KVA_NORM, I_L1_W_UKV, I_L1_C_QN, I_L1_C_KN, I_L1_W_OUT, I_L1_FFN_NORM, I_L1_ROUTER, I_L1_WE_GATE, I_L1_WE_UP, I_L1_WE_DOWN };

__device__ __forceinline__ void cvt_item(const float* W, int ldw, int srccol0  , const float* kgain, bf16_t* Bt, int K, int dstrow0, bool perm, int k0, LAS float* scr, int lane) {
#pragma unroll
    for (int i = 0; i < 8; ++i) { const int kk = 8 * i + (lane >> 3), c4 = (lane & 7) * 4; f32x4 v = (f32x4){0.f, 0.f, 0.f, 0.f};
        if (srccol0 >= 0) { v = __builtin_nontemporal_load((const f32x4*)(W + (size_t)(k0 + kk) * ldw + srccol0 + c4)); if (kgain) v = v * kgain[k0 + kk]; }
        scr[kk * 33 + c4] = v[0]; scr[kk * 33 + c4 + 1] = v[1]; scr[kk * 33 + c4 + 2] = v[2]; scr[kk * 33 + c4 + 3] = v[3]; }
    LDS_WAIT(); asm volatile("" ::: "memory");
    const int c = lane & 7;
#pragma unroll
    for (int j = 0; j < 4; ++j) { const int rho = (lane >> 3) + 8 * j; const int sc = perm ? pg8::perm32(rho) : rho; const LAS float* s = scr + (8 * c) * 33 + sc;
        u32x4 o; o.x = cvt_pk_bf16(s[0 * 33], s[1 * 33]); o.y = cvt_pk_bf16(s[2 * 33], s[3 * 33]); o.z = cvt_pk_bf16(s[4 * 33], s[5 * 33]); o.w = cvt_pk_bf16(s[6 * 33], s[7 * 33]);
        __builtin_nontemporal_store(o, (u32x4*)(Bt + (size_t)(dstrow0 + rho) * K + k0 + 8 * c)); }
    LDS_WAIT(); asm volatile("" ::: "memory");
}
__device__ __forceinline__ void cvt_item8(const float* W, int ldw, int srccol0, unsigned char* Bt, int K, int dstrow0, bool perm, int k0, float scale, LAS float* scr, int lane) {
#pragma unroll
    for (int i = 0; i < 8; ++i) { const int kk = 8 * i + (lane >> 3), c4 = (lane & 7) * 4; const f32x4 v = __builtin_nontemporal_load((const f32x4*)(W + (size_t)(k0 + kk) * ldw + srccol0 + c4)) * scale;
        scr[kk * 33 + c4] = v[0]; scr[kk * 33 + c4 + 1] = v[1]; scr[kk * 33 + c4 + 2] = v[2]; scr[kk * 33 + c4 + 3] = v[3]; }
    LDS_WAIT(); asm volatile("" ::: "memory");
    const int rho = lane >> 1, kh = (lane & 1) * 32; const int sc = perm ? pg8::perm32(rho) : rho; const LAS float* s = scr + kh * 33 + sc;
    u32x4 o0, o1;
    o0.x = pk4_fp8(s[0 * 33], s[1 * 33], s[2 * 33], s[3 * 33]); o0.y = pk4_fp8(s[4 * 33], s[5 * 33], s[6 * 33], s[7 * 33]); o0.z = pk4_fp8(s[8 * 33], s[9 * 33], s[10 * 33], s[11 * 33]); o0.w = pk4_fp8(s[12 * 33], s[13 * 33], s[14 * 33], s[15 * 33]);
    o1.x = pk4_fp8(s[16 * 33], s[17 * 33], s[18 * 33], s[19 * 33]); o1.y = pk4_fp8(s[20 * 33], s[21 * 33], s[22 * 33], s[23 * 33]); o1.z = pk4_fp8(s[24 * 33], s[25 * 33], s[26 * 33], s[27 * 33]); o1.w = pk4_fp8(s[28 * 33], s[29 * 33], s[30 * 33], s[31 * 33]);
    unsigned char* dp = Bt + (size_t)(dstrow0 + rho) * K + k0 + kh;
    __builtin_nontemporal_store(o0, (u32x4*)dp); __builtin_nontemporal_store(o1, (u32x4*)(dp + 16));
    LDS_WAIT(); asm volatile("" ::: "memory");
}
__device__ __forceinline__ void p0_weights(const Frame& F) {
    const int lane_ = lane_id_v(), tid_ = F.wave * 64 + lane_; (void)tid_;
    LAS float* scr = (LAS float*)(F.lds + F.wave * 16384);
    const int gw = F.bid * 8 + F.wave, NGW = F.G * 8;
    constexpr int N0 = (L0_IN / 32) * (DM / 64);
    constexpr int N1 = (DM / 32) * (DM / 64);
    constexpr int N2 = (2 * DFF / 32) * (DM / 64);
    constexpr int N3 = (DM / 32) * (DFF / 64);
    constexpr int N4 = (L1_INP / 32) * (DM / 64);
    constexpr int N5 = (NUQ / 32) * (CQ / 64);
    constexpr int N6 = (NUKV / 32) * (CKV / 64);
    constexpr int N7 = N1;
    constexpr int N8 = NEXP * (2 * DFE / 32) * (DM / 64);
    constexpr int N9 = NEXP * (DM / 32) * (DFE / 64);
    constexpr int NT = N0 + N1 + N2 + N3 + N4 + N5 + N6 + N7 + N8 + N9;
    unsigned char* ws = F.ws;
    for (int it = gw; it < NT; it += NGW) {
        int r = it;
        if (r < N0) { const int g = r % (L0_IN / 32), kb = r / (L0_IN / 32); const int pn = g >> 3, bj = (g >> 2) & 1, wc = g & 3;
            cvt_item(F.in[I_L0_W_IN], L0_IN, pn * 256 + wc * 64 + bj * 32, F.in[I_L0_ATTN_NORM], (bf16_t*)(ws + W0_IN), DM, g * 32, true, kb * 64, scr, lane_); continue; } r -= N0;
        if (r < N1) { const int g = r % (DM / 32), kb = r / (DM / 32);
            cvt_item(F.in[I_L0_W_OUT], DM, g * 32, nullptr, (bf16_t*)(ws + W0_OUT), DM, g * 32, true, kb * 64, scr, lane_); continue; } r -= N1;
        if (r < N2) { const int g = r % (2 * DFF / 32), kb = r / (2 * DFF / 32); const int pn = g >> 3, bj = (g >> 2) & 1, wc = g & 3;
            cvt_item(bj ? F.in[I_L0_W_UP] : F.in[I_L0_W_GATE], DFF, pn * 128 + wc * 32, F.in[I_L0_FFN_NORM], (bf16_t*)(ws + W0_GU), DM, g * 32, true, kb * 64, scr, lane_); continue; } r -= N2;
        if (r < N3) { const int g = r % (DM / 32), kb = r / (DM / 32);
            cvt_item(F.in[I_L0_W_DOWN], DM, g * 32, nullptr, (bf16_t*)(ws + W0_DN), DFF, g * 32, true, kb * 64, scr, lane_); continue; } r -= N3;
        if (r < N4) { const int g = r % (L1_INP / 32), kb = r / (L1_INP / 32);
            cvt_item(F.in[I_L1_W_IN], 672, g < 21 ? g * 32 : -1, F.in[I_L1_ATTN_NORM], (bf16_t*)(ws + W1_IN), DM, g * 32, true, kb * 64, scr, lane_); continue; } r -= N4;
        if (r < N5) { const int g = r % (NUQ / 32), kb = r / (NUQ / 32);
            cvt_item(F.in[I_L1_W_UQ], NUQ, g * 32, F.in[I_L1_QA_NORM], (bf16_t*)(ws + W1_UQ), CQ, g * 32, true, kb * 64, scr, lane_); continue; } r -= N5;
        if (r < N6) { const int g = r % (NUKV / 32), kb = r / (NUKV / 32); const int pn = g >> 3, bj = (g >> 2) & 1, wc = g & 3;
            cvt_item(F.in[I_L1_W_UKV], NUKV, (2 * pn + (wc & 1)) * 128 + (wc >> 1) * 64 + bj * 32, F.in[I_L1_KVA_NORM], (bf16_t*)(ws + W1_UKV), CKV, g * 32, true, kb * 64, scr, lane_); continue; } r -= N6;
        if (r < N7) { const int g = r % (DM / 32), kb = r / (DM / 32);
            cvt_item(F.in[I_L1_W_OUT], DM, g * 32, nullptr, (bf16_t*)(ws + W1_OUT), DM, g * 32, true, kb * 64, scr, lane_); continue; } r -= N7;
        if (r < N8) { constexpr int PE = (2 * DFE / 32) * (DM / 64); const int e = r / PE, q = r % PE; const int g = q % (2 * DFE / 32), kb = q / (2 * DFE / 32); const int pn = g >> 3, bj = (g >> 2) & 1, wc = g & 3;
            cvt_item8((bj ? F.in[I_L1_WE_UP] : F.in[I_L1_WE_GATE]) + (size_t)e * DM * DFE, DFE, pn * 128 + wc * 32, (unsigned char*)(ws + WE_GU) + (size_t)e * 2 * DFE * DM, DM, g * 32, true, kb * 64, bj ? WGU_SCALE : WGU_SCALE * LOG2E, scr, lane_); continue; } r -= N8;
        { constexpr int PE = (DM / 32) * (DFE / 64); const int e = r / PE, q = r % PE; const int g = q % (DM / 32), kb = q / (DM / 32);
            cvt_item8(F.in[I_L1_WE_DOWN] + (size_t)e * DFE * DM, DM, g * 32, (unsigned char*)(ws + WE_DN) + (size_t)e * DM * DFE, DFE, g * 32, true, kb * 64, WDN_SCALE, scr, lane_); }
    }
}
__device__ __forceinline__ void p0_rope(const Frame& F) {
    const int lane_ = lane_id_v(), tid_ = F.wave * 64 + lane_; (void)tid_;
    const int* pos = (const int*)F.in[I_POS];
    float* ch = (float*)(F.ws + WS_ROPEH); float* sh = ch + (size_t)NTOK * 32;
    float* cc = (float*)(F.ws + WS_ROPEC); float* sc = cc + (size_t)NTOK * 16;
    const size_t stride = (size_t)F.G * 512;
    const int f = tid_ & 31;
    const float inv = powf(10000.0f, -(float)(2 * f) / 64.0f), inv2 = powf(10000.0f, -(float)(2 * (f & 15)) / 32.0f);
    for (size_t i = (size_t)F.bid * 512 + tid_; i < (size_t)NTOK * 32; i += stride) {
        const int t = (int)(i >> 5); const float p = (float)pos[t];
        float s, c; sincosf(p * inv, &s, &c); ch[i] = c; sh[i] = s;
        if (f < 16) { sincosf(p * inv2, &s, &c); cc[(size_t)t * 16 + f] = c; sc[(size_t)t * 16 + f] = s; }
    }
}
__device__ __forceinline__ void x_rows(const Frame& F, const float* src, bf16_t* dst, float* rs0) {
    const int lane_ = lane_id_v();
    const int gw = F.bid * 8 + F.wave, NGW = F.G * 8;
    for (int m = gw * 4; m < NTOK; m += NGW * 4) {
        f32x4 v[4][4]; float s[4];
#pragma unroll
        for (int r = 0; r < 4; ++r) { const f32x4* xr = (const f32x4*)(src + (size_t)(m + r) * DM) + lane_;
#pragma unroll
            for (int j = 0; j < 4; ++j) v[r][j] = __builtin_nontemporal_load(&xr[64 * j]); }
#pragma unroll
        for (int r = 0; r < 4; ++r) { s[r] = 0.f;
#pragma unroll
            for (int j = 0; j < 4; ++j) s[r] += (v[r][j].x * v[r][j].x + v[r][j].y * v[r][j].y) + (v[r][j].z * v[r][j].z + v[r][j].w * v[r][j].w); }
#pragma unroll
        for (int r = 0; r < 4; ++r) {
            const float rstd = __builtin_amdgcn_rsqf(wave_sum(s[r]) * (1.f / DM) + EPS);
            if (lane_ == 0) rs0[m + r] = rstd;
            u32x2* o8 = (u32x2*)(dst + (size_t)(m + r) * DM) + lane_;
#pragma unroll
            for (int j = 0; j < 4; ++j) { u32x2 w; w.x = cvt_pk_bf16(v[r][j].x, v[r][j].y); w.y = cvt_pk_bf16(v[r][j].z, v[r][j].w); o8[64 * j] = w; }
        }
    }
}

constexpr int BK_ROWS = 384, BK_VOFF = BK_ROWS * 128, BK_VD0 = BK_ROWS * 64;
struct BandItem { int b, qcol, kcol, vcol, dil, cls0, cls1, tq0, tq1, maxd, mode  , outcol, pidx, head; float sink; bool has_sink, split_rows; };
template <bool FIXREF>
__device__ __forceinline__ void band_item(const Frame& F, const BandItem it) {
    const int lane_ = lane_id_v();
    const bf16_t* P = (const bf16_t*)(F.ws + WS_PROJ0);
    LAS unsigned char* lds = F.lds;
    const int lane = lane_, w = F.wave, hq = w >> 2, wq = w & 3, hi = lane >> 5, r32 = lane & 31;
    const size_t tokbase = (size_t)it.b * SEQ;
    {
        const __amdgpu_buffer_rsrc_t rsP = __builtin_amdgcn_make_buffer_rsrc((void*)(P + tokbase * L0_IN), (short)0, SEQ * L0_IN * 2, 0x00020000);
        const int k16 = lane >> 2, pc = lane & 3;
        const unsigned vok = (unsigned)(k16 * it.dil * 128 + (pc ^ ((k16 >> 2) & 3)) * 16), vov = (unsigned)(k16 * it.dil * 128 + pc * 16);
#pragma unroll 1
        for (int i = 0; i < 12; ++i) {
            const int p = w + 8 * i; const bool isv = p >= 48; const int j = isv ? p - 48 : p;
            const int kg = isv ? j % 24 : j >> 1, sub = isv ? j / 24 : j & 1;
            const int R0 = kg * 16; const bool second = it.split_rows && R0 >= 256;
            const int kidx = second ? R0 - 256 : it.tq0 - 128 + R0; const int cls = second ? it.cls1 : it.cls0;
            if (kidx >= 0 && kidx < SEQ / it.dil) {
                const unsigned so = (unsigned)((((isv ? it.vcol : it.kcol) >> 6) * SEQ + cls + it.dil * kidx) * 128 + sub * 64);
                dma_piece(rsP, (unsigned)(uintptr_t)lds + (unsigned)(isv ? BK_VOFF + j * 1024 : p * 1024), isv ? vov : vok, so);
            }
        }
    }
    const int tq = hq ? it.tq1 : it.tq0, cls = hq ? it.cls1 : it.cls0;
    const int qidx0 = tq + 32 * wq, qidx = qidx0 + r32;
    const size_t qtok = tokbase + cls + (size_t)it.dil * qidx;
    bf16x8 qf[4];
#pragma unroll
    for (int kk = 0; kk < 4; ++kk) qf[kk] = *(const bf16x8*)(P + (((size_t)it.b * 36 + (it.qcol >> 6)) * SEQ + cls + (size_t)it.dil * qidx) * 64 + 16 * kk + 8 * hi);
    float m = it.has_sink ? it.sink : 0.f, l = (it.has_sink && hi == 0) ? 1.f : 0.f;
    f32x16 o0, o1, negm;
#pragma unroll
    for (int r = 0; r < 16; ++r) { o0[r] = 0.f; o1[r] = 0.f; negm[r] = -m; }
    asm volatile("s_waitcnt vmcnt(0) lgkmcnt(0)\n\ts_barrier" ::: "memory");
    {
        const int vlane = (4 * hi + ((lane & 15) >> 2)) * 64 + ((lane >> 4) & 1) * 32 + (lane & 3) * 8;
        const int ksw = (r32 >> 2) & 3, ke0 = ((hi) ^ ksw) * 16, ke1 = ((2 + hi) ^ ksw) * 16;
#define BK_KP(kb) (lds + (8 * hq + 2 * (kb) + (r32 >> 4)) * 2048 + (r32 & 15) * 64)
#define BK_VP(kb) (lds + BK_VOFF + (128 * hq + 32 * (kb)) * 64 + vlane)
        const int kx0 = tq - 128 + 32 * wq;
        if (kx0 >= 0) {
            attn_step<64, true, FIXREF>(BK_KP(wq), BK_KP(wq + 1), ke0, ke1, BK_VP(wq), BK_VP(wq + 1), BK_VD0, qf, negm, m, l, o0, o1, true, false, qidx, kx0, it.maxd, hi);
            attn_step<64, true, FIXREF>(BK_KP(wq + 2), BK_KP(wq + 3), ke0, ke1, BK_VP(wq + 2), BK_VP(wq + 3), BK_VD0, qf, negm, m, l, o0, o1, false, false, qidx, kx0 + 64, it.maxd, hi);
            attn_step<64, false, FIXREF>(BK_KP(wq + 4), BK_KP(wq + 4), ke0, ke1, BK_VP(wq + 4), BK_VP(wq + 4), BK_VD0, qf, negm, m, l, o0, o1, true, false, qidx, kx0 + 128, it.maxd, hi);
        } else {
#pragma unroll 1
            for (int kb = 4; kb < wq + 4; ++kb) attn_step<64, false, FIXREF>(BK_KP(kb), BK_KP(kb), ke0, ke1, BK_VP(kb), BK_VP(kb), BK_VD0, qf, negm, m, l, o0, o1, false, false, qidx, tq - 128 + 32 * kb, it.maxd, hi);
            attn_step<64, false, FIXREF>(BK_KP(wq + 4), BK_KP(wq + 4), ke0, ke1, BK_VP(wq + 4), BK_VP(wq + 4), BK_VD0, qf, negm, m, l, o0, o1, true, false, qidx, kx0 + 128, it.maxd, hi);
        }
#undef BK_KP
#undef BK_VP
    }
    l = swap32_sum(l);
    const float inv = 1.0f / l;
    const float lse = m + __builtin_amdgcn_logf(l);
    LAS unsigned char* st = lds + 98304 + w * OST_WAVE;
    LAS float* wst = (LAS float*)(lds + 98304 + 8 * OST_WAVE) + w * 128;
    const int srow = lane >> 3, sch = lane & 7;
    if (it.mode != 2) {
        ostage_write(st, o0, o1, inv, r32, hi);
        asm volatile("s_waitcnt lgkmcnt(0)" ::: "memory");
        bf16_t* obase = it.mode == 0 ? (bf16_t*)(F.ws + WS_MIX) + it.outcol : (bf16_t*)(F.ws + WS_PART) + (size_t)it.pidx * NTOK * 512 + it.head * 64;
        const int opitch = it.mode == 0 ? DM : 512;
#pragma unroll
        for (int i = 0; i < 4; ++i) { const int row = 8 * i + srow; const u32x4 v = *(const LAS u32x4*)(st + row * OST_ROW + sch * 16);
            *(u32x4*)(obase + (tokbase + cls + (size_t)it.dil * (qidx0 + row)) * opitch + sch * 8) = v; }
        if (it.mode == 1 && hi == 0) ((float*)(F.ws + WS_LSE))[(size_t)it.pidx * NTOK * 8 + qtok * 8 + it.head] = lse;
    } else {
        const float* lsep = (const float*)(F.ws + WS_LSE);
        const float l1 = lsep[qtok * 8 + it.head], l2 = lsep[(size_t)NTOK * 8 + qtok * 8 + it.head];
        const float M = fmaxf(fmaxf(l1, l2), lse);
        float w0 = __builtin_amdgcn_exp2f(lse - M), w1 = __builtin_amdgcn_exp2f(l1 - M), w2 = __builtin_amdgcn_exp2f(l2 - M);
        const float wn = 1.0f / (w0 + w1 + w2); w0 *= wn; w1 *= wn; w2 *= wn;
        ostage_write(st, o0, o1, inv * w0, r32, hi);
        if (hi == 0) { wst[r32 * 4 + 1] = w1; wst[r32 * 4 + 2] = w2; }
        asm volatile("s_waitcnt lgkmcnt(0)" ::: "memory");
        const bf16_t* p1b = (const bf16_t*)(F.ws + WS_PART) + it.head * 64; const bf16_t* p2b = p1b + (size_t)NTOK * 512;
        bf16_t* obase = (bf16_t*)(F.ws + WS_MIX) + it.outcol;
#pragma unroll
        for (int i = 0; i < 4; ++i) { const int row = 8 * i + srow; const size_t tk = tokbase + cls + (size_t)it.dil * (qidx0 + row);
            const u32x4 a = *(const LAS u32x4*)(st + row * OST_ROW + sch * 16); const u32x4 x1 = *(const u32x4*)(p1b + tk * 512 + sch * 8), x2 = *(const u32x4*)(p2b + tk * 512 + sch * 8);
            const float q1 = wst[row * 4 + 1], q2 = wst[row * 4 + 2];
            u32x4 o;
            o.x = cvt_pk_bf16(bf_lo(a.x) + bf_lo(x1.x) * q1 + bf_lo(x2.x) * q2, bf_hi(a.x) + bf_hi(x1.x) * q1 + bf_hi(x2.x) * q2);
            o.y = cvt_pk_bf16(bf_lo(a.y) + bf_lo(x1.y) * q1 + bf_lo(x2.y) * q2, bf_hi(a.y) + bf_hi(x1.y) * q1 + bf_hi(x2.y) * q2);
            o.z = cvt_pk_bf16(bf_lo(a.z) + bf_lo(x1.z) * q1 + bf_lo(x2.z) * q2, bf_hi(a.z) + bf_hi(x1.z) * q1 + bf_hi(x2.z) * q2);
            o.w = cvt_pk_bf16(bf_lo(a.w) + bf_lo(x1.w) * q1 + bf_lo(x2.w) * q2, bf_hi(a.w) + bf_hi(x1.w) * q1 + bf_hi(x2.w) * q2);
            *(u32x4*)(obase + tk * DM + sch * 8) = o; }
    }
    __syncthreads();
}
__device__ __forceinline__ void band_phase(const Frame& F, int which  ) {
    const float* sinks = F.in[I_L0_A_SINKS];
    float gm[4] = {0.f, 0.f, 0.f, 0.f}, smax = 0.f;
    for (int i = 0; i < 64; ++i) { gm[0] = fmaxf(gm[0], fabsf(F.in[I_L0_A_QN][i])); gm[1] = fmaxf(gm[1], fabsf(F.in[I_L0_A_KN][i])); gm[2] = fmaxf(gm[2], fabsf(F.in[I_L0_B_QN][i])); gm[3] = fmaxf(gm[3], fabsf(F.in[I_L0_B_KN][i])); }
    for (int i = 0; i < 8; ++i) smax = fmaxf(smax, fabsf(sinks[i]));
    const bool fix = fmaxf(fmaxf(gm[0] * gm[1], gm[2] * gm[3]) * 8.0f, smax) * LOG2E < ATT_FIX_BOUND;
    const int nitems = which == 0 ? 6144 : 2048;
    for (int idx = F.bid; idx < nitems; idx += F.G) {
        BandItem it;
        const int ty = which == 0 ? idx / 2048 : 3, r = idx % 2048;
        it.b = r >> 6; const int h = (r >> 3) & 7, jp = r & 7;
        it.head = h; it.split_rows = false; it.has_sink = false; it.sink = 0.f; it.pidx = 0;
        if (ty == 0) { it.qcol = 64 * h; it.kcol = 512 + 64 * (h >> 2); it.vcol = 640 + 64 * (h >> 2); it.dil = 1; it.cls0 = it.cls1 = 0; it.tq0 = 256 * jp; it.tq1 = it.tq0 + 128; it.maxd = 127; it.mode = 0; it.outcol = 64 * h;
            it.has_sink = true; it.sink = sinks[h] * LOG2E; }
        else { it.qcol = 768 + 64 * h; it.kcol = 1280 + 64 * h; it.vcol = 1792 + 64 * h; it.maxd = 128; it.outcol = 512 + 64 * h;
            if (ty == 1) { it.dil = 1; it.cls0 = it.cls1 = 0; it.tq0 = 256 * jp; it.tq1 = it.tq0 + 128; it.mode = 1; it.pidx = 0; }
            else if (ty == 2) { it.dil = 4; it.cls0 = it.cls1 = jp >> 1; it.tq0 = 256 * (jp & 1); it.tq1 = it.tq0 + 128; it.mode = 1; it.pidx = 1; }
            else { it.dil = 16; it.cls0 = 2 * jp; it.cls1 = 2 * jp + 1; it.tq0 = 0; it.tq1 = 0; it.mode = 2; it.split_rows = true; } }
        if (fix) band_item<true>(F, it); else band_item<false>(F, it);
    }
}

constexpr int ML_KB = 12288, ML_VB = 8192, ML_STAGE = ML_KB + ML_VB;
__device__ __forceinline__ void mla_q_prep(bf16x8 (&q)[6], const float* gq, const float* cc, const float* sc, size_t t, int hi) {
    float ss = 0.f;
#pragma unroll
    for (int kk = 0; kk < 6; ++kk) { const u32x4 x = __builtin_bit_cast(u32x4, q[kk]);
        ss += bf_lo(x.x) * bf_lo(x.x) + bf_hi(x.x) * bf_hi(x.x) + bf_lo(x.y) * bf_lo(x.y) + bf_hi(x.y) * bf_hi(x.y) + bf_lo(x.z) * bf_lo(x.z) + bf_hi(x.z) * bf_hi(x.z) + bf_lo(x.w) * bf_lo(x.w) + bf_hi(x.w) * bf_hi(x.w); }
    const float rsd = __builtin_amdgcn_rsqf(swap32_sum(ss) * (1.f / 96.f) + EPS) * (0.10206207261596577f * LOG2E);
    float va[8], vb[8];
#pragma unroll
    for (int kk = 0; kk < 6; ++kk) { const u32x4 x = __builtin_bit_cast(u32x4, q[kk]);
        const f32x4 g0 = *(const f32x4*)(gq + 16 * kk + 8 * hi) * rsd, g1 = *(const f32x4*)(gq + 16 * kk + 8 * hi + 4) * rsd;
        float v[8] = {bf_lo(x.x) * g0[0], bf_hi(x.x) * g0[1], bf_lo(x.y) * g0[2], bf_hi(x.y) * g0[3], bf_lo(x.z) * g1[0], bf_hi(x.z) * g1[1], bf_lo(x.w) * g1[2], bf_hi(x.w) * g1[3]};
        if (kk < 4) { u32x4 o; o.x = cvt_pk_bf16(v[0], v[1]); o.y = cvt_pk_bf16(v[2], v[3]); o.z = cvt_pk_bf16(v[4], v[5]); o.w = cvt_pk_bf16(v[6], v[7]); q[kk] = __builtin_bit_cast(bf16x8, o); }
        else {
#pragma unroll
            for (int j = 0; j < 8; ++j) { if (kk == 4) va[j] = v[j]; else vb[j] = v[j]; } } }
    const f32x4 c0 = *(const f32x4*)(cc + t * 16 + 8 * hi), c1 = *(const f32x4*)(cc + t * 16 + 8 * hi + 4), s0 = *(const f32x4*)(sc + t * 16 + 8 * hi), s1 = *(const f32x4*)(sc + t * 16 + 8 * hi + 4);
    float ra[8], rb[8];
#pragma unroll
    for (int j = 0; j < 8; ++j) { const float c = j < 4 ? c0[j & 3] : c1[j & 3], s = j < 4 ? s0[j & 3] : s1[j & 3]; ra[j] = va[j] * c - vb[j] * s; rb[j] = vb[j] * c + va[j] * s; }
    { u32x4 o; o.x = cvt_pk_bf16(ra[0], ra[1]); o.y = cvt_pk_bf16(ra[2], ra[3]); o.z = cvt_pk_bf16(ra[4], ra[5]); o.w = cvt_pk_bf16(ra[6], ra[7]); q[4] = __builtin_bit_cast(bf16x8, o);
      o.x = cvt_pk_bf16(rb[0], rb[1]); o.y = cvt_pk_bf16(rb[2], rb[3]); o.z = cvt_pk_bf16(rb[4], rb[5]); o.w = cvt_pk_bf16(rb[6], rb[7]); q[5] = __builtin_bit_cast(bf16x8, o); }
}
template <bool FIXREF>
__device__ __forceinline__ void mla_unit(const Frame& F, int b, int h, int qb) {
    const int lane_ = lane_id_v();
    const bf16_t* Q = (const bf16_t*)(F.ws + WS_Q); const bf16_t* Kt = (const bf16_t*)(F.ws + WS_K); const bf16_t* V = (const bf16_t*)(F.ws + WS_KV);
    LAS unsigned char* lds = F.lds;
    const int lane = lane_, w = F.wave, hi = lane >> 5, r32 = lane & 31;
    const size_t tokbase = (size_t)b * SEQ;
    const int q0 = qb * 256, qidx0 = q0 + 32 * w, qidx = qidx0 + r32;
    const int NT = 4 * (qb + 1);
    const size_t hbase = ((size_t)b * 16 + h) * SEQ;
    const __amdgpu_buffer_rsrc_t rsK = __builtin_amdgcn_make_buffer_rsrc((void*)(Kt + hbase * 96), (short)0, SEQ * 96 * 2, 0x00020000);
    const __amdgpu_buffer_rsrc_t rsV = __builtin_amdgcn_make_buffer_rsrc((void*)(V + hbase * 64), (short)0, SEQ * 64 * 2, 0x00020000);
    const int k16 = lane >> 2, pc = lane & 3, swz = pc ^ ((k16 >> 2) & 3);
    unsigned vo0, vo1, vo2;
    { const int kg = w / 3, cg = w % 3; vo0 = (unsigned)((kg * 16 + k16) * 192 + (cg * 4 + swz) * 16); }
    if (w < 4) { const int id = w + 8, kg = id / 3, cg = id % 3; vo1 = (unsigned)((kg * 16 + k16) * 192 + (cg * 4 + swz) * 16);
                 const int j = w + 4, d0 = j >> 2, kgv = j & 3; vo2 = (unsigned)((kgv * 16 + k16) * 128 + (d0 * 4 + pc) * 16); }
    else { const int j = w - 4, d0 = j >> 2, kgv = j & 3; vo1 = (unsigned)((kgv * 16 + k16) * 128 + (d0 * 4 + pc) * 16); vo2 = 0; }
    const unsigned lds0 = (unsigned)(uintptr_t)lds;
#define ML_DMA(t, st) do { const unsigned so_k = (unsigned)((t) * 64 * 192), so_v = (unsigned)((t) * 64 * 128); \
        dma_piece(rsK, lds0 + (st) + w * 1024, vo0, so_k); \
        if (w < 4) { dma_piece(rsK, lds0 + (st) + (w + 8) * 1024, vo1, so_k); dma_piece(rsV, lds0 + (st) + ML_KB + (w + 4) * 1024, vo2, so_v); } \
        else { dma_piece(rsV, lds0 + (st) + ML_KB + (w - 4) * 1024, vo1, so_v); } } while (0)
    ML_DMA(0, 0);
    bf16x8 qf[6];
#pragma unroll
    for (int kk = 0; kk < 6; ++kk) qf[kk] = *(const bf16x8*)(Q + (hbase + qidx) * 96 + 16 * kk + 8 * hi);
    mla_q_prep(qf, F.in[I_L1_C_QN], (const float*)(F.ws + WS_ROPEC), (const float*)(F.ws + WS_ROPEC) + (size_t)NTOK * 16, tokbase + qidx, hi);
    float m = 0.f, l = 0.f; f32x16 o0, o1, negm;
#pragma unroll
    for (int r = 0; r < 16; ++r) { o0[r] = 0.f; o1[r] = 0.f; negm[r] = 0.f; }
    const int vlane = (4 * hi + ((lane & 15) >> 2)) * 64 + ((lane >> 4) & 1) * 32 + (lane & 3) * 8;
    const int klane = (r32 >> 4) * 3072 + (r32 & 15) * 64, ksw = (r32 >> 2) & 3, ke0 = ((hi) ^ ksw) * 16, ke1 = ((2 + hi) ^ ksw) * 16;
    asm volatile("s_waitcnt vmcnt(0) lgkmcnt(0)\n\ts_barrier" ::: "memory");
#define ML_TILE(t, CUR, NXT) do { \
        if ((t) + 1 < NT) ML_DMA((t) + 1, NXT); \
        const int kidx0 = 64 * (t); \
        LAS unsigned char* kp0 = lds + (CUR) + klane; LAS unsigned char* kp1 = kp0 + 6144; \
        LAS unsigned char* vp0 = lds + (CUR) + ML_KB + vlane; LAS unsigned char* vp1 = vp0 + 32 * 64; \
        if (kidx0 <= qidx0 + 31) \
            attn_step<96, true, FIXREF>(kp0, kp1, ke0, ke1, vp0, vp1, 4096, qf, negm, m, l, o0, o1, kidx0 + 31 > qidx0, kidx0 + 63 > qidx0, qidx, kidx0, 1 << 30, hi); \
        asm volatile("s_waitcnt vmcnt(0) lgkmcnt(0)\n\ts_barrier" ::: "memory"); } while (0)
#pragma unroll 1
    for (int t = 0; t < NT; t += 2) {
        ML_TILE(t, 0, ML_STAGE);
        ML_TILE(t + 1, ML_STAGE, 0);
    }
#undef ML_TILE
#undef ML_DMA
    l = swap32_sum(l);
    const float inv = 1.0f / l;
    { LAS unsigned char* st = lds + 2 * ML_STAGE + w * OST_WAVE;
      ostage_write(st, o0, o1, inv, r32, hi);
      asm volatile("s_waitcnt lgkmcnt(0)" ::: "memory");
      bf16_t* obase = (bf16_t*)(F.ws + WS_ATT) + (tokbase + qidx0) * DM + h * 64;
#pragma unroll
      for (int i = 0; i < 4; ++i) { const int row = 8 * i + (lane >> 3); *(u32x4*)(obase + (size_t)row * DM + (lane & 7) * 8) = *(const LAS u32x4*)(st + row * OST_ROW + (lane & 7) * 16); } }
}
__device__ __forceinline__ void mla_unit2(const Frame& F, int b, int h, int qb  ) {
    const int lane_ = lane_id_v();
    const bf16_t* Q = (const bf16_t*)(F.ws + WS_Q); const bf16_t* Kt = (const bf16_t*)(F.ws + WS_K); const bf16_t* V = (const bf16_t*)(F.ws + WS_KV);
    LAS unsigned char* lds = F.lds;
    const int lane = lane_, w = F.wave, hi = lane >> 5, r32 = lane & 31;
    const size_t tokbase = (size_t)b * SEQ;
    const int qidx0 = qb * 512 + 64 * w, qidx = qidx0 + r32;
    const int NT = 8 * (qb + 1);
    const size_t hbase = ((size_t)b * 16 + h) * SEQ;
    const __amdgpu_buffer_rsrc_t rsK = __builtin_amdgcn_make_buffer_rsrc((void*)(Kt + hbase * 96), (short)0, SEQ * 96 * 2, 0x00020000);
    const __amdgpu_buffer_rsrc_t rsV = __builtin_amdgcn_make_buffer_rsrc((void*)(V + hbase * 64), (short)0, SEQ * 64 * 2, 0x00020000);
    const int k16 = lane >> 2, pc = lane & 3, swz = pc ^ ((k16 >> 2) & 3);
    unsigned vo0, vo1, vo2;
    { const int kg = w / 3, cg = w % 3; vo0 = (unsigned)((kg * 16 + k16) * 192 + (cg * 4 + swz) * 16); }
    if (w < 4) { const int id = w + 8, kg = id / 3, cg = id % 3; vo1 = (unsigned)((kg * 16 + k16) * 192 + (cg * 4 + swz) * 16);
                 const int j = w + 4, d0 = j >> 2, kgv = j & 3; vo2 = (unsigned)((kgv * 16 + k16) * 128 + (d0 * 4 + pc) * 16); }
    else { const int j = w - 4, d0 = j >> 2, kgv = j & 3; vo1 = (unsigned)((kgv * 16 + k16) * 128 + (d0 * 4 + pc) * 16); vo2 = 0; }
    const unsigned lds0 = (unsigned)(uintptr_t)lds;
#define ML_DMA(t, st) do { const unsigned so_k = (unsigned)((t) * 64 * 192), so_v = (unsigned)((t) * 64 * 128); \
        dma_piece(rsK, lds0 + (st) + w * 1024, vo0, so_k); \
        if (w < 4) { dma_piece(rsK, lds0 + (st) + (w + 8) * 1024, vo1, so_k); dma_piece(rsV, lds0 + (st) + ML_KB + (w + 4) * 1024, vo2, so_v); } \
        else { dma_piece(rsV, lds0 + (st) + ML_KB + (w - 4) * 1024, vo1, so_v); } } while (0)
    ML_DMA(0, 0);
    bf16x8 qa[6], qb2[6];
    { const __amdgpu_buffer_rsrc_t rsQ = __builtin_amdgcn_make_buffer_rsrc((void*)(Q + hbase * 96), (short)0, SEQ * 96 * 2, 0x00020000);
      const unsigned qo = (unsigned)(qidx * 192 + hi * 16);
#pragma unroll
      for (int kk = 0; kk < 6; ++kk) { qa[kk] = __builtin_bit_cast(bf16x8, __builtin_amdgcn_raw_buffer_load_b128(rsQ, qo + kk * 32, 0, 0)); qb2[kk] = __builtin_bit_cast(bf16x8, __builtin_amdgcn_raw_buffer_load_b128(rsQ, qo + 32 * 192 + kk * 32, 0, 0)); } }
    { const float* cc_ = (const float*)(F.ws + WS_ROPEC); mla_q_prep(qa, F.in[I_L1_C_QN], cc_, cc_ + (size_t)NTOK * 16, tokbase + qidx, hi); mla_q_prep(qb2, F.in[I_L1_C_QN], cc_, cc_ + (size_t)NTOK * 16, tokbase + qidx + 32, hi); }
    float la = 0.f, lb = 0.f; f32x16 oa0, oa1, ob0, ob1;
#pragma unroll
    for (int r = 0; r < 16; ++r) { oa0[r] = 0.f; oa1[r] = 0.f; ob0[r] = 0.f; ob1[r] = 0.f; }
    const int vlane = (4 * hi + ((lane & 15) >> 2)) * 64 + ((lane >> 4) & 1) * 32 + (lane & 3) * 8;
    const int klane = (r32 >> 4) * 3072 + (r32 & 15) * 64, ksw = (r32 >> 2) & 3, ke0 = ((hi) ^ ksw) * 16, ke1 = ((2 + hi) ^ ksw) * 16;
    asm volatile("s_waitcnt vmcnt(0) lgkmcnt(0)\n\ts_barrier" ::: "memory");
#define ML_TILE(t, CUR, NXT) do { \
        if ((t) + 1 < NT) ML_DMA((t) + 1, NXT); \
        const int kidx0 = 64 * (t); \
        if (kidx0 <= qidx0 + 63) { \
            attn_step2<96>(lds + (CUR) + klane, ke0, ke1, lds + (CUR) + ML_KB + vlane, 4096, qa, qb2, la, lb, oa0, oa1, ob0, ob1, kidx0 + 31 > qidx0, kidx0 + 31 > qidx0 + 32, qidx, kidx0, hi); \
            attn_step2<96>(lds + (CUR) + klane + 6144, ke0, ke1, lds + (CUR) + ML_KB + vlane + 32 * 64, 4096, qa, qb2, la, lb, oa0, oa1, ob0, ob1, kidx0 + 63 > qidx0, kidx0 + 63 > qidx0 + 32, qidx, kidx0 + 32, hi); } \
        asm volatile("s_waitcnt vmcnt(0) lgkmcnt(0)\n\ts_barrier" ::: "memory"); } while (0)
#pragma unroll 1
    for (int t = 0; t < NT; t += 2) {
        ML_TILE(t, 0, ML_STAGE);
        ML_TILE(t + 1, ML_STAGE, 0);
    }
#undef ML_TILE
#undef ML_DMA
    la = swap32_sum(la); lb = swap32_sum(lb);
    const float ia = 1.0f / la, ib = 1.0f / lb;
    { LAS unsigned char* st = lds + 2 * ML_STAGE + w * 2 * OST_WAVE;
      ostage_write(st, oa0, oa1, ia, r32, hi); ostage_write(st + OST_WAVE, ob0, ob1, ib, r32, hi);
      asm volatile("s_waitcnt lgkmcnt(0)" ::: "memory");
      bf16_t* obase = (bf16_t*)(F.ws + WS_ATT) + (tokbase + qidx0) * DM + h * 64;
#pragma unroll
      for (int i = 0; i < 8; ++i) { const int row = 8 * i + (lane >> 3); *(u32x4*)(obase + (size_t)row * DM + (lane & 7) * 8) = *(const LAS u32x4*)(st + row * OST_ROW + (lane & 7) * 16); } }
}
__device__ __forceinline__ void mla_phase(const Frame& F) {
    float gq = 0.f, gk = 0.f;
    for (int i = 0; i < 96; ++i) { gq = fmaxf(gq, fabsf(F.in[I_L1_C_QN][i])); gk = fmaxf(gk, fabsf(F.in[I_L1_C_KN][i])); }
    const bool fix = gq * gk * 9.797959f * LOG2E < ATT_FIX_BOUND;
    if (fix) {
        for (int idx = F.bid; idx < 1024; idx += F.G) {
            const int bh = idx >> 1, s = idx & 1;
#pragma nounroll
            for (int u = 0; u < 2; ++u) mla_unit2(F, bh >> 4, bh & 15, u ? s : 3 - s);
        }
    } else {
        for (int idx = F.bid; idx < 2048; idx += F.G) {
            const int bh = idx >> 2, s = idx & 3;
#pragma nounroll
            for (int u = 0; u < 2; ++u) mla_unit<false>(F, bh >> 4, bh & 15, u ? s : 7 - s);
        }
    }
}

__device__ __forceinline__ void mla_rowstats(const Frame& F) {
    const int lane_ = lane_id_v();
    const bf16_t* P1 = (const bf16_t*)(F.ws + WS_PROJ1); float* rs = (float*)(F.ws + RT_ROWST);
    for (int t = F.bid * 8 + F.wave; t < NTOK; t += F.G * 8) {
        const bf16_t* pr = P1 + (size_t)t * L1_INP;
        const u32x2 a = *(const u32x2*)(pr + lane_ * 4); const unsigned a2 = *(const unsigned*)(pr + 256 + lane_ * 2); const u32x2 c = *(const u32x2*)(pr + CQ + lane_ * 4);
        const float s1 = bf_lo(a.x) * bf_lo(a.x) + bf_hi(a.x) * bf_hi(a.x) + bf_lo(a.y) * bf_lo(a.y) + bf_hi(a.y) * bf_hi(a.y) + bf_lo(a2) * bf_lo(a2) + bf_hi(a2) * bf_hi(a2);
        const float s2 = bf_lo(c.x) * bf_lo(c.x) + bf_hi(c.x) * bf_hi(c.x) + bf_lo(c.y) * bf_lo(c.y) + bf_hi(c.y) * bf_hi(c.y);
        const float rq = __builtin_amdgcn_rsqf(wave_sum(s1) * (1.f / CQ) + EPS), rkv = __builtin_amdgcn_rsqf(wave_sum(s2) * (1.f / CKV) + EPS);
        if (lane_ == 0) *(f32x2*)(rs + 2 * t) = (f32x2){rq, rkv};
    }
}
__device__ __forceinline__ void moe_route1(const Frame& F) {
    const int lane_ = lane_id_v(), tid_ = F.wave * 64 + lane_; (void)tid_;
    const bf16_t* x = (const bf16_t*)(F.ws + WS_X3); const float* gain = F.in[I_L1_FFN_NORM]; const float* router = F.in[I_L1_ROUTER];
    unsigned char* dst = (unsigned char*)(F.ws + WS_H3F8);
    int* tok_e = (int*)(F.ws + RT_TOKE); float* tok_g = (float*)(F.ws + RT_TOKG); int* wgcnt = (int*)(F.ws + RT_WGCNT);
    LAS int* cnt = (LAS int*)(F.lds + 32768);
    if (tid_ < 8) cnt[tid_] = 0;
    __syncthreads();
    f32x4 rr[4][4][2];
#pragma unroll
    for (int j = 0; j < 4; ++j)
#pragma unroll
        for (int c = 0; c < 4; ++c) { const int d = (lane_ + 64 * j) * 4 + c; rr[j][c][0] = *(const f32x4*)(router + d * 8); rr[j][c][1] = *(const f32x4*)(router + d * 8 + 4); }
    f32x4 gv[4];
#pragma unroll
    for (int j = 0; j < 4; ++j) gv[j] = ((const f32x4*)gain)[lane_ + 64 * j];
    u32x2 nx[4];
    { const int m0 = F.bid * 8 + F.wave; const u32x2* xr = (const u32x2*)(x + (size_t)m0 * DM) + lane_;
#pragma unroll
      for (int j = 0; j < 4; ++j) nx[j] = xr[64 * j]; }
    for (int m = F.bid * 8 + F.wave; m < NTOK; m += F.G * 8) {
        u32x2 cx[4];
#pragma unroll
        for (int j = 0; j < 4; ++j) cx[j] = nx[j];
        if (m + F.G * 8 < NTOK) { const u32x2* xr = (const u32x2*)(x + (size_t)(m + F.G * 8) * DM) + lane_;
#pragma unroll
            for (int j = 0; j < 4; ++j) nx[j] = xr[64 * j]; }
        f32x4 v[4]; float s = 0.f;
#pragma unroll
        for (int j = 0; j < 4; ++j) { const u32x2 xx = cx[j]; v[j] = (f32x4){bf_lo(xx.x), bf_hi(xx.x), bf_lo(xx.y), bf_hi(xx.y)}; s += (v[j].x * v[j].x + v[j].y * v[j].y) + (v[j].z * v[j].z + v[j].w * v[j].w); }
        const float rstd = __builtin_amdgcn_rsqf(wave_sum(s) * (1.f / DM) + EPS);
        float lg[8];
#pragma unroll
        for (int e = 0; e < 8; ++e) lg[e] = 0.f;
        unsigned* o8 = (unsigned*)(dst + (size_t)m * DM) + lane_;
#pragma unroll
        for (int j = 0; j < 4; ++j) {
            f32x4 hv = v[j] * rstd * gv[j];
            __builtin_nontemporal_store(pk4_fp8(hv.x, hv.y, hv.z, hv.w), &o8[64 * j]);
#pragma unroll
            for (int c = 0; c < 4; ++c) { const f32x4 r0 = rr[j][c][0], r1 = rr[j][c][1];
                lg[0] += hv[c] * r0.x; lg[1] += hv[c] * r0.y; lg[2] += hv[c] * r0.z; lg[3] += hv[c] * r0.w; lg[4] += hv[c] * r1.x; lg[5] += hv[c] * r1.y; lg[6] += hv[c] * r1.z; lg[7] += hv[c] * r1.w; }
        }
        { const bool b0 = lane_ & 1, b1 = (lane_ >> 1) & 1, b2 = (lane_ >> 2) & 1;
          float k4[4], k2[2], k1;
#pragma unroll
          for (int i = 0; i < 4; ++i) { const float keep = b0 ? lg[4 + i] : lg[i], send = b0 ? lg[i] : lg[4 + i]; k4[i] = keep + __shfl_xor(send, 1); }
#pragma unroll
          for (int i = 0; i < 2; ++i) { const float keep = b1 ? k4[2 + i] : k4[i], send = b1 ? k4[i] : k4[2 + i]; k2[i] = keep + __shfl_xor(send, 2); }
          { const float keep = b2 ? k2[1] : k2[0], send = b2 ? k2[0] : k2[1]; k1 = keep + __shfl_xor(send, 4); }
          k1 += __shfl_xor(k1, 8); k1 += __shfl_xor(k1, 16); k1 += __shfl_xor(k1, 32);
#pragma unroll
          for (int e = 0; e < 8; ++e) lg[e] = __uint_as_float(__builtin_amdgcn_readlane(__float_as_uint(k1), (e >> 2) | (((e >> 1) & 1) << 1) | ((e & 1) << 2))); }
        int e0 = 0; float v0 = lg[0];
#pragma unroll
        for (int e = 1; e < 8; ++e) if (lg[e] > v0) { v0 = lg[e]; e0 = e; }
        int e1 = -1; float v1 = -INFINITY;
#pragma unroll
        for (int e = 0; e < 8; ++e) if (e != e0 && lg[e] > v1) { v1 = lg[e]; e1 = e; }
        const float p1 = __expf(v1 - v0), g0 = 1.0f / (1.0f + p1), g1 = p1 * g0;
        if (lane_ == 0) { tok_e[2 * m] = e0; tok_e[2 * m + 1] = e1; tok_g[2 * m] = g0; tok_g[2 * m + 1] = g1;
            __hip_atomic_fetch_add(cnt + e0, 1, __ATOMIC_RELAXED, __HIP_MEMORY_SCOPE_WORKGROUP); __hip_atomic_fetch_add(cnt + e1, 1, __ATOMIC_RELAXED, __HIP_MEMORY_SCOPE_WORKGROUP); }
    }
    __syncthreads();
    if (tid_ < 8) wgcnt[F.bid * 8 + tid_] = cnt[tid_];
}
__device__ __forceinline__ void moe_route2(const Frame& F) {
    const int lane_ = lane_id_v(), tid_ = F.wave * 64 + lane_; (void)tid_;
    const int* tok_e = (const int*)(F.ws + RT_TOKE); int* tok_s = (int*)(F.ws + RT_TOKS); int* row_tok = (int*)(F.ws + RT_ROWTOK);
    const int* wgcnt = (const int*)(F.ws + RT_WGCNT); int* tile_e = (int*)(F.ws + RT_TILEE);
    LAS int* tot = (LAS int*)F.lds;
    if (tid_ < 32) tot[tid_] = 0;
    __syncthreads();
    { const int e = tid_ & 7; int a = 0, b = 0;
      for (int wg = tid_ >> 3; wg < F.G; wg += 64) { const int c = wgcnt[wg * 8 + e]; a += c; if (wg < F.bid) b += c; }
      __hip_atomic_fetch_add(tot + e, a, __ATOMIC_RELAXED, __HIP_MEMORY_SCOPE_WORKGROUP); __hip_atomic_fetch_add(tot + 8 + e, b, __ATOMIC_RELAXED, __HIP_MEMORY_SCOPE_WORKGROUP); }
    __syncthreads();
    if (tid_ == 0) { int ps = 0; for (int e = 0; e < 8; ++e) { tot[16 + e] = ps; ps += (tot[e] + 255) / 256 * 256; } tot[32] = ps; }
    __syncthreads();
    if (F.bid == 0) {
        const int used = tot[32] / 256;
        for (int t = tid_; t < MOE_TILES_MAX; t += 512) { int e = -1; if (t < used) { e = 7; for (int q = 7; q >= 1; --q) if (t * 256 < tot[16 + q]) e = q - 1; } tile_e[t] = e < 0 ? 0 : e; }
        if (tid_ == 0) tile_e[MOE_TILES_MAX] = used;
    }
    if (F.bid < 8) {
        const int e = F.bid, lo = tot[16 + e] + tot[e], hi = tot[16 + e] + (tot[e] + 255) / 256 * 256;
        for (int p = lo + tid_; p < hi; p += 512) row_tok[p] = -1;
    }
    { const int gw = F.bid * 8 + F.wave, NGW = F.G * 8;
      for (int j0 = 0; gw + j0 * NGW < NTOK; j0 += 32) {
          const int m = gw + (j0 + (lane_ >> 1)) * NGW, k = lane_ & 1;
          int slot = -1;
          if (m < NTOK) { const int e = tok_e[2 * m + k];
              slot = tot[16 + e] + tot[8 + e] + __hip_atomic_fetch_add(tot + 24 + e, 1, __ATOMIC_RELAXED, __HIP_MEMORY_SCOPE_WORKGROUP);
              row_tok[slot] = 2 * m + k; tok_s[2 * m + k] = slot; }
          const unsigned char* h3 = (const unsigned char*)(F.ws + WS_H3F8); unsigned char* h3s = (unsigned char*)(F.ws + WS_H3S);
#pragma unroll 16
          for (int i = 0; i < 64; ++i) { const int si = __builtin_amdgcn_readlane(slot, i), mi = gw + (j0 + (i >> 1)) * NGW;
              if (si >= 0) { const u32x4 v = *(const u32x4*)(h3 + (size_t)mi * DM + lane_ * 16); *(u32x4*)(h3s + (size_t)si * DM + lane_ * 16) = v; } } } }
    __syncthreads();
}
__device__ __forceinline__ void moe_combine(const Frame& F, bool dry) {
    const int lane_ = lane_id_v();
    const f32x2* tok_g = (const f32x2*)(F.ws + RT_TOKG); const u32x2* tok_s = (const u32x2*)(F.ws + RT_TOKS); const unsigned char* Y = (const unsigned char*)(F.ws + WS_Y);
    for (int m = (F.bid * 8 + F.wave) * 2; m < NTOK; m += F.G * 16) {
        const f32x2 ga = tok_g[m], gb = tok_g[m + 1];
        f32x4* xa = (f32x4*)(F.out + (size_t)m * DM) + lane_; f32x4* xb = xa + DM / 4;
        const u32x2* x3a = (const u32x2*)((const bf16_t*)(F.ws + WS_X3) + (size_t)m * DM) + lane_; const u32x2* x3b = x3a + DM / 4;
        const unsigned* ya0 = (const unsigned*)(Y + (size_t)(2 * m) * DM) + lane_; const unsigned* ya1 = ya0 + DM / 4;
        const unsigned* yb0 = ya1 + DM / 4; const unsigned* yb1 = yb0 + DM / 4;
        f32x4 va[4], vb[4]; unsigned a0[4], a1[4], b0[4], b1[4];
#pragma unroll
        for (int j = 0; j < 4; ++j) { { const u32x2 p = __builtin_nontemporal_load(&x3a[64 * j]), q = __builtin_nontemporal_load(&x3b[64 * j]); va[j] = (f32x4){bf_lo(p.x), bf_hi(p.x), bf_lo(p.y), bf_hi(p.y)}; vb[j] = (f32x4){bf_lo(q.x), bf_hi(q.x), bf_lo(q.y), bf_hi(q.y)}; } a0[j] = __builtin_nontemporal_load(&ya0[64 * j]); a1[j] = __builtin_nontemporal_load(&ya1[64 * j]); b0[j] = __builtin_nontemporal_load(&yb0[64 * j]); b1[j] = __builtin_nontemporal_load(&yb1[64 * j]); }
#pragma unroll
        for (int j = 0; j < 4; ++j) {
            const float gax = ga.x * 0.0625f, gay = ga.y * 0.0625f, gbx = gb.x * 0.0625f, gby = gb.y * 0.0625f;
            f32x4 v = va[j];
            v.x += gax * __builtin_amdgcn_cvt_f32_fp8((int)a0[j], 0) + gay * __builtin_amdgcn_cvt_f32_fp8((int)a1[j], 0); v.y += gax * __builtin_amdgcn_cvt_f32_fp8((int)a0[j], 1) + gay * __builtin_amdgcn_cvt_f32_fp8((int)a1[j], 1);
            v.z += gax * __builtin_amdgcn_cvt_f32_fp8((int)a0[j], 2) + gay * __builtin_amdgcn_cvt_f32_fp8((int)a1[j], 2); v.w += gax * __builtin_amdgcn_cvt_f32_fp8((int)a0[j], 3) + gay * __builtin_amdgcn_cvt_f32_fp8((int)a1[j], 3);
            if (!dry) xa[64 * j] = v;
            v = vb[j];
            v.x += gbx * __builtin_amdgcn_cvt_f32_fp8((int)b0[j], 0) + gby * __builtin_amdgcn_cvt_f32_fp8((int)b1[j], 0); v.y += gbx * __builtin_amdgcn_cvt_f32_fp8((int)b0[j], 1) + gby * __builtin_amdgcn_cvt_f32_fp8((int)b1[j], 1);
            v.z += gbx * __builtin_amdgcn_cvt_f32_fp8((int)b0[j], 2) + gby * __builtin_amdgcn_cvt_f32_fp8((int)b1[j], 2); v.w += gbx * __builtin_amdgcn_cvt_f32_fp8((int)b0[j], 3) + gby * __builtin_amdgcn_cvt_f32_fp8((int)b1[j], 3);
            if (!dry) xb[64 * j] = v; }
    }
}

constexpr int NPHASE = 21;
__global__ void __launch_bounds__(512, 2) mk_fwd(Args args) {
    extern __shared__ __attribute__((aligned(16))) unsigned char lds_raw[];
    Frame F;
    F.lds = (LAS unsigned char*)lds_raw;
    F.wave = __builtin_amdgcn_readfirstlane((int)threadIdx.x >> 6);
    F.G = gridDim.x; F.bid = blockIdx.x; F.ws = args.ws; F.out = args.out; F.in = args.in;
    volatile LAS unsigned* MISC = (volatile LAS unsigned*)(F.lds + LDS_MISC);
    { const int l0 = lane_id_v(); if (F.wave == 0) MISC[l0] = 0u; }
    __syncthreads();
    unsigned* ctl = (unsigned*)(args.ws + WS_CTL);
    XcdBarrier bar; bar.bar = ctl + CW_BAR; bar.x = 0; bar.st = nullptr; bar.wave = F.wave;
    if (!MK_PER_PHASE) bar = xcd_barrier_post(ctl + CW_BAR, MISC, F.wave);
    const int lo = args.ph_lo, hi = args.ph_hi; const unsigned probe = args.probe; (void)probe;
    unsigned char* ws = args.ws;
#define IN(k) (lo <= (k) && (k) < hi)
#if PROBE_MASK != 0
#define DRY(k) (rep_ < (int)((probe >> (k)) & 1u))
#define REPS(k) _Pragma("nounroll") for (int rep_ = 0; rep_ <= (int)((probe >> (k)) & 1u); ++rep_)
#else
#define DRY(k) false
#define REPS(k)
#endif
#define SEAM(k) do { if (IN(k) && IN((k) + 1)) { if (!MK_PER_PHASE) xcd_barrier(bar); } } while (0)
    int ph = 0;
    if (IN(0)) REPS(0) { p0_weights(F); p0_rope(F); x_rows(F, F.in[I_X], (bf16_t*)(ws + WS_H), (float*)(ws + RT_ROWST)); } SEAM(0);
    if (IN(1)) REPS(1) { pg8::Gemm g{(const bf16_t*)(ws + WS_H), (const bf16_t*)(ws + W0_IN), DM, DM, 0, nullptr}; pg8::StaticOrder S; S.init(NTOK / 256, L0_IN / 256, F.G, F.bid);
        pg8::EpiQKV0 E{(bf16_t*)(ws + WS_PROJ0), (const float*)(ws + WS_ROPEH), (const float*)(ws + WS_ROPEH) + (size_t)NTOK * 32, (const float*)(ws + RT_ROWST), F.in[I_L0_A_QN], F.in[I_L0_A_KN], F.in[I_L0_B_QN], F.in[I_L0_B_KN]};
        pg8::gemm_phase<pg8::EpiQKV0, false, 2, L0_IN / 256>(F.lds, g, S, E, 0, F.wave); } SEAM(1);
    if (IN(2)) REPS(2) { band_phase(F, 0); } SEAM(2);
    if (IN(3)) REPS(3) { band_phase(F, 1); } SEAM(3);
    if (IN(4)) REPS(4) { pg8::Gemm g{(const bf16_t*)(ws + WS_MIX), (const bf16_t*)(ws + W0_OUT), DM, DM, 0, nullptr}; pg8::StaticOrder S; S.init(NTOK / 256, DM / 256, F.G, F.bid);
        pg8::EpiRes<true, true, true> E{ws + WS_H, ws + WS_X12, false, (float*)(ws + WS_SSX), (LAS float*)(F.lds + RING_BYTES + 2048)}; pg8::gemm_phase<pg8::EpiRes<true, true, true>, false, 2, DM / 256>(F.lds, g, S, E, 0, F.wave); } SEAM(4);
    if (IN(6)) REPS(6) { pg8::Gemm g{(const bf16_t*)(ws + WS_X12), (const bf16_t*)(ws + W0_GU), DM, DM, 0, nullptr}; pg8::StaticOrder S; S.init(NTOK / 256, 2 * DFF / 256, F.G, F.bid);
        pg8::EpiSwiGLU E{(bf16_t*)(ws + WS_HID0), DFF, 0, (const float*)(ws + WS_SSX)}; pg8::gemm_phase<pg8::EpiSwiGLU, false, 2, 2 * DFF / 256>(F.lds, g, S, E, 0, F.wave); } SEAM(6);
    if (IN(7)) REPS(7) { pg8::Gemm g{(const bf16_t*)(ws + WS_HID0), (const bf16_t*)(ws + W0_DN), DFF, DFF, 0, nullptr}; pg8::StaticOrder S; S.init(NTOK / 256, DM / 256, F.G, F.bid);
        pg8::EpiRes<true, true, true> E{ws + WS_X12, ws + WS_X12, DRY(7), (float*)(ws + WS_SSX), (LAS float*)(F.lds + RING_BYTES + 2048)}; pg8::gemm_phase<pg8::EpiRes<true, true, true>, false, 2, DM / 256>(F.lds, g, S, E, 0, F.wave); } SEAM(7);
    if (IN(9)) REPS(9) { pg8::Gemm g{(const bf16_t*)(ws + WS_X12), (const bf16_t*)(ws + W1_IN), DM, DM, 0, nullptr}; pg8::StaticOrder S; S.init(NTOK / 256, L1_INP / 256, F.G, F.bid);
        pg8::EpiProj1 E{(bf16_t*)(ws + WS_PROJ1), (float*)(ws + WS_ROPEH), (LAS float*)(F.lds + RING_BYTES + 2048), (const float*)(ws + WS_SSX)}; pg8::gemm_phase<pg8::EpiProj1, false, 2, L1_INP / 256>(F.lds, g, S, E, 0, F.wave); } SEAM(9);
    if (IN(11)) REPS(11) {
        { pg8::Gemm g{(const bf16_t*)(ws + WS_PROJ1), (const bf16_t*)(ws + W1_UQ), L1_INP, CQ, 0, nullptr}; pg8::StaticOrder S; S.init(NTOK / 256, NUQ / 256, F.G, F.bid);
          pg8::EpiBf16Row E{(bf16_t*)(ws + WS_Q), NUQ, (const float*)(ws + WS_ROPEH), 0}; pg8::gemm_phase<pg8::EpiBf16Row, false, 2, NUQ / 256>(F.lds, g, S, E, 0, F.wave); } }
    if (IN(12)) REPS(12) {
        { pg8::Gemm g{(const bf16_t*)(ws + WS_PROJ1) + CQ, (const bf16_t*)(ws + W1_UKV), L1_INP, CKV, 0, nullptr}; pg8::StaticOrder S; S.init(NTOK / 256, NUKV / 256, F.G, F.bid);
          const float* cc_ = (const float*)(ws + WS_ROPEC);
          pg8::EpiKV1 E{(bf16_t*)(ws + WS_K), (bf16_t*)(ws + WS_KV), (const float*)(ws + WS_ROPEH), (const bf16_t*)(ws + WS_PROJ1), cc_, cc_ + (size_t)NTOK * 16, F.in[I_L1_C_KN]};
          pg8::gemm_phase<pg8::EpiKV1, false, 2, NUKV / 256>(F.lds, g, S, E, 0, F.wave); } } SEAM(12);
    if (IN(14)) REPS(14) { mla_phase(F); } SEAM(14);
    if (IN(15)) REPS(15) { pg8::Gemm g{(const bf16_t*)(ws + WS_ATT), (const bf16_t*)(ws + W1_OUT), DM, DM, 0, nullptr}; pg8::StaticOrder S; S.init(NTOK / 256, DM / 256, F.G, F.bid);
        pg8::EpiRes<true, true> E{ws + WS_X12, ws + WS_X3, false, nullptr, nullptr}; pg8::gemm_phase<pg8::EpiRes<true, true>, false, 2, DM / 256>(F.lds, g, S, E, 0, F.wave); } SEAM(15);
    if (IN(16)) REPS(16) { moe_route1(F); } SEAM(16);
    if (IN(17)) REPS(17) { moe_route2(F); } SEAM(17);
    if (IN(18)) REPS(18) {
        const int* tile_e = (const int*)(ws + RT_TILEE); const int used = tile_e[MOE_TILES_MAX];
        pg8::Gemm g{(const bf16_t*)(ws + WS_H3S), (const bf16_t*)(ws + WE_GU), DM, DM, (size_t)2 * DFE * DM, nullptr}; pg8::StaticOrder S; S.init(used, 2 * DFE / 256, F.G, F.bid, 0, tile_e);
        static_assert(WGU_SCALE == 32.0f && WDN_SCALE == 64.0f, "MFMA block scales below");
        pg8::EpiSwiGLU8 E{(unsigned char*)(ws + WS_HIDE), DFE, DRY(18)}; pg8::gemm_phase<pg8::EpiSwiGLU8, false, 1, 0, 0x7a7a7a7a>(F.lds, g, S, E, 0, F.wave); } SEAM(18);
    if (IN(19)) REPS(19) {
        const int* tile_e = (const int*)(ws + RT_TILEE); const int used = tile_e[MOE_TILES_MAX];
        pg8::Gemm g{(const bf16_t*)(ws + WS_HIDE), (const bf16_t*)(ws + WE_DN), DFE, DFE, (size_t)DM * DFE, nullptr}; pg8::StaticOrder S; S.init(used, DM / 256, F.G, F.bid, 0, tile_e);
        pg8::EpiFp8 E{(unsigned char*)(ws + WS_Y), DM, (const int*)(ws + RT_ROWTOK)}; pg8::gemm_phase<pg8::EpiFp8, false, 1, 0, 0x7d7d7d7d>(F.lds, g, S, E, 0, F.wave); } SEAM(19);
    if (IN(20)) REPS(20) { moe_combine(F, DRY(20)); }
    (void)ph;
#undef IN
#undef SEAM
}

extern "C" void kernel_launch(void* const* d_in, const int* in_sizes, int n_in, void* d_out, int out_size, void* d_ws, size_t ws_size, hipStream_t stream) {
    static int grid = 0;
    if (grid == 0) {
        if (n_in != 28 || in_sizes[0] != NTOK * DM || out_size != NTOK * DM || ws_size < WS_END) {
            fprintf(stderr, "kernel_launch: unexpected shapes (n_in %d, in0 %d, out %d, ws %zu < %zu); nothing launched\n", n_in, n_in > 0 ? in_sizes[0] : -1, out_size, ws_size, (size_t)WS_END); grid = -1; return; }
        int dev = 0, cus = 0, per_cu = 0;
        if (hipGetDevice(&dev) != hipSuccess || hipDeviceGetAttribute(&cus, hipDeviceAttributeMultiprocessorCount, dev) != hipSuccess) { grid = -1; return; }
        if (hipFuncSetAttribute((const void*)mk_fwd, hipFuncAttributeMaxDynamicSharedMemorySize, LDS_BYTES) != hipSuccess) { fprintf(stderr, "kernel_launch: hipFuncSetAttribute failed\n"); grid = -1; return; }
        if (hipOccupancyMaxActiveBlocksPerMultiprocessor(&per_cu, (const void*)mk_fwd, 512, LDS_BYTES) != hipSuccess || per_cu < 1) fprintf(stderr, "kernel_launch: occupancy query reports %d\n", per_cu);
        (void)hipGetLastError();
        grid = cus;
    }
    if (grid < 0) return;
    if (hipMemsetAsync((char*)d_ws + WS_CTL, 0, CTL_ZERO_BYTES, stream) != hipSuccess) return;
    Args a{};
    for (int i = 0; i < 28; ++i) a.in[i] = (const float*)d_in[i];
    a.out = (float*)d_out; a.ws = (unsigned char*)d_ws; a.probe = PROBE_MASK; a.pad = 0;
    if (MK_PER_PHASE) {
        for (int p = 0; p < NPHASE; ++p) { a.ph_lo = p; a.ph_hi = p + 1; hipLaunchKernelGGL(mk_fwd, dim3(grid), dim3(512), LDS_BYTES, stream, a); }
    } else {
        a.ph_lo = 0; a.ph_hi = NPHASE; hipLaunchKernelGGL(mk_fwd, dim3(grid), dim3(512), LDS_BYTES, stream, a);
    }
}
```
